# Optimizing an MI355X kernel written in HIP

```python
import math
import jax, jax.numpy as jnp
from jax import lax
import numpy as np

D_MODEL = 1024
BATCH = 4
SEQ = 4096
DEPTH = 2
DEC_BATCH = 32
DEC_SEQ = 2048
PAST_LEN = 128

HEAD_DIM = 64
N_RET_HEADS = 4
N_FNET_GROUPS = 4
N_DIL_HEADS = 4
DIL_PAIRS = ((128, 1), (512, 4), (2048, 16))
N_DIL_GROUPS = 3
N_MLA_HEADS = 4
MLA_NOPE = 64
MLA_ROPE = 32
MLA_V = 64
Q_LORA = 256
KV_LORA = 128
D_FF = 2816
RET_CHUNK = 128
Q_BLOCK = 128
ROPE_THETA = 500000.0
RET_THETA = 10000.0
PARTIAL_ROT = HEAD_DIM // 4
EPS = 1e-6
NEG = -1e30

RET_W = N_RET_HEADS * HEAD_DIM
FNET_W = N_FNET_GROUPS * HEAD_DIM
DIL_W = N_DIL_GROUPS * N_DIL_HEADS * HEAD_DIM
D_IN = 4 * RET_W + FNET_W + 3 * DIL_W + Q_LORA + KV_LORA + MLA_ROPE
D_MIX = RET_W + FNET_W + N_DIL_HEADS * HEAD_DIM + N_MLA_HEADS * MLA_V
SPLIT_SIZES = (RET_W, RET_W, RET_W, RET_W, FNET_W, DIL_W, DIL_W, DIL_W, Q_LORA, KV_LORA, MLA_ROPE)

kernel_name = 'hybrid_bidir_parallel_heads_encoder'


def rms_norm(x, g):
    xf = x.astype(jnp.float32)
    y = xf * lax.rsqrt(jnp.mean(xf * xf, axis=-1, keepdims=True) + EPS)
    return (y * g.astype(jnp.float32)).astype(x.dtype)


def rope(x, pos, theta, rot_dim):
    half = rot_dim // 2
    inv = jnp.power(theta, -jnp.arange(half, dtype=jnp.float32) * 2.0 / rot_dim)
    ang = pos.astype(jnp.float32)[:, None] * inv[None, :]
    cos = jnp.cos(ang)[:, None, :]
    sin = jnp.sin(ang)[:, None, :]
    xf = x.astype(jnp.float32)
    x1 = xf[..., :half]
    x2 = xf[..., half:rot_dim]
    out = jnp.concatenate([x1 * cos - x2 * sin, x2 * cos + x1 * sin, xf[..., rot_dim:]], axis=-1)
    return out.astype(x.dtype)


def retention_one_direction(q, k, v, log_gamma, include_diag):
    B, H, S, d = q.shape
    C = RET_CHUNK
    N = S // C
    qc = q.reshape(B, H, N, C, d)
    kc = k.reshape(B, H, N, C, d)
    vc = v.reshape(B, H, N, C, d)
    idx = jnp.arange(C, dtype=jnp.float32)
    diff = idx[:, None] - idx[None, :]
    mask = (diff >= 0) if include_diag else (diff > 0)
    lg = log_gamma[:, None, None]
    decay = jnp.where(mask[None], jnp.exp(jnp.where(mask, diff, 0.0)[None] * lg), 0.0)
    scores = jnp.einsum('bhncd,bhnjd->bhncj', qc, kc) * decay[None, :, None]
    intra = jnp.einsum('bhncj,bhnje->bhnce', scores, vc)
    k_dec = kc * jnp.exp((C - 1 - idx)[None, :] * log_gamma[:, None])[None, :, None, :, None]
    kv = jnp.einsum('bhnjd,bhnje->nbhde', k_dec, vc)
    chunk_decay = jnp.exp(C * log_gamma)[None, :, None, None]

    def step(state, kv_n):
        return state * chunk_decay + kv_n, state

    _, prev = lax.scan(step, jnp.zeros(kv.shape[1:], jnp.float32), kv)
    q_dec = qc * jnp.exp((idx + 1.0)[None, :] * log_gamma[:, None])[None, :, None, :, None]
    cross = jnp.einsum('bhncd,nbhde->bhnce', q_dec, prev)
    return (intra + cross).reshape(B, H, S, d)


def retention_mixer(q, k, v, g, pos, dec_f, dec_b):
    B, S, _ = q.shape
    shp = (B, S, N_RET_HEADS, HEAD_DIM)
    q = rope(q.reshape(shp), pos, RET_THETA, HEAD_DIM)
    k = rope(k.reshape(shp), pos, RET_THETA, HEAD_DIM) * (HEAD_DIM ** -0.5)
    qh = q.transpose(0, 2, 1, 3).astype(jnp.float32)
    kh = k.transpose(0, 2, 1, 3).astype(jnp.float32)
    vh = v.reshape(shp).transpose(0, 2, 1, 3).astype(jnp.float32)
    lf = jax.nn.log_sigmoid(dec_f.astype(jnp.float32))
    lb = jax.nn.log_sigmoid(dec_b.astype(jnp.float32))
    fwd = retention_one_direction(qh, kh, vh, lf, True)
    bwd = retention_one_direction(qh[:, :, ::-1], kh[:, :, ::-1], vh[:, :, ::-1], lb, False)[:, :, ::-1]
    o = fwd + bwd
    o = o * lax.rsqrt(jnp.mean(o * o, axis=-1, keepdims=True) + EPS)
    o = o.transpose(0, 2, 1, 3).reshape(B, S, RET_W).astype(g.dtype)
    return jax.nn.silu(g) * o


def fourier_mixer(u, w_fmix):
    B, S, _ = u.shape
    ug = u.reshape(B, S, N_FNET_GROUPS, HEAD_DIM).astype(jnp.float32)
    f = jnp.fft.fft2(ug, axes=(1, 3), norm='ortho').real.astype(u.dtype)
    return jnp.einsum('bsgc,gce->bsge', f, w_fmix).reshape(B, S, FNET_W)


def dilated_group(q, k, v, dil, radius):
    B, S, H, dh = q.shape
    L = S // dil
    R = radius
    nblk = -(-L // R)
    Lp = nblk * R

    def to_sub(t, left, right):
        t = t.reshape(B, L, dil, H, dh).transpose(0, 2, 1, 3, 4)
        return jnp.pad(t, ((0, 0), (0, 0), (left, right), (0, 0), (0, 0)))

    qs = to_sub(q, 0, Lp - L).reshape(B, dil, nblk, R, H, dh)
    ks = to_sub(k, R, Lp - L + R).reshape(B, dil, nblk + 2, R, H, dh)
    vs = to_sub(v, R, Lp - L + R).reshape(B, dil, nblk + 2, R, H, dh)
    kw = jnp.concatenate([ks[:, :, :-2], ks[:, :, 1:-1], ks[:, :, 2:]], axis=3)
    vw = jnp.concatenate([vs[:, :, :-2], vs[:, :, 1:-1], vs[:, :, 2:]], axis=3)
    qi = jnp.arange(nblk)[:, None] * R + jnp.arange(R)[None, :]
    kj = jnp.arange(nblk)[:, None] * R - R + jnp.arange(3 * R)[None, :]
    valid = (jnp.abs(qi[:, :, None] - kj[:, None, :]) <= R) & (kj[:, None, :] >= 0) & (kj[:, None, :] < L)
    s = jnp.einsum('bgnqhd,bgnkhd->bgnhqk', qs, kw).astype(jnp.float32) * (dh ** -0.5)
    s = jnp.where(valid[None, None, :, None], s, NEG)
    m = jnp.max(s, axis=-1, keepdims=True)
    p = jnp.exp(s - m)
    den = jnp.sum(p, axis=-1)
    o = jnp.einsum('bgnhqk,bgnkhd->bgnqhd', p, vw.astype(jnp.float32))
    o = o / den.transpose(0, 1, 2, 4, 3)[..., None]
    lse = (m[..., 0] + jnp.log(den)).transpose(0, 1, 2, 4, 3)
    o = o.reshape(B, dil, Lp, H, dh)[:, :, :L].transpose(0, 2, 1, 3, 4).reshape(B, S, H, dh)
    lse = lse.reshape(B, dil, Lp, H)[:, :, :L].transpose(0, 2, 1, 3).reshape(B, S, H)
    return o, lse


def dilated_mixer(q, k, v, pos):
    B, S, _ = q.shape
    shp = (B, S, N_DIL_GROUPS, N_DIL_HEADS, HEAD_DIM)
    q = q.reshape(shp)
    k = k.reshape(shp)
    v = v.reshape(shp)
    outs, lses = [], []
    for gi, (win, dil) in enumerate(DIL_PAIRS):
        qg = rope(q[:, :, gi], pos, ROPE_THETA, PARTIAL_ROT)
        kg = rope(k[:, :, gi], pos, ROPE_THETA, PARTIAL_ROT)
        o, lse = dilated_group(qg, kg, v[:, :, gi], dil, win // (2 * dil))
        outs.append(o)
        lses.append(lse)
    wgt = jax.nn.softmax(jnp.stack(lses, 0), axis=0)
    o = jnp.sum(wgt[..., None] * jnp.stack(outs, 0), axis=0)
    return o.reshape(B, S, N_DIL_HEADS * HEAD_DIM).astype(q.dtype)


def mla_mixer(c_q, c_kv, k_rope, pos, q_norm, w_qb, kv_norm, w_kvb):
    B, S, _ = c_q.shape
    H = N_MLA_HEADS
    q = (rms_norm(c_q, q_norm) @ w_qb).reshape(B, S, H, MLA_NOPE + MLA_ROPE)
    q_nope = q[..., :MLA_NOPE]
    q_pe = rope(q[..., MLA_NOPE:], pos, ROPE_THETA, MLA_ROPE)
    kv = (rms_norm(c_kv, kv_norm) @ w_kvb).reshape(B, S, H, MLA_NOPE + MLA_V)
    k_nope = kv[..., :MLA_NOPE]
    v = kv[..., MLA_NOPE:]
    k_pe = rope(k_rope[:, :, None, :], pos, ROPE_THETA, MLA_ROPE)[:, :, 0]
    scale = (MLA_NOPE + MLA_ROPE) ** -0.5
    nq = S // Q_BLOCK
    qn_b = q_nope.reshape(B, nq, Q_BLOCK, H, MLA_NOPE).transpose(1, 0, 2, 3, 4)
    qp_b = q_pe.reshape(B, nq, Q_BLOCK, H, MLA_ROPE).transpose(1, 0, 2, 3, 4)

    def block(args):
        qn, qp = args
        s = (jnp.einsum('bqhd,bkhd->bhqk', qn, k_nope) + jnp.einsum('bqhr,bkr->bhqk', qp, k_pe)).astype(jnp.float32) * scale
        p = jax.nn.softmax(s, axis=-1).astype(v.dtype)
        return jnp.einsum('bhqk,bkhd->bqhd', p, v)

    o = lax.map(block, (qn_b, qp_b))
    return o.transpose(1, 0, 2, 3, 4).reshape(B, S, H * MLA_V)


def dwconv3(u, w, b):
    S = u.shape[1]
    up = jnp.pad(u, ((0, 0), (1, 1), (0, 0)))
    return up[:, :S] * w[0] + up[:, 1:S + 1] * w[1] + up[:, 2:] * w[2] + b


def trunk(x, c, params):
    S = x.shape[1]
    pos = jnp.arange(S)
    cond = jax.nn.silu(c)
    split_pts = [int(i) for i in np.cumsum(SPLIT_SIZES)[:-1]]
    for l in range(DEPTH):
        (w_ada, b_ada, n_pre_mix, w_in, dec_f, dec_b, w_fmix, q_norm, w_qb, kv_norm, w_kvb,
         w_out, n_post_mix, n_pre_ffn, w_up, conv_w, conv_b, w_down, n_post_ffn) = [p[l] for p in params]
        mod = cond @ w_ada + b_ada
        sh1, sc1, g1, sh2, sc2, g2 = [m[:, None, :] for m in jnp.split(mod, 6, axis=-1)]
        h = rms_norm(x, n_pre_mix) * (1.0 + sc1) + sh1
        z = h @ w_in
        rq, rk, rv, rg, fu, dq, dk, dv, cq, ckv, kr = jnp.split(z, split_pts, axis=-1)
        o = jnp.concatenate([
            retention_mixer(rq, rk, rv, rg, pos, dec_f, dec_b),
            fourier_mixer(fu, w_fmix),
            dilated_mixer(dq, dk, dv, pos),
            mla_mixer(cq, ckv, kr, pos, q_norm, w_qb, kv_norm, w_kvb)], axis=-1)
        x = x + g1 * rms_norm(o @ w_out, n_post_mix)
        h = rms_norm(x, n_pre_ffn) * (1.0 + sc2) + sh2
        u = dwconv3(h @ w_up, conv_w, conv_b)
        a, bu = jnp.split(u, 2, axis=-1)
        x = x + g2 * rms_norm((jax.nn.silu(a) * bu) @ w_down, n_post_ffn)
    return x


def setup_inputs(seed: int = 0) -> dict:
    key = jax.random.key(seed)
    ks = jax.random.split(key, 24)
    f32 = jnp.float32

    def nrm(k, shape, scale):
        return jax.random.normal(k, shape, f32) * scale

    L = DEPTH
    hh = jnp.arange(N_RET_HEADS, dtype=f32)
    decay_init = jnp.log(jnp.power(2.0, 5.0 + hh) - 1.0)
    return {
        'x_prompt': nrm(ks[0], (BATCH, SEQ, D_MODEL), 1.0),
        'x_sample': nrm(ks[1], (DEC_BATCH, DEC_SEQ, D_MODEL), 1.0),
        'c_prompt': nrm(ks[2], (BATCH, D_MODEL), 1.0),
        'c_sample': nrm(ks[3], (DEC_BATCH, D_MODEL), 1.0),
        'w_ada': nrm(ks[4], (L, D_MODEL, 6 * D_MODEL), D_MODEL ** -0.5),
        'b_ada': nrm(ks[5], (L, 6 * D_MODEL), 0.01),
        'norm_pre_mix': 1.0 + nrm(ks[6], (L, D_MODEL), 0.05),
        'w_in': nrm(ks[7], (L, D_MODEL, D_IN), D_MODEL ** -0.5),
        'ret_decay_fwd': decay_init[None] + nrm(ks[8], (L, N_RET_HEADS), 0.1),
        'ret_decay_bwd': decay_init[None] + nrm(ks[9], (L, N_RET_HEADS), 0.1),
        'w_fmix': nrm(ks[10], (L, N_FNET_GROUPS, HEAD_DIM, HEAD_DIM), HEAD_DIM ** -0.5),
        'mla_q_norm': 1.0 + nrm(ks[11], (L, Q_LORA), 0.05),
        'mla_w_qb': nrm(ks[12], (L, Q_LORA, N_MLA_HEADS * (MLA_NOPE + MLA_ROPE)), Q_LORA ** -0.5),
        'mla_kv_norm': 1.0 + nrm(ks[13], (L, KV_LORA), 0.05),
        'mla_w_kvb': nrm(ks[14], (L, KV_LORA, N_MLA_HEADS * (MLA_NOPE + MLA_V)), KV_LORA ** -0.5),
        'w_out': nrm(ks[15], (L, D_MIX, D_MODEL), D_MIX ** -0.5),
        'norm_post_mix': 1.0 + nrm(ks[16], (L, D_MODEL), 0.05),
        'norm_pre_ffn': 1.0 + nrm(ks[17], (L, D_MODEL), 0.05),
        'w_up': nrm(ks[18], (L, D_MODEL, 2 * D_FF), D_MODEL ** -0.5),
        'conv_w': nrm(ks[19], (L, 3, 2 * D_FF), 3 ** -0.5),
        'conv_b': nrm(ks[20], (L, 2 * D_FF), 0.01),
        'w_down': nrm(ks[21], (L, D_FF, D_MODEL), D_FF ** -0.5),
        'norm_post_ffn': 1.0 + nrm(ks[22], (L, D_MODEL), 0.05),
    }


def reference(x_prompt, x_sample, c_prompt, c_sample, w_ada, b_ada, norm_pre_mix, w_in,
              ret_decay_fwd, ret_decay_bwd, w_fmix, mla_q_norm, mla_w_qb, mla_kv_norm, mla_w_kvb,
              w_out, norm_post_mix, norm_pre_ffn, w_up, conv_w, conv_b, w_down, norm_post_ffn):
    params = (w_ada, b_ada, norm_pre_mix, w_in, ret_decay_fwd, ret_decay_bwd, w_fmix,
              mla_q_norm, mla_w_qb, mla_kv_norm, mla_w_kvb, w_out, norm_post_mix,
              norm_pre_ffn, w_up, conv_w, conv_b, w_down, norm_post_ffn)
    y_prompt = trunk(x_prompt, c_prompt, params)
    y_sample = trunk(x_sample, c_sample, params)
    return (y_prompt, y_sample)
```

```cpp
#include <hip/hip_runtime.h>
#include <hip/hip_cooperative_groups.h>
#include <cstdio>
namespace cg = cooperative_groups;

#ifndef MULTI
#define MULTI 1
#endif

#define DI __device__ __forceinline__
typedef unsigned short u16;
typedef __attribute__((ext_vector_type(8))) short bf16x8;
typedef __attribute__((ext_vector_type(4))) float f32x4;

constexpr int NTOK = 81920;
constexpr int ZW = 3744;
constexpr int Z_RQ = 0, Z_RK = 256, Z_RV = 512, Z_RG = 768, Z_DQ = 1024, Z_DK = 1792, Z_DV = 2560, Z_CQ = 3328, Z_CKV = 3584, Z_KR = 3712;
constexpr int DFF = 2816;
constexpr float EPS = 1e-6f;
constexpr float LOG2E = 1.4426950408889634f;
constexpr float LN2 = 0.6931471805599453f;

constexpr size_t OFF_RA = 0;
constexpr size_t OFF_RB = 167772160ull;
constexpr size_t OFF_PQT = OFF_RB + 613416960ull;
constexpr size_t OFF_RS = OFF_RB + 697303040ull;
constexpr size_t OFF_WT = OFF_RS + 83886080ull;
constexpr size_t WT_LAYER = 28639232ull;
constexpr size_t WT_IN = 0, WT_OUT = 8912896ull, WT_UP = 11010048ull, WT_DOWN = 22544384ull, WT_QB = 28311552ull, WT_KVB = 28508160ull;
constexpr size_t OFF_DFT = OFF_WT + 2 * WT_LAYER;
constexpr size_t OFF_TAB = OFF_DFT + 33554432ull;
constexpr size_t OFF_MOD = OFF_TAB + 1835008ull;
constexpr size_t OFF_LSE = OFF_MOD + 1769472ull;
constexpr size_t WS_NEED = OFF_LSE + 3932160ull;
constexpr size_t RA_QM = 0, RA_KB = 62914560ull, RA_VT = 125829120ull;
constexpr size_t RB_H2 = 0, RB_GATED = 167772160ull;

constexpr int DYN_LDS = 73728;

struct Params {
  const float *x_p, *x_s, *c_p, *c_s, *w_ada, *b_ada, *n_pre_mix, *w_in, *dec_f, *dec_b, *w_fmix, *q_norm, *w_qb, *kv_norm,
      *w_kvb, *w_out, *n_post_mix, *n_pre_ffn, *w_up, *conv_w, *conv_b, *w_down, *n_post_ffn;
  float* out;
  char* ws;
  int ph_lo, ph_hi;
};

DI int ltid() { int t = threadIdx.x; asm volatile("" : "+v"(t)); return t; }
DI u16 f2bf(float x) { unsigned u = __float_as_uint(x); u += 0x7fffu + ((u >> 16) & 1u); return (u16)(u >> 16); }
DI float bf2f(unsigned b) { return __uint_as_float(b << 16); }
DI unsigned pack2(float a, float b) { return (unsigned)f2bf(a) | ((unsigned)f2bf(b) << 16); }
DI uint2 pack4(const f32x4& v) { return make_uint2(pack2(v[0], v[1]), pack2(v[2], v[3])); }
DI float blo(unsigned w) { return __uint_as_float(w << 16); }
DI float bhi(unsigned w) { return __uint_as_float(w & 0xffff0000u); }
DI int tok0_of_batch(int bi) { return bi < 4 ? bi * 4096 : 16384 + (bi - 4) * 2048; }
DI void tile_info(int tile, int& bi, int& S, int& pos0) {
  if (tile < 128) { bi = tile >> 5; S = 4096; pos0 = (tile & 31) << 7; }
  else { int t = tile - 128; bi = 4 + (t >> 4); S = 2048; pos0 = (t & 15) << 7; }
}
DI int batch_of_tok(int tok) { return tok < 16384 ? (tok >> 12) : 4 + ((tok - 16384) >> 11); }

template <int TM, int TN>
DI void mma(const u16* sA, int lda, const u16* sB, int ldb, int ksteps, f32x4 (&acc)[TM][TN], int lane) {
  const int r = lane & 15, q = lane >> 4;
  for (int ks = 0; ks < ksteps; ++ks) {
    bf16x8 a[TM], b[TN];
#pragma unroll
    for (int i = 0; i < TM; ++i) a[i] = *(const bf16x8*)(sA + (i * 16 + r) * lda + ks * 32 + q * 8);
#pragma unroll
    for (int i = 0; i < TN; ++i) b[i] = *(const bf16x8*)(sB + (i * 16 + r) * ldb + ks * 32 + q * 8);
#pragma unroll
    for (int i = 0; i < TM; ++i)
#pragma unroll
      for (int j = 0; j < TN; ++j) acc[i][j] = __builtin_amdgcn_mfma_f32_16x16x32_bf16(b[j], a[i], acc[i][j], 0, 0, 0);
  }
}
template <int TM, int TN>
DI void zero_acc(f32x4 (&acc)[TM][TN]) {
#pragma unroll
  for (int i = 0; i < TM; ++i)
#pragma unroll
    for (int j = 0; j < TN; ++j) acc[i][j] = f32x4{0.f, 0.f, 0.f, 0.f};
}

template <class LA, class LB, class EP>
DI void gemm_tile(char* smem, int nk, LA loadA, LB loadB, EP epi) {
  u16* sA = (u16*)smem;
  u16* sB = sA + 128 * 72;
  const int tid = ltid(), lane = tid & 63, w = tid >> 6, wm = w >> 1, wn = w & 1;
  const int lr = tid >> 3, lk = (tid & 7) * 8;
  uint4 ra[4], rb[4];
  f32x4 acc[4][4];
  zero_acc(acc);
#pragma unroll
  for (int i = 0; i < 4; ++i) { ra[i] = loadA(lr + 32 * i, lk); rb[i] = loadB(lr + 32 * i, lk); }
  for (int kt = 0; kt < nk; ++kt) {
    __syncthreads();
#pragma unroll
    for (int i = 0; i < 4; ++i) {
      *(uint4*)(sA + (lr + 32 * i) * 72 + lk) = ra[i];
      *(uint4*)(sB + (lr + 32 * i) * 72 + lk) = rb[i];
    }
    __syncthreads();
    if (kt + 1 < nk) {
#pragma unroll
      for (int i = 0; i < 4; ++i) { ra[i] = loadA(lr + 32 * i, (kt + 1) * 64 + lk); rb[i] = loadB(lr + 32 * i, (kt + 1) * 64 + lk); }
    }
    mma<4, 4>(sA + wm * 64 * 72, 72, sB + wn * 64 * 72, 72, 2, acc, lane);
  }
  epi(acc, wm, wn, lane);
}

DI void rope_pair(f32x4& a, f32x4& b, const float2* tabrow, int q, float sc) {
#pragma unroll
  for (int jj = 0; jj < 4; ++jj) {
    float2 cs = tabrow[q * 4 + jj];
    float x1 = a[jj], x2 = b[jj];
    a[jj] = (x1 * cs.x - x2 * cs.y) * sc;
    b[jj] = (x2 * cs.x + x1 * cs.y) * sc;
  }
}

constexpr int PI_TRL = 3416, PI_TR = 2 * PI_TRL, PI_FOLD = 128, PI_PAD = 2, PI_MOD = 192, PI_DFT = 256, PI_TAB = 256;
constexpr int N_PREP = PI_TR + PI_FOLD + PI_PAD + PI_MOD + PI_DFT + PI_TAB;

DI void tr_tile(char* smem, const float* src, int lds, int k0, int s0, int nvalid, u16* dst, int ldd, int n0, const float* kscale) {
  float* t = (float*)smem;
  const int tid = ltid();
  __syncthreads();
#pragma unroll 4
  for (int i = 0; i < 16; ++i) {
    int kr = (tid >> 6) + 4 * i, c = tid & 63;
    float v = (c < nvalid) ? src[(size_t)(k0 + kr) * lds + s0 + c] : 0.f;
    if (kscale) v *= kscale[k0 + kr];
    t[c * 65 + kr] = v;
  }
  __syncthreads();
#pragma unroll 4
  for (int i = 0; i < 16; ++i) {
    int c = (tid >> 6) + 4 * i, kr = tid & 63;
    if (c < nvalid) dst[(size_t)(n0 + c) * ldd + k0 + kr] = f2bf(t[c * 65 + kr]);
  }
}

DI void ph_prep(const Params& p, int item, char* smem) {
  const int tid = ltid();
  if (item < PI_TR) {
    int layer = item / PI_TRL, it = item % PI_TRL;
    char* wt = p.ws + OFF_WT + layer * WT_LAYER;
    if (it < 1008) {
      int ct = it >> 4, kt = it & 15;
      if (ct >= 16 && ct < 20) return;
      int s0 = ct * 64, n0 = s0 < 1024 ? s0 + 512 : s0 + 256;
      int nv = 4000 - s0 < 64 ? 4000 - s0 : 64;
      tr_tile(smem, p.w_in + (size_t)layer * 1024 * 4000, 4000, kt * 64, s0, nv, (u16*)(wt + WT_IN), 1024, n0, nullptr);
      return;
    }
    it -= 1008;
    if (it < 256) { tr_tile(smem, p.w_out + (size_t)layer * 1024 * 1024, 1024, (it & 15) * 64, (it >> 4) * 64, 64, (u16*)(wt + WT_OUT), 1024, (it >> 4) * 64, nullptr); return; }
    it -= 256;
    if (it < 1408) { tr_tile(smem, p.w_up + (size_t)layer * 1024 * 5632, 5632, (it & 15) * 64, (it >> 4) * 64, 64, (u16*)(wt + WT_UP), 1024, (it >> 4) * 64, nullptr); return; }
    it -= 1408;
    if (it < 704) { int kt = it % 44, ct = it / 44; tr_tile(smem, p.w_down + (size_t)layer * 2816 * 1024, 1024, kt * 64, ct * 64, 64, (u16*)(wt + WT_DOWN), 2816, ct * 64, nullptr); return; }
    it -= 704;
    if (it < 24) { int kt = it & 3, ct = it >> 2; tr_tile(smem, p.w_qb + (size_t)layer * 256 * 384, 384, kt * 64, ct * 64, 64, (u16*)(wt + WT_QB), 256, ct * 64, p.q_norm + layer * 256); return; }
    it -= 24;
    { int kt = it & 1, ct = it >> 1; tr_tile(smem, p.w_kvb + (size_t)layer * 128 * 512, 512, kt * 64, ct * 64, 64, (u16*)(wt + WT_KVB), 128, ct * 64, p.kv_norm + layer * 128); return; }
  }
  item -= PI_TR;
  if (item < PI_FOLD) {
    int layer = item >> 6, g = (item >> 4) & 3, cs = (item >> 3) & 1, kc = item & 7;
    float* M = (float*)smem;
    float* ct = M + 4096;
    __syncthreads();
    if (tid < 64) ct[tid] = cospif((float)tid / 32.f);
    __syncthreads();
    const float* Wf = p.w_fmix + ((size_t)layer * 4 + g) * 4096;
    for (int i = 0; i < 16; ++i) {
      int idx = tid + 256 * i, c = idx >> 6, e = idx & 63;
      float a = 0.f;
      for (int c2 = 0; c2 < 64; ++c2) {
        int x = (c * c2) & 63;
        float tv = cs ? ct[(x - 16) & 63] : ct[x];
        a += tv * Wf[c2 * 64 + e];
      }
      M[c * 64 + e] = a;
    }
    __syncthreads();
    const float* W = p.w_in + (size_t)layer * 1024 * 4000 + 1024 + g * 64;
    u16* dst = (u16*)(p.ws + OFF_WT + layer * WT_LAYER + WT_IN);
    int e = tid & 63, kq = tid >> 6;
    for (int i = 0; i < 32; ++i) {
      int k = kc * 128 + kq * 32 + i;
      float a = 0.f;
#pragma unroll 8
      for (int c = 0; c < 64; ++c) a += W[(size_t)k * 4000 + c] * M[c * 64 + e];
      dst[(size_t)(cs * 256 + g * 64 + e) * 1024 + k] = f2bf(a);
    }
    return;
  }
  item -= PI_FOLD;
  if (item < PI_PAD) {
    uint4* dst = (uint4*)(p.ws + OFF_WT + item * WT_LAYER + WT_IN + (size_t)4256 * 1024 * 2);
    for (int i = tid; i < 96 * 1024 * 2 / 16; i += 256) dst[i] = make_uint4(0, 0, 0, 0);
    return;
  }
  item -= PI_PAD;
  if (item < PI_MOD) {
    int layer = item / 96, cb = item % 96;
    float* sC = (float*)smem;
    float* sR = sC + 4608;
    int col = cb * 64 + (tid & 63), kq = tid >> 6;
    float acc[36];
#pragma unroll
    for (int b = 0; b < 36; ++b) acc[b] = 0.f;
    const float* wa = p.w_ada + (size_t)layer * 1024 * 6144;
#pragma unroll 1
    for (int kc = 0; kc < 8; ++kc) {
      __syncthreads();
#pragma unroll 2
      for (int i = 0; i < 18; ++i) {
        int idx = tid + 256 * i, qq = idx / 1152, rem = idx % 1152, b = rem >> 5, kk = rem & 31;
        int k = qq * 256 + kc * 32 + kk;
        float c = b < 4 ? p.c_p[b * 1024 + k] : p.c_s[(b - 4) * 1024 + k];
        sC[idx] = c / (1.f + __expf(-c));
      }
      __syncthreads();
#pragma unroll 2
      for (int kk = 0; kk < 32; ++kk) {
        float wv = wa[(size_t)(kq * 256 + kc * 32 + kk) * 6144 + col];
#pragma unroll
        for (int b = 0; b < 36; ++b) acc[b] += sC[(kq * 36 + b) * 32 + kk] * wv;
      }
    }
    __syncthreads();
#pragma unroll
    for (int b = 0; b < 36; ++b) sR[(kq * 36 + b) * 64 + (tid & 63)] = acc[b];
    __syncthreads();
    float* mod = (float*)(p.ws + OFF_MOD) + (size_t)layer * 36 * 6144;
    for (int i = 0; i < 9; ++i) {
      int idx = tid + 256 * i, b = idx >> 6, c = idx & 63;
      float s = sR[(0 * 36 + b) * 64 + c] + sR[(1 * 36 + b) * 64 + c] + sR[(2 * 36 + b) * 64 + c] + sR[(3 * 36 + b) * 64 + c];
      mod[b * 6144 + cb * 64 + c] = s + p.b_ada[layer * 6144 + cb * 64 + c];
    }
    return;
  }
  item -= PI_MOD;
  if (item < PI_DFT) {
    float* tab = (float*)smem;
    __syncthreads();
    for (int i = tid; i < 4096; i += 256) tab[i] = cospif((float)i / 2048.f);
    __syncthreads();
    u16* dft = (u16*)(p.ws + OFF_DFT);
    for (int rr = 0; rr < 16; ++rr) {
      int j = item * 16 + rr;
      for (int i = 0; i < 2; ++i) {
        int ch = tid + 256 * i;
        int kb = (ch & 255) * 8;
        bool sn = ch >= 256;
        unsigned wv[4];
#pragma unroll
        for (int e = 0; e < 8; e += 2) {
          int i0 = (j * (kb + e)) & 4095, i1 = (j * (kb + e + 1)) & 4095;
          float v0 = sn ? -tab[(i0 - 1024) & 4095] : tab[i0];
          float v1 = sn ? -tab[(i1 - 1024) & 4095] : tab[i1];
          wv[e >> 1] = pack2(v0, v1);
        }
        *(uint4*)(dft + (size_t)j * 4096 + ch * 8) = make_uint4(wv[0], wv[1], wv[2], wv[3]);
      }
    }
    return;
  }
  item -= PI_DFT;
  {
    float2* tab = (float2*)(p.ws + OFF_TAB);
    for (int idx = tid; idx < 896; idx += 256) {
      int pos = item * 16 + idx / 56, a = idx % 56;
      float inv;
      if (a < 16) inv = powf(500000.f, -(float)a * 2.f / 32.f);
      else if (a < 24) inv = powf(500000.f, -(float)(a - 16) * 2.f / 16.f);
      else inv = powf(10000.f, -(float)(a - 24) * 2.f / 64.f);
      float ang = (float)pos * inv;
      float s, c;
      sincosf(ang, &s, &c);
      tab[pos * 56 + a] = make_float2(c, s);
    }
  }
}

DI void ph_ew(const Params& p, int item, int mode, int layer) {
  const int tid = ltid(), lane = tid & 63, w = tid >> 6;
  const float* mod = (const float*)(p.ws + OFF_MOD);
  for (int i = 0; i < 4; ++i) {
    int tok = item * 16 + w * 4 + i;
    int bi = batch_of_tok(tok);
    const float* xin;
    if (mode == 0 || (mode == 1 && layer == 0)) xin = tok < 16384 ? p.x_p + (size_t)tok * 1024 : p.x_s + (size_t)(tok - 16384) * 1024;
    else xin = p.out + (size_t)tok * 1024;
    float x[16];
#pragma unroll
    for (int h2 = 0; h2 < 2; ++h2) {
      const float4* xp = (const float4*)(xin + lane * 8 + 512 * h2);
      float4 a = xp[0], b = xp[1];
      x[h2 * 8 + 0] = a.x; x[h2 * 8 + 1] = a.y; x[h2 * 8 + 2] = a.z; x[h2 * 8 + 3] = a.w;
      x[h2 * 8 + 4] = b.x; x[h2 * 8 + 5] = b.y; x[h2 * 8 + 6] = b.z; x[h2 * 8 + 7] = b.w;
    }
    if (mode != 0) {
      const u16* y = (const u16*)(p.ws + OFF_RA) + (size_t)tok * 1024;
      float yv[16];
      float ss = 0.f;
#pragma unroll
      for (int h2 = 0; h2 < 2; ++h2) {
        uint4 v = *(const uint4*)(y + lane * 8 + 512 * h2);
        unsigned wv[4] = {v.x, v.y, v.z, v.w};
#pragma unroll
        for (int e = 0; e < 4; ++e) { yv[h2 * 8 + 2 * e] = blo(wv[e]); yv[h2 * 8 + 2 * e + 1] = bhi(wv[e]); }
      }
#pragma unroll
      for (int e = 0; e < 16; ++e) ss += yv[e] * yv[e];
#pragma unroll
      for (int o = 1; o < 64; o <<= 1) ss += __shfl_xor(ss, o);
      float rs = rsqrtf(ss * (1.f / 1024.f) + EPS);
      const float* npost = (mode == 1 ? p.n_post_mix : p.n_post_ffn) + layer * 1024;
      const float* g = mod + ((size_t)layer * 36 + bi) * 6144 + (mode == 1 ? 2048 : 5120);
#pragma unroll
      for (int h2 = 0; h2 < 2; ++h2)
#pragma unroll
        for (int e = 0; e < 8; ++e) {
          int c = lane * 8 + 512 * h2 + e;
          x[h2 * 8 + e] += g[c] * (yv[h2 * 8 + e] * rs * npost[c]);
        }
      float* xo = p.out + (size_t)tok * 1024;
#pragma unroll
      for (int h2 = 0; h2 < 2; ++h2) {
        float4* op = (float4*)(xo + lane * 8 + 512 * h2);
        op[0] = make_float4(x[h2 * 8 + 0], x[h2 * 8 + 1], x[h2 * 8 + 2], x[h2 * 8 + 3]);
        op[1] = make_float4(x[h2 * 8 + 4], x[h2 * 8 + 5], x[h2 * 8 + 6], x[h2 * 8 + 7]);
      }
    }
    if (mode == 2 && layer == 1) continue;
    int nl = mode == 2 ? layer + 1 : layer;
    const float* npre = (mode == 1 ? p.n_pre_ffn : p.n_pre_mix) + nl * 1024;
    const float* mb = mod + ((size_t)nl * 36 + bi) * 6144 + (mode == 1 ? 3072 : 0);
    float ss = 0.f;
#pragma unroll
    for (int e = 0; e < 16; ++e) ss += x[e] * x[e];
#pragma unroll
    for (int o = 1; o < 64; o <<= 1) ss += __shfl_xor(ss, o);
    float rs = rsqrtf(ss * (1.f / 1024.f) + EPS);
    u16* hd = (mode == 1 ? (u16*)(p.ws + OFF_RB + RB_H2) : (u16*)(p.ws + OFF_RA)) + (size_t)tok * 1024;
#pragma unroll
    for (int h2 = 0; h2 < 2; ++h2) {
      unsigned wv[4];
#pragma unroll
      for (int e = 0; e < 8; e += 2) {
        int c = lane * 8 + 512 * h2 + e;
        float v0 = x[h2 * 8 + e] * rs * npre[c] * (1.f + mb[1024 + c]) + mb[c];
        float v1 = x[h2 * 8 + e + 1] * rs * npre[c + 1] * (1.f + mb[1024 + c + 1]) + mb[c + 1];
        wv[e >> 1] = pack2(v0, v1);
      }
      *(uint4*)(hd + lane * 8 + 512 * h2) = make_uint4(wv[0], wv[1], wv[2], wv[3]);
    }
  }
}

DI void ph_win(const Params& p, int item, int layer, char* smem) {
  const int nt = item % 34, tile = item / 34;
  int bi, S, pos0;
  tile_info(tile, bi, S, pos0);
  const u16* h = (const u16*)(p.ws + OFF_RA) + (size_t)tile * 128 * 1024;
  const u16* wt = (const u16*)(p.ws + OFF_WT + layer * WT_LAYER + WT_IN) + (size_t)nt * 128 * 1024;
  u16* z = (u16*)(p.ws + OFF_RB);
  u16* pqt = (u16*)(p.ws + OFF_PQT) + (size_t)tok0_of_batch(bi) * 512;
  const float2* tab = (const float2*)(p.ws + OFF_TAB);
  auto la = [&](int row, int k) { return *(const uint4*)(h + (size_t)row * 1024 + k); };
  auto lb = [&](int n, int k) { return *(const uint4*)(wt + (size_t)n * 1024 + k); };
  auto epi = [&](f32x4 (&acc)[4][4], int wm, int wn, int lane) {
    const int r = lane & 15, q = lane >> 4;
    const int nw0 = nt * 128 + wn * 64;
    const int zc0 = nw0 - 512;
    if (nt >= 4 && zc0 >= ZW) return;
#pragma unroll
    for (int tm = 0; tm < 4; ++tm) {
      int m = wm * 64 + tm * 16 + r;
      int pos = pos0 + m;
      size_t tok = (size_t)tile * 128 + m;
      if (nt < 4) {
#pragma unroll
        for (int tn = 0; tn < 4; ++tn)
#pragma unroll
          for (int jj = 0; jj < 4; ++jj) {
            int n = nw0 + tn * 16 + q * 4 + jj;
            pqt[(size_t)n * S + pos] = f2bf(acc[tm][tn][jj]);
          }
        continue;
      }
      const float2* tr = tab + pos * 56;
      if (zc0 < 512) {
        float sc = zc0 >= 256 ? 0.125f : 1.f;
        rope_pair(acc[tm][0], acc[tm][2], tr + 24, q, sc);
        rope_pair(acc[tm][1], acc[tm][3], tr + 24 + 16, q, sc);
      } else if (zc0 >= Z_DQ && zc0 < Z_DV) {
        float sc = zc0 < Z_DK ? 0.125f * LOG2E : 1.f;
#pragma unroll
        for (int jj = 0; jj < 4; ++jj) {
          float2 cs = tr[16 + (q & 1) * 4 + jj];
          float v = acc[tm][0][jj];
          float o = __shfl_xor(v, 32);
          acc[tm][0][jj] = q < 2 ? v * cs.x - o * cs.y : v * cs.x + o * cs.y;
        }
#pragma unroll
        for (int tn = 0; tn < 4; ++tn)
#pragma unroll
          for (int jj = 0; jj < 4; ++jj) acc[tm][tn][jj] *= sc;
      } else if (zc0 == Z_KR) {
        rope_pair(acc[tm][0], acc[tm][1], tr, q, 1.f);
      }
      u16* zr = z + tok * ZW + zc0 + q * 4;
      *(uint2*)(zr) = pack4(acc[tm][0]);
      *(uint2*)(zr + 16) = pack4(acc[tm][1]);
      if (zc0 != Z_KR) {
        *(uint2*)(zr + 32) = pack4(acc[tm][2]);
        *(uint2*)(zr + 48) = pack4(acc[tm][3]);
      }
    }
  };
  gemm_tile(smem, 16, la, lb, epi);
}

constexpr int N_DIL = 15360, N_QP = 1920, N_KVP = 2560, N_RST = 2560, N_PQF = 2304;
constexpr int N_P2 = N_DIL + N_QP + N_KVP + N_RST + N_PQF;

DI void ph_dil(const Params& p, int item, char* smem) {
  int bi, rem, nbt, S;
  if (item < 3072) { bi = item / 768; rem = item % 768; nbt = 64; S = 4096; }
  else { int it = item - 3072; bi = 4 + it / 384; rem = it % 384; nbt = 32; S = 2048; }
  const int gh = rem / nbt, blk = rem % nbt, g = gh >> 2, hd = gh & 3, dil = 1 << (2 * g), L = S / dil, nblk = L >> 6;
  const int r = blk / nblk, nb = blk % nblk;
  const size_t tokb = tok0_of_batch(bi);
  u16* z = (u16*)(p.ws + OFF_RB);
  u16* sQ = (u16*)smem;
  u16* sK = sQ + 64 * 72;
  u16* sVT = sK + 192 * 72;
  u16* sP = sK;
  const int tid = ltid(), lane = tid & 63, w = tid >> 6;
  const int colq = Z_DQ + g * 256 + hd * 64, colk = Z_DK + g * 256 + hd * 64, colv = Z_DV + g * 256 + hd * 64;
  __syncthreads();
#pragma unroll
  for (int i = 0; i < 2; ++i) {
    int c = tid + 256 * i, row = c >> 3, kc = (c & 7) * 8;
    int pos = r + dil * (nb * 64 + row);
    *(uint4*)(sQ + row * 72 + kc) = *(const uint4*)(z + (tokb + pos) * ZW + colq + kc);
  }
#pragma unroll
  for (int i = 0; i < 6; ++i) {
    int c = tid + 256 * i, row = c >> 3, kc = (c & 7) * 8;
    int t = nb * 64 - 64 + row;
    uint4 v = make_uint4(0, 0, 0, 0);
    if (t >= 0 && t < L) v = *(const uint4*)(z + (tokb + r + dil * t) * ZW + colk + kc);
    *(uint4*)(sK + row * 72 + kc) = v;
  }
#pragma unroll
  for (int i = 0; i < 6; ++i) {
    int c = tid + 256 * i, row = c % 192, kc = (c / 192) * 8;
    int t = nb * 64 - 64 + row;
    uint4 v = make_uint4(0, 0, 0, 0);
    if (t >= 0 && t < L) v = *(const uint4*)(z + (tokb + r + dil * t) * ZW + colv + kc);
    unsigned wv[4] = {v.x, v.y, v.z, v.w};
#pragma unroll
    for (int e = 0; e < 8; ++e) sVT[(kc + e) * 200 + row] = (u16)((wv[e >> 1] >> ((e & 1) * 16)) & 0xffffu);
  }
  __syncthreads();
  f32x4 s[1][12];
  zero_acc(s);
  mma<1, 12>(sQ + w * 16 * 72, 72, sK, 72, 2, s, lane);
  const int qq = w * 16 + (lane & 15), q4 = lane >> 4;
  float mx = -1e30f;
#pragma unroll
  for (int tn = 0; tn < 12; ++tn)
#pragma unroll
    for (int jj = 0; jj < 4; ++jj) {
      int kk = tn * 16 + q4 * 4 + jj, t = nb * 64 - 64 + kk;
      bool ok = kk >= qq && kk <= qq + 128 && t >= 0 && t < L;
      float v = ok ? s[0][tn][jj] : -1e30f;
      s[0][tn][jj] = v;
      mx = fmaxf(mx, v);
    }
  mx = fmaxf(mx, __shfl_xor(mx, 16));
  mx = fmaxf(mx, __shfl_xor(mx, 32));
  float den = 0.f;
#pragma unroll
  for (int tn = 0; tn < 12; ++tn)
#pragma unroll
    for (int jj = 0; jj < 4; ++jj) {
      float pv = exp2f(s[0][tn][jj] - mx);
      den += pv;
      s[0][tn][jj] = pv;
    }
  den += __shfl_xor(den, 16);
  den += __shfl_xor(den, 32);
  __syncthreads();
#pragma unroll
  for (int tn = 0; tn < 12; ++tn) *(uint2*)(sP + qq * 200 + tn * 16 + q4 * 4) = pack4(s[0][tn]);
  __syncthreads();
  f32x4 o[1][4];
  zero_acc(o);
  mma<1, 4>(sP + w * 16 * 200, 200, sVT, 200, 6, o, lane);
  const float inv = 1.f / den;
  const size_t tok = tokb + r + dil * (nb * 64 + qq);
#pragma unroll
  for (int tn = 0; tn < 4; ++tn) {
    f32x4 v = o[0][tn];
    v[0] *= inv; v[1] *= inv; v[2] *= inv; v[3] *= inv;
    *(uint2*)(z + tok * ZW + colq + tn * 16 + q4 * 4) = pack4(v);
  }
  if (q4 == 0) ((float*)(p.ws + OFF_LSE))[((size_t)g * NTOK + tok) * 4 + hd] = (mx + log2f(den)) * LN2;
}

DI void row_rstd(float* sR, const u16* base, int ncols) {
  const int tid = ltid(), row = tid >> 1, half = tid & 1;
  const u16* b = base + (size_t)row * ZW + half * (ncols >> 1);
  float ss = 0.f;
  for (int c = 0; c < (ncols >> 4); ++c) {
    uint4 v = *(const uint4*)(b + c * 8);
    unsigned wv[4] = {v.x, v.y, v.z, v.w};
#pragma unroll
    for (int e = 0; e < 4; ++e) { float a = blo(wv[e]), d = bhi(wv[e]); ss += a * a + d * d; }
  }
  ss += __shfl_xor(ss, 1);
  if (half == 0) sR[row] = rsqrtf(ss / (float)ncols + EPS);
}

DI void ph_qproj(const Params& p, int item, int layer, char* smem) {
  const int nt = item % 3, tile = item / 3;
  int bi, S, pos0;
  tile_info(tile, bi, S, pos0);
  const u16* z = (const u16*)(p.ws + OFF_RB) + (size_t)tile * 128 * ZW;
  const u16* wt = (const u16*)(p.ws + OFF_WT + layer * WT_LAYER + WT_QB) + (size_t)nt * 128 * 256;
  u16* qm = (u16*)(p.ws + OFF_RA + RA_QM);
  const float2* tab = (const float2*)(p.ws + OFF_TAB);
  float* sR = (float*)(smem + 36864);
  __syncthreads();
  row_rstd(sR, z + Z_CQ, 256);
  auto la = [&](int row, int k) { return *(const uint4*)(z + (size_t)row * ZW + Z_CQ + k); };
  auto lb = [&](int n, int k) { return *(const uint4*)(wt + (size_t)n * 256 + k); };
  auto epi = [&](f32x4 (&acc)[4][4], int wm, int wn, int lane) {
    const int r = lane & 15, q = lane >> 4;
    const int nw0 = nt * 128 + wn * 64;
    const float QS = 0.10206207261596575f * LOG2E;
#pragma unroll
    for (int tm = 0; tm < 4; ++tm) {
      int m = wm * 64 + tm * 16 + r;
      int pos = pos0 + m;
      size_t tok = (size_t)tile * 128 + m;
      float rs = sR[m] * QS;
#pragma unroll
      for (int tn = 0; tn < 4; ++tn)
#pragma unroll
        for (int jj = 0; jj < 4; ++jj) acc[tm][tn][jj] *= rs;
      const float2* tr = tab + pos * 56;
      if (nw0 == 64 || nw0 == 256) rope_pair(acc[tm][0], acc[tm][1], tr, q, 1.f);
      else if (nw0 == 128 || nw0 == 320) rope_pair(acc[tm][2], acc[tm][3], tr, q, 1.f);
      u16* d = qm + tok * 384 + nw0 + q * 4;
#pragma unroll
      for (int tn = 0; tn < 4; ++tn) *(uint2*)(d + tn * 16) = pack4(acc[tm][tn]);
    }
  };
  gemm_tile(smem, 4, la, lb, epi);
}

DI void ph_kvproj(const Params& p, int item, int layer, char* smem) {
  const int nt = item & 3, tile = item >> 2;
  int bi, S, pos0;
  tile_info(tile, bi, S, pos0);
  const u16* z = (const u16*)(p.ws + OFF_RB) + (size_t)tile * 128 * ZW;
  const u16* wt = (const u16*)(p.ws + OFF_WT + layer * WT_LAYER + WT_KVB) + (size_t)nt * 128 * 128;
  u16* kb = (u16*)(p.ws + OFF_RA + RA_KB);
  u16* vt = (u16*)(p.ws + OFF_RA + RA_VT) + (size_t)tok0_of_batch(bi) * 256;
  float* sR = (float*)(smem + 36864);
  __syncthreads();
  row_rstd(sR, z + Z_CKV, 128);
  auto la = [&](int row, int k) { return *(const uint4*)(z + (size_t)row * ZW + Z_CKV + k); };
  auto lb = [&](int n, int k) { return *(const uint4*)(wt + (size_t)n * 128 + k); };
  auto epi = [&](f32x4 (&acc)[4][4], int wm, int wn, int lane) {
    const int r = lane & 15, q = lane >> 4;
#pragma unroll
    for (int tm = 0; tm < 4; ++tm) {
      int m = wm * 64 + tm * 16 + r;
      int pos = pos0 + m;
      size_t tok = (size_t)tile * 128 + m;
      float rs = sR[m];
#pragma unroll
      for (int tn = 0; tn < 4; ++tn)
#pragma unroll
        for (int jj = 0; jj < 4; ++jj) acc[tm][tn][jj] *= rs;
      if (wn == 0) {
        u16* d = kb + tok * 384 + nt * 96 + q * 4;
#pragma unroll
        for (int tn = 0; tn < 4; ++tn) *(uint2*)(d + tn * 16) = pack4(acc[tm][tn]);
      } else {
#pragma unroll
        for (int tn = 0; tn < 4; ++tn)
#pragma unroll
          for (int jj = 0; jj < 4; ++jj) vt[(size_t)(nt * 64 + tn * 16 + q * 4 + jj) * S + pos] = f2bf(acc[tm][tn][jj]);
      }
    }
    if (wn == 0) {
      int m = wm * 64 + lane;
      size_t tok = (size_t)tile * 128 + m;
      const uint4* src = (const uint4*)(z + (size_t)m * ZW + Z_KR);
      uint4* dst = (uint4*)(kb + tok * 384 + nt * 96 + 64);
#pragma unroll
      for (int e = 0; e < 4; ++e) dst[e] = src[e];
    }
  };
  gemm_tile(smem, 2, la, lb, epi);
}

DI float logsig(float x) { return -log1pf(expf(-x)); }

DI void ph_retstate(const Params& p, int item, int layer, char* smem) {
  const int hd = item & 3, tile = item >> 2;
  const u16* z = (const u16*)(p.ws + OFF_RB) + (size_t)tile * 128 * ZW;
  u16* sKf = (u16*)smem;
  u16* sKb = sKf + 64 * 136;
  u16* sVT = sKb + 64 * 136;
  const int tid = ltid(), lane = tid & 63, w = tid >> 6;
  const float lf = logsig(p.dec_f[layer * 4 + hd]), lb = logsig(p.dec_b[layer * 4 + hd]);
  __syncthreads();
#pragma unroll
  for (int i = 0; i < 4; ++i) {
    int c = tid + 256 * i, j = c & 127, kc = (c >> 7) * 8;
    uint4 kv = *(const uint4*)(z + (size_t)j * ZW + Z_RK + hd * 64 + kc);
    uint4 vv = *(const uint4*)(z + (size_t)j * ZW + Z_RV + hd * 64 + kc);
    unsigned kw[4] = {kv.x, kv.y, kv.z, kv.w}, vw[4] = {vv.x, vv.y, vv.z, vv.w};
    float df = __expf((float)(127 - j) * lf), db = __expf((float)j * lb);
#pragma unroll
    for (int e = 0; e < 8; ++e) {
      float kx = (e & 1) ? bhi(kw[e >> 1]) : blo(kw[e >> 1]);
      sKf[(kc + e) * 136 + j] = f2bf(kx * df);
      sKb[(kc + e) * 136 + j] = f2bf(kx * db);
      sVT[(kc + e) * 136 + j] = (u16)((vw[e >> 1] >> ((e & 1) * 16)) & 0xffffu);
    }
  }
  __syncthreads();
  const int dir = w >> 1, eh = w & 1;
  f32x4 acc[2][4];
  zero_acc(acc);
  mma<2, 4>(sVT + eh * 32 * 136, 136, dir ? sKb : sKf, 136, 4, acc, lane);
  float* rs = (float*)(p.ws + OFF_RS) + ((size_t)item * 2 + dir) * 4096;
  const int r = lane & 15, q = lane >> 4;
#pragma unroll
  for (int tm = 0; tm < 2; ++tm)
#pragma unroll
    for (int tn = 0; tn < 4; ++tn) {
      int e = eh * 32 + tm * 16 + r, d = tn * 16 + q * 4;
      *(float4*)(rs + e * 64 + d) = make_float4(acc[tm][tn][0], acc[tm][tn][1], acc[tm][tn][2], acc[tm][tn][3]);
    }
}

DI void ph_pqfold(const Params& p, int item) {
  const int bi = item >> 6, cg8 = item & 63;
  const int S = bi < 4 ? 4096 : 2048;
  u16* pq = (u16*)(p.ws + OFF_PQT) + (size_t)tok0_of_batch(bi) * 512;
  for (int rr = 0; rr < 8; ++rr) {
    int row = cg8 * 8 + rr;
    u16* rp = pq + (size_t)row * S;
    float sgn = row < 256 ? 1.f : -1.f;
    for (int k = 1 + ltid(); k < S / 2; k += 256) {
      float a = bf2f(rp[k]), b = bf2f(rp[S - k]);
      rp[k] = f2bf(a + sgn * b);
    }
  }
}

constexpr int N_MLA = 2560, N_FG = 1280, N_SCAN = 1152, N_COMB = 640;
constexpr int N_P3 = N_MLA + N_FG + N_SCAN + N_COMB;

DI void mla_softmax(f32x4 (&s)[4], f32x4 (&o)[4], float& mrun, float& lrun, u16* sProw) {
  float mx = -1e30f;
#pragma unroll
  for (int tn = 0; tn < 4; ++tn)
#pragma unroll
    for (int jj = 0; jj < 4; ++jj) mx = fmaxf(mx, s[tn][jj]);
  mx = fmaxf(mx, __shfl_xor(mx, 16));
  mx = fmaxf(mx, __shfl_xor(mx, 32));
  float mn = fmaxf(mrun, mx);
  float alpha = exp2f(mrun - mn);
  mrun = mn;
  float ps = 0.f;
#pragma unroll
  for (int tn = 0; tn < 4; ++tn) {
#pragma unroll
    for (int jj = 0; jj < 4; ++jj) { float pv = exp2f(s[tn][jj] - mn); ps += pv; s[tn][jj] = pv; }
    *(uint2*)(sProw + tn * 16) = pack4(s[tn]);
  }
  lrun = lrun * alpha + ps;
#pragma unroll
  for (int tn = 0; tn < 4; ++tn)
#pragma unroll
    for (int jj = 0; jj < 4; ++jj) o[tn][jj] *= alpha;
}

DI void ph_mla(const Params& p, int item, char* smem) {
  int bi, hd, qb, S;
  if (item < 512) { bi = item >> 7; hd = (item >> 5) & 3; qb = item & 31; S = 4096; }
  else { int it = item - 512; bi = 4 + (it >> 6); hd = (it >> 4) & 3; qb = it & 15; S = 2048; }
  const size_t tokb = tok0_of_batch(bi);
  const u16* qm = (const u16*)(p.ws + OFF_RA + RA_QM) + (tokb + qb * 128) * 384 + hd * 96;
  const u16* kb = (const u16*)(p.ws + OFF_RA + RA_KB) + tokb * 384 + hd * 96;
  const u16* vt = (const u16*)(p.ws + OFF_RA + RA_VT) + tokb * 256 + (size_t)hd * 64 * S;
  u16* z = (u16*)(p.ws + OFF_RB);
  u16* sQ = (u16*)smem;
  u16* sK = sQ + 128 * 104;
  u16* sVT = sK + 64 * 104;
  u16* sP = sVT + 64 * 72;
  const int tid = ltid(), lane = tid & 63, w = tid >> 6, r = lane & 15, q4 = lane >> 4;
  __syncthreads();
#pragma unroll
  for (int i = 0; i < 6; ++i) {
    int c = tid + 256 * i, row = c / 12, kc = (c % 12) * 8;
    *(uint4*)(sQ + row * 104 + kc) = *(const uint4*)(qm + (size_t)row * 384 + kc);
  }
  const int kr0 = tid / 12, kc0 = (tid % 12) * 8, kr1 = (tid + 256) / 12, kc1 = ((tid + 256) % 12) * 8, kr2 = (tid + 512) / 12, kc2 = ((tid + 512) % 12) * 8;
  const int vr0 = tid >> 3, vc0 = (tid & 7) * 8, vr1 = vr0 + 32;
  uint4 rk0, rk1, rk2, rv0, rv1;
  rk0 = *(const uint4*)(kb + (size_t)kr0 * 384 + kc0);
  rk1 = *(const uint4*)(kb + (size_t)kr1 * 384 + kc1);
  rk2 = *(const uint4*)(kb + (size_t)kr2 * 384 + kc2);
  rv0 = *(const uint4*)(vt + (size_t)vr0 * S + vc0);
  rv1 = *(const uint4*)(vt + (size_t)vr1 * S + vc0);
  f32x4 o[2][4];
  zero_acc(o);
  float m0 = -1e30f, m1 = -1e30f, l0 = 0.f, l1 = 0.f;
  const int nkt = S >> 6;
  for (int kt = 0; kt < nkt; ++kt) {
    __syncthreads();
    *(uint4*)(sK + kr0 * 104 + kc0) = rk0;
    *(uint4*)(sK + kr1 * 104 + kc1) = rk1;
    *(uint4*)(sK + kr2 * 104 + kc2) = rk2;
    *(uint4*)(sVT + vr0 * 72 + vc0) = rv0;
    *(uint4*)(sVT + vr1 * 72 + vc0) = rv1;
    __syncthreads();
    if (kt + 1 < nkt) {
      const u16* kb2 = kb + (size_t)(kt + 1) * 64 * 384;
      rk0 = *(const uint4*)(kb2 + (size_t)kr0 * 384 + kc0);
      rk1 = *(const uint4*)(kb2 + (size_t)kr1 * 384 + kc1);
      rk2 = *(const uint4*)(kb2 + (size_t)kr2 * 384 + kc2);
      rv0 = *(const uint4*)(vt + (size_t)vr0 * S + (kt + 1) * 64 + vc0);
      rv1 = *(const uint4*)(vt + (size_t)vr1 * S + (kt + 1) * 64 + vc0);
    }
    f32x4 s[2][4];
    zero_acc(s);
    mma<2, 4>(sQ + w * 32 * 104, 104, sK, 104, 3, s, lane);
    mla_softmax(s[0], o[0], m0, l0, sP + (w * 32 + r) * 72 + q4 * 4);
    mla_softmax(s[1], o[1], m1, l1, sP + (w * 32 + 16 + r) * 72 + q4 * 4);
    __syncthreads();
    mma<2, 4>(sP + w * 32 * 72, 72, sVT, 72, 2, o, lane);
  }
#pragma unroll
  for (int tm = 0; tm < 2; ++tm) {
    float l = tm ? l1 : l0;
    l += __shfl_xor(l, 16);
    l += __shfl_xor(l, 32);
    float inv = 1.f / l;
    size_t tok = tokb + qb * 128 + w * 32 + tm * 16 + r;
#pragma unroll
    for (int tn = 0; tn < 4; ++tn) {
      f32x4 v = o[tm][tn];
      v[0] *= inv; v[1] *= inv; v[2] *= inv; v[3] *= inv;
      *(uint2*)(z + tok * ZW + Z_CQ + hd * 64 + tn * 16 + q4 * 4) = pack4(v);
    }
  }
}

DI void ph_fgemm(const Params& p, int item, char* smem) {
  int bi, mt, nt, S;
  if (item < 256) { bi = item >> 6; mt = (item >> 1) & 31; nt = item & 1; S = 4096; }
  else { int it = item - 256; bi = 4 + (it >> 5); mt = (it >> 1) & 15; nt = it & 1; S = 2048; }
  const size_t tokb = tok0_of_batch(bi);
  const int H = S >> 1;
  const int rmul = S == 4096 ? 1 : 2;
  const u16* dft = (const u16*)(p.ws + OFF_DFT);
  const u16* pq = (const u16*)(p.ws + OFF_PQT) + tokb * 512;
  u16* z = (u16*)(p.ws + OFF_RB);
  auto la = [&](int row, int k) {
    int j = (mt * 128 + row) * rmul;
    int kk = k < H ? k : 2048 + (k - H);
    return *(const uint4*)(dft + (size_t)j * 4096 + kk);
  };
  auto lb = [&](int n, int k) {
    int c = nt * 128 + n;
    return k < H ? *(const uint4*)(pq + (size_t)c * S + k) : *(const uint4*)(pq + (size_t)(256 + c) * S + (k - H));
  };
  const float nrm = rsqrtf((float)S * 64.f);
  auto epi = [&](f32x4 (&acc)[4][4], int wm, int wn, int lane) {
    const int r = lane & 15, q = lane >> 4;
#pragma unroll
    for (int tm = 0; tm < 4; ++tm) {
      int m = wm * 64 + tm * 16 + r;
      int pos = mt * 128 + m;
      float sg = (pos & 1) ? -1.f : 1.f;
      size_t tok = tokb + pos;
#pragma unroll
      for (int tn = 0; tn < 4; ++tn) {
        int c = nt * 128 + wn * 64 + tn * 16 + q * 4;
        f32x4 v = acc[tm][tn];
#pragma unroll
        for (int jj = 0; jj < 4; ++jj) v[jj] = (v[jj] + sg * bf2f(pq[(size_t)(c + jj) * S + H])) * nrm;
        *(uint2*)(z + tok * ZW + Z_DK + c) = pack4(v);
      }
    }
  };
  gemm_tile(smem, S >> 6, la, lb, epi);
}

DI void ph_scan(const Params& p, int item, int layer) {
  const int quarter = item & 3, dir = (item >> 2) & 1, hd = (item >> 3) & 3, bi = item >> 5;
  const int N = bi < 4 ? 32 : 16;
  const int tb0 = bi < 4 ? bi * 32 : 128 + (bi - 4) * 16;
  const float lg = logsig(dir ? p.dec_b[layer * 4 + hd] : p.dec_f[layer * 4 + hd]);
  const float cd = __expf(128.f * lg);
  float* rs = (float*)(p.ws + OFF_RS) + quarter * 1024 + ltid() * 4;
  float4 prev = make_float4(0.f, 0.f, 0.f, 0.f);
  for (int n0 = 0; n0 < N; n0 += 4) {
    float4 t[4];
    float4* ad[4];
#pragma unroll
    for (int u = 0; u < 4; ++u) {
      int n = dir ? N - 1 - (n0 + u) : n0 + u;
      ad[u] = (float4*)(rs + ((size_t)((tb0 + n) * 4 + hd) * 2 + dir) * 4096);
      t[u] = *ad[u];
    }
#pragma unroll
    for (int u = 0; u < 4; ++u) {
      *ad[u] = prev;
      prev.x = prev.x * cd + t[u].x; prev.y = prev.y * cd + t[u].y; prev.z = prev.z * cd + t[u].z; prev.w = prev.w * cd + t[u].w;
    }
  }
}

DI void ph_comb(const Params& p, int item) {
  const int tid = ltid();
  const size_t tok = (size_t)item * 128 + (tid >> 1);
  u16* z = (u16*)(p.ws + OFF_RB) + tok * ZW + Z_DQ;
  const float* lse = (const float*)(p.ws + OFF_LSE);
#pragma unroll
  for (int hh = 0; hh < 2; ++hh) {
    int hd = (tid & 1) * 2 + hh;
    float l0 = lse[((size_t)0 * NTOK + tok) * 4 + hd], l1 = lse[((size_t)1 * NTOK + tok) * 4 + hd], l2 = lse[((size_t)2 * NTOK + tok) * 4 + hd];
    float mx = fmaxf(l0, fmaxf(l1, l2));
    float w0 = __expf(l0 - mx), w1 = __expf(l1 - mx), w2 = __expf(l2 - mx);
    float inv = 1.f / (w0 + w1 + w2);
    w0 *= inv; w1 *= inv; w2 *= inv;
    for (int c8 = 0; c8 < 8; ++c8) {
      u16* a = z + hd * 64 + c8 * 8;
      uint4 v0 = *(const uint4*)a, v1 = *(const uint4*)(a + 256), v2 = *(const uint4*)(a + 512);
      unsigned x0[4] = {v0.x, v0.y, v0.z, v0.w}, x1[4] = {v1.x, v1.y, v1.z, v1.w}, x2[4] = {v2.x, v2.y, v2.z, v2.w}, o[4];
#pragma unroll
      for (int e = 0; e < 4; ++e)
        o[e] = pack2(w0 * blo(x0[e]) + w1 * blo(x1[e]) + w2 * blo(x2[e]), w0 * bhi(x0[e]) + w1 * bhi(x1[e]) + w2 * bhi(x2[e]));
      *(uint4*)a = make_uint4(o[0], o[1], o[2], o[3]);
    }
  }
}

DI void ph_retout(const Params& p, int item, int layer, char* smem) {
  const int hd = item & 3, tile = item >> 2;
  u16* z = (u16*)(p.ws + OFF_RB) + (size_t)tile * 128 * ZW;
  const float* rs = (const float*)(p.ws + OFF_RS) + (size_t)item * 2 * 4096;
  u16* sQ = (u16*)smem;
  u16* sK = sQ + 128 * 72;
  u16* sVT = sK + 128 * 72;
  u16* sSf = sVT + 64 * 136;
  u16* sSb = sSf + 64 * 72;
  u16* sS = sSf;
  const int tid = ltid(), lane = tid & 63, w = tid >> 6, r = lane & 15, q4 = lane >> 4;
  const float lf = logsig(p.dec_f[layer * 4 + hd]), lb = logsig(p.dec_b[layer * 4 + hd]);
  __syncthreads();
#pragma unroll
  for (int i = 0; i < 4; ++i) {
    int c = tid + 256 * i, row = c >> 3, kc = (c & 7) * 8;
    *(uint4*)(sQ + row * 72 + kc) = *(const uint4*)(z + (size_t)row * ZW + Z_RQ + hd * 64 + kc);
    *(uint4*)(sK + row * 72 + kc) = *(const uint4*)(z + (size_t)row * ZW + Z_RK + hd * 64 + kc);
  }
#pragma unroll
  for (int i = 0; i < 4; ++i) {
    int c = tid + 256 * i, j = c & 127, kc = (c >> 7) * 8;
    uint4 vv = *(const uint4*)(z + (size_t)j * ZW + Z_RV + hd * 64 + kc);
    unsigned vw[4] = {vv.x, vv.y, vv.z, vv.w};
#pragma unroll
    for (int e = 0; e < 8; ++e) sVT[(kc + e) * 136 + j] = (u16)((vw[e >> 1] >> ((e & 1) * 16)) & 0xffffu);
  }
#pragma unroll
  for (int i = 0; i < 4; ++i) {
    int c = tid + 256 * i, e = c >> 4, d = (c & 15) * 4;
    float4 a = *(const float4*)(rs + e * 64 + d), b = *(const float4*)(rs + 4096 + e * 64 + d);
    *(uint2*)(sSf + e * 72 + d) = make_uint2(pack2(a.x, a.y), pack2(a.z, a.w));
    *(uint2*)(sSb + e * 72 + d) = make_uint2(pack2(b.x, b.y), pack2(b.z, b.w));
  }
  __syncthreads();
  f32x4 oc[2][1][4];
#pragma unroll
  for (int h = 0; h < 2; ++h) {
    f32x4 cf[1][4], cb[1][4];
    zero_acc(cf);
    zero_acc(cb);
    mma<1, 4>(sQ + (h * 64 + w * 16) * 72, 72, sSf, 72, 2, cf, lane);
    mma<1, 4>(sQ + (h * 64 + w * 16) * 72, 72, sSb, 72, 2, cb, lane);
    int i = h * 64 + w * 16 + r;
    float rf = __expf((float)(i + 1) * lf), rb = __expf((float)(128 - i) * lb);
#pragma unroll
    for (int tn = 0; tn < 4; ++tn)
#pragma unroll
      for (int jj = 0; jj < 4; ++jj) oc[h][0][tn][jj] = rf * cf[0][tn][jj] + rb * cb[0][tn][jj];
  }
  __syncthreads();
#pragma unroll
  for (int h = 0; h < 2; ++h) {
    const int i = h * 64 + w * 16 + r;
    {
      f32x4 s[1][8];
      zero_acc(s);
      mma<1, 8>(sQ + (h * 64 + w * 16) * 72, 72, sK, 72, 2, s, lane);
#pragma unroll
      for (int tn = 0; tn < 8; ++tn) {
        f32x4 v = s[0][tn];
#pragma unroll
        for (int jj = 0; jj < 4; ++jj) {
          int j = tn * 16 + q4 * 4 + jj;
          float dcy = i >= j ? __expf((float)(i - j) * lf) : __expf((float)(j - i) * lb);
          v[jj] *= dcy;
        }
        *(uint2*)(sS + (w * 16 + r) * 136 + tn * 16 + q4 * 4) = pack4(v);
      }
    }
    __syncthreads();
    mma<1, 4>(sS + w * 16 * 136, 136, sVT, 136, 4, oc[h], lane);
    __syncthreads();
    float ss = 0.f;
#pragma unroll
    for (int tn = 0; tn < 4; ++tn)
#pragma unroll
      for (int jj = 0; jj < 4; ++jj) ss += oc[h][0][tn][jj] * oc[h][0][tn][jj];
    ss += __shfl_xor(ss, 16);
    ss += __shfl_xor(ss, 32);
    float rn = rsqrtf(ss * (1.f / 64.f) + EPS);
#pragma unroll
    for (int tn = 0; tn < 4; ++tn) {
      u16* gp = z + (size_t)i * ZW + Z_RG + hd * 64 + tn * 16 + q4 * 4;
      uint2 gv = *(const uint2*)gp;
      float g0 = blo(gv.x), g1 = bhi(gv.x), g2 = blo(gv.y), g3 = bhi(gv.y);
      f32x4 v = oc[h][0][tn];
      v[0] *= rn * g0 / (1.f + __expf(-g0));
      v[1] *= rn * g1 / (1.f + __expf(-g1));
      v[2] *= rn * g2 / (1.f + __expf(-g2));
      v[3] *= rn * g3 / (1.f + __expf(-g3));
      *(uint2*)gp = pack4(v);
    }
  }
}

DI void ph_wout(const Params& p, int item, int layer, char* smem) {
  const int nt = item & 7, tile = item >> 3;
  const u16* z = (const u16*)(p.ws + OFF_RB) + (size_t)tile * 128 * ZW;
  const u16* wt = (const u16*)(p.ws + OFF_WT + layer * WT_LAYER + WT_OUT) + (size_t)nt * 128 * 1024;
  u16* y = (u16*)(p.ws + OFF_RA) + (size_t)tile * 128 * 1024 + nt * 128;
  auto la = [&](int row, int k) {
    int seg = k >> 8;
    int zc = (seg == 0 ? Z_RG : seg == 1 ? Z_DK : seg == 2 ? Z_DQ : Z_CQ) + (k & 255);
    return *(const uint4*)(z + (size_t)row * ZW + zc);
  };
  auto lb = [&](int n, int k) { return *(const uint4*)(wt + (size_t)n * 1024 + k); };
  auto epi = [&](f32x4 (&acc)[4][4], int wm, int wn, int lane) {
    const int r = lane & 15, q = lane >> 4;
#pragma unroll
    for (int tm = 0; tm < 4; ++tm) {
      int m = wm * 64 + tm * 16 + r;
#pragma unroll
      for (int tn = 0; tn < 4; ++tn) *(uint2*)(y + (size_t)m * 1024 + wn * 64 + tn * 16 + q * 4) = pack4(acc[tm][tn]);
    }
  };
  gemm_tile(smem, 16, la, lb, epi);
}

constexpr int N_UPM = 676;
DI void ph_up(const Params& p, int item, int layer, char* smem) {
  const int nt = item % 44, mtile = item / 44;
  int bi, mt, S;
  if (mtile < 132) { bi = mtile / 33; mt = mtile % 33; S = 4096; }
  else { int t = mtile - 132; bi = 4 + t / 17; mt = t % 17; S = 2048; }
  const size_t tokb = tok0_of_batch(bi);
  const u16* h2 = (const u16*)(p.ws + OFF_RB + RB_H2) + tokb * 1024;
  const u16* wt = (const u16*)(p.ws + OFF_WT + layer * WT_LAYER + WT_UP);
  u16* gated = (u16*)(p.ws + OFF_RB + RB_GATED) + tokb * DFF;
  const int pbase = 126 * mt - 1;
  auto la = [&](int row, int k) {
    int pos = pbase + row;
    uint4 v = make_uint4(0, 0, 0, 0);
    if (pos >= 0 && pos < S) v = *(const uint4*)(h2 + (size_t)pos * 1024 + k);
    return v;
  };
  auto lb = [&](int n, int k) {
    int nn = n < 64 ? nt * 64 + n : DFF + nt * 64 + (n - 64);
    return *(const uint4*)(wt + (size_t)nn * 1024 + k);
  };
  auto epi = [&](f32x4 (&acc)[4][4], int wm, int wn, int lane) {
    const int r = lane & 15, q = lane >> 4, tid = ltid();
    u16* sU = (u16*)smem;
    __syncthreads();
#pragma unroll
    for (int tm = 0; tm < 4; ++tm) {
      int m = wm * 64 + tm * 16 + r;
#pragma unroll
      for (int tn = 0; tn < 4; ++tn) *(uint2*)(sU + m * 136 + wn * 64 + tn * 16 + q * 4) = pack4(acc[tm][tn]);
    }
    __syncthreads();
    const int c2 = (tid & 31) * 2, rb = tid >> 5;
    const int na = nt * 64 + c2, nb = DFF + na;
    const float* cw = p.conv_w + (size_t)layer * 3 * 5632;
    const float* cbias = p.conv_b + (size_t)layer * 5632;
    float wa[3][2], wb[3][2], ba[2], bb[2];
#pragma unroll
    for (int t = 0; t < 3; ++t) { wa[t][0] = cw[t * 5632 + na]; wa[t][1] = cw[t * 5632 + na + 1]; wb[t][0] = cw[t * 5632 + nb]; wb[t][1] = cw[t * 5632 + nb + 1]; }
    ba[0] = cbias[na]; ba[1] = cbias[na + 1]; bb[0] = cbias[nb]; bb[1] = cbias[nb + 1];
    for (int i = 0; i < 16; ++i) {
      int rr = rb + 8 * i;
      int pos = pbase + rr;
      if (rr >= 1 && rr <= 126 && pos < S) {
        float a0 = ba[0], a1 = ba[1], b0 = bb[0], b1 = bb[1];
#pragma unroll
        for (int t = 0; t < 3; ++t) {
          unsigned ua = *(const unsigned*)(sU + (rr - 1 + t) * 136 + c2);
          unsigned ub = *(const unsigned*)(sU + (rr - 1 + t) * 136 + 64 + c2);
          a0 += wa[t][0] * blo(ua); a1 += wa[t][1] * bhi(ua);
          b0 += wb[t][0] * blo(ub); b1 += wb[t][1] * bhi(ub);
        }
        float g0 = a0 / (1.f + __expf(-a0)) * b0, g1 = a1 / (1.f + __expf(-a1)) * b1;
        *(unsigned*)(gated + (size_t)pos * DFF + na) = pack2(g0, g1);
      }
    }
  };
  gemm_tile(smem, 16, la, lb, epi);
}

DI void ph_down(const Params& p, int item, int layer, char* smem) {
  const int nt = item & 7, tile = item >> 3;
  const u16* a = (const u16*)(p.ws + OFF_RB + RB_GATED) + (size_t)tile * 128 * DFF;
  const u16* wt = (const u16*)(p.ws + OFF_WT + layer * WT_LAYER + WT_DOWN) + (size_t)nt * 128 * DFF;
  u16* y = (u16*)(p.ws + OFF_RA) + (size_t)tile * 128 * 1024 + nt * 128;
  auto la = [&](int row, int k) { return *(const uint4*)(a + (size_t)row * DFF + k); };
  auto lb = [&](int n, int k) { return *(const uint4*)(wt + (size_t)n * DFF + k); };
  auto epi = [&](f32x4 (&acc)[4][4], int wm, int wn, int lane) {
    const int r = lane & 15, q = lane >> 4;
#pragma unroll
    for (int tm = 0; tm < 4; ++tm) {
      int m = wm * 64 + tm * 16 + r;
#pragma unroll
      for (int tn = 0; tn < 4; ++tn) *(uint2*)(y + (size_t)m * 1024 + wn * 64 + tn * 16 + q * 4) = pack4(acc[tm][tn]);
    }
  };
  gemm_tile(smem, 44, la, lb, epi);
}

constexpr int N_PHASES = 20;

__global__ void __launch_bounds__(256, 2) mega(Params pp) {
  extern __shared__ __attribute__((aligned(16))) char smem[];
  cg::grid_group grid = cg::this_grid();
  for (int ph = pp.ph_lo; ph < pp.ph_hi; ++ph) {
    if (ph > pp.ph_lo) grid.sync();
    Params p = pp;
    asm volatile("" : "+s"(p.ws), "+s"(p.out));
    if (ph == 0) {
      for (int it = blockIdx.x; it < N_PREP; it += gridDim.x) ph_prep(p, it, smem);
    } else if (ph == 1) {
      for (int it = blockIdx.x; it < 5120; it += gridDim.x) ph_ew(p, it, 0, 0);
    } else {
      const int layer = (ph - 2) / 9, sub = (ph - 2) % 9;
      switch (sub) {
        case 0:
          for (int it = blockIdx.x; it < 640 * 34; it += gridDim.x) ph_win(p, it, layer, smem);
          break;
        case 1:
          for (int it = blockIdx.x; it < N_P2; it += gridDim.x) {
            int i = it;
            if (i < N_DIL) { ph_dil(p, i, smem); continue; }
            i -= N_DIL;
            if (i < N_QP) { ph_qproj(p, i, layer, smem); continue; }
            i -= N_QP;
            if (i < N_KVP) { ph_kvproj(p, i, layer, smem); continue; }
            i -= N_KVP;
            if (i < N_RST) { ph_retstate(p, i, layer, smem); continue; }
            i -= N_RST;
            ph_pqfold(p, i);
          }
          break;
        case 2:
          for (int it = blockIdx.x; it < N_P3; it += gridDim.x) {
            int i = it;
            if (i < N_MLA) { ph_mla(p, i, smem); continue; }
            i -= N_MLA;
            if (i < N_FG) { ph_fgemm(p, i, smem); continue; }
            i -= N_FG;
            if (i < N_SCAN) { ph_scan(p, i, layer); continue; }
            i -= N_SCAN;
            ph_comb(p, i);
          }
          break;
        case 3:
          for (int it = blockIdx.x; it < 2560; it += gridDim.x) ph_retout(p, it, layer, smem);
          break;
        case 4:
          for (int it = blockIdx.x; it < 640 * 8; it += gridDim.x) ph_wout(p, it, layer, smem);
          break;
        case 5:
          for (int it = blockIdx.x; it < 5120; it += gridDim.x) ph_ew(p, it, 1, layer);
          break;
        case 6:
          for (int it = blockIdx.x; it < N_UPM * 44; it += gridDim.x) ph_up(p, it, layer, smem);
          break;
        case 7:
          for (int it = blockIdx.x; it < 640 * 8; it += gridDim.x) ph_down(p, it, layer, smem);
          break;
        default:
          for (int it = blockIdx.x; it < 5120; it += gridDim.x) ph_ew(p, it, 2, layer);
          break;
      }
    }
  }
}

extern "C" void kernel_launch(void* const* d_in, const int* in_sizes, int n_in, void* d_out, int out_size, void* d_ws,
                              size_t ws_size, hipStream_t stream) {
  static int grid_blocks = 0;
  if (!grid_blocks) {
    hipFuncSetAttribute((const void*)mega, hipFuncAttributeMaxDynamicSharedMemorySize, DYN_LDS);
    int dev = 0, cus = 0, per_cu = 0;
    hipGetDevice(&dev);
    hipDeviceGetAttribute(&cus, hipDeviceAttributeMultiprocessorCount, dev);
    hipOccupancyMaxActiveBlocksPerMultiprocessor(&per_cu, mega, 256, DYN_LDS);
    if (per_cu > 2) per_cu = 2;
    if (per_cu < 1) per_cu = 1;
    grid_blocks = cus * per_cu;
  }
  if (ws_size < WS_NEED) { fprintf(stderr, "workspace too small: %zu < %zu\n", ws_size, (size_t)WS_NEED); return; }
  Params p{};
  const float** f = (const float**)&p;
  for (int i = 0; i < 23; ++i) f[i] = (const float*)d_in[i];
  p.out = (float*)d_out;
  p.ws = (char*)d_ws;
#if MULTI
  for (int ph = 0; ph < N_PHASES; ++ph) {
    p.ph_lo = ph;
    p.ph_hi = ph + 1;
    hipLaunchKernelGGL(mega, dim3(grid_blocks), dim3(256), DYN_LDS, stream, p);
  }
#else
  p.ph_lo = 0;
  p.ph_hi = N_PHASES;
  void* args[] = {&p};
  hipError_t e = hipLaunchCooperativeKernel((void*)mega, dim3(grid_blocks), dim3(256), args, DYN_LDS, stream);
  if (e != hipSuccess) fprintf(stderr, "cooperative launch failed: %s (grid %d)\n", hipGetErrorString(e), grid_blocks);
#endif
}
```

```cpp
#include <hip/hip_runtime.h>
#include <hip/hip_cooperative_groups.h>
#include <cstdio>
namespace cg = cooperative_groups;

#ifndef PROBE
#define PROBE 0
#endif
#ifndef MULTI
#define MULTI 0
#endif

#define DI __device__ __forceinline__
typedef unsigned short u16;
typedef __attribute__((ext_vector_type(8))) short bf16x8;
typedef __attribute__((ext_vector_type(4))) float f32x4;

constexpr int NTOK = 81920;
constexpr int ZW = 3744;
constexpr int Z_RQ = 0, Z_RK = 256, Z_RV = 512, Z_RG = 768, Z_DK0 = 1024, Z_DQ0 = 1280, Z_CQ = 1536, Z_CKV = 3584, Z_KR = 3712;
__device__ __forceinline__ int zdq(int g) { return g == 0 ? 1280 : 1792 + (g - 1) * 256; }
__device__ __forceinline__ int zdk(int g) { return g == 0 ? 1024 : 2304 + (g - 1) * 256; }
__device__ __forceinline__ int zdv(int g) { return 2816 + g * 256; }
constexpr int DFF = 2816;
constexpr float EPS = 1e-6f;
constexpr float LOG2E = 1.4426950408889634f;
constexpr float LN2 = 0.6931471805599453f;

constexpr size_t OFF_RA = 0;
constexpr size_t OFF_RB = 167772160ull;
constexpr size_t OFF_PQT = OFF_RB + 613416960ull;
constexpr size_t OFF_RS = OFF_RB + 697303040ull;
constexpr size_t OFF_WT = OFF_RS + 83886080ull;
constexpr size_t WT_LAYER = 28639232ull;
constexpr size_t WT_IN = 0, WT_OUT = 8912896ull, WT_UP = 11010048ull, WT_DOWN = 22544384ull, WT_QB = 28311552ull, WT_KVB = 28508160ull;
constexpr size_t OFF_DFT = OFF_WT + 2 * WT_LAYER;
constexpr size_t OFF_TAB = OFF_DFT + 33554432ull;
constexpr size_t OFF_MOD = OFF_TAB + 1835008ull;
constexpr size_t OFF_LSE = OFF_MOD + 1769472ull;
constexpr size_t OFF_CTR = OFF_LSE + 3932160ull;
constexpr size_t OFF_BAR = OFF_CTR + 4096ull;
constexpr size_t WS_NEED = OFF_BAR + 16384ull;
constexpr size_t RA_QM = 0, RA_KB = 62914560ull, RA_VT = 125829120ull;
constexpr size_t RB_H2 = 0, RB_GATED = 169345024ull;

constexpr int HALF_LDS = 73728;
constexpr int DYN_LDS = 2 * HALF_LDS + 64;

struct Params {
  const float *x_p, *x_s, *c_p, *c_s, *w_ada, *b_ada, *n_pre_mix, *w_in, *dec_f, *dec_b, *w_fmix, *q_norm, *w_qb, *kv_norm,
      *w_kvb, *w_out, *n_post_mix, *n_pre_ffn, *w_up, *conv_w, *conv_b, *w_down, *n_post_ffn;
  float* out;
  char* ws;
  int ph_lo, ph_hi, wv, pad_;
};

DI int lane_now() { int l; asm volatile("v_mbcnt_lo_u32_b32 %0, -1, 0\n\tv_mbcnt_hi_u32_b32 %0, -1, %0" : "=v"(l)); return l; }
DI int ltid_w(int wv) { int t = ((wv & 3) << 6) | lane_now(); asm volatile("" : "+v"(t)); return t; }
#define ltid() ltid_w(p.wv)
DI u16 f2bf(float x) { __bf16 h = (__bf16)x; return __builtin_bit_cast(u16, h); }
DI float bf2f(unsigned b) { return __uint_as_float(b << 16); }
typedef __bf16 bf16x2_t __attribute__((ext_vector_type(2)));
typedef float f32x2_t __attribute__((ext_vector_type(2)));
DI unsigned pack2(float a, float b) { f32x2_t v = {a, b}; bf16x2_t r = __builtin_convertvector(v, bf16x2_t); return __builtin_bit_cast(unsigned, r); }
DI float fsilu(float a) { return a * __builtin_amdgcn_rcpf(1.f + __expf(-a)); }
DI uint2 pack4(const f32x4& v) { return make_uint2(pack2(v[0], v[1]), pack2(v[2], v[3])); }
DI float blo(unsigned w) { return __uint_as_float(w << 16); }
DI float bhi(unsigned w) { return __uint_as_float(w & 0xffff0000u); }
DI int tok0_of_batch(int bi) { return bi < 4 ? bi * 4096 : 16384 + (bi - 4) * 2048; }
DI void tile_info(int tile, int& bi, int& S, int& pos0) {
  if (tile < 128) { bi = tile >> 5; S = 4096; pos0 = (tile & 31) << 7; }
  else { int t = tile - 128; bi = 4 + (t >> 4); S = 2048; pos0 = (t & 15) << 7; }
}
DI int batch_of_tok(int tok) { return tok < 16384 ? (tok >> 12) : 4 + ((tok - 16384) >> 11); }

template <int TM, int TN>
DI void mma(const u16* sA, int lda, const u16* sB, int ldb, int ksteps, f32x4 (&acc)[TM][TN], int lane) {
  const int r = lane & 15, q = lane >> 4;
  for (int ks = 0; ks < ksteps; ++ks) {
    bf16x8 a[TM], b[TN];
#pragma unroll
    for (int i = 0; i < TM; ++i) a[i] = *(const bf16x8*)(sA + (i * 16 + r) * lda + ks * 32 + q * 8);
#pragma unroll
    for (int i = 0; i < TN; ++i) b[i] = *(const bf16x8*)(sB + (i * 16 + r) * ldb + ks * 32 + q * 8);
#pragma unroll
    for (int i = 0; i < TM; ++i)
#pragma unroll
      for (int j = 0; j < TN; ++j) acc[i][j] = __builtin_amdgcn_mfma_f32_16x16x32_bf16(b[j], a[i], acc[i][j], 0, 0, 0);
  }
}
template <int TM, int TN>
DI void zero_acc(f32x4 (&acc)[TM][TN]) {
  float zz = 0.f;
  asm volatile("" : "+v"(zz));
#pragma unroll
  for (int i = 0; i < TM; ++i)
#pragma unroll
    for (int j = 0; j < TN; ++j) acc[i][j] = f32x4{zz, zz, zz, zz};
}

template <class LA, class LB, class EP>
DI void gemm_tile_(int wv_, char* smem, int nk, LA loadA, LB loadB, EP epi) {
  u16* sA = (u16*)smem;
  u16* sB = sA + 128 * 72;
  const int tid = ltid_w(wv_), lane = tid & 63, w = tid >> 6, wm = w >> 1, wn = w & 1;
  const int lr = tid >> 3, lk = (tid & 7) * 8;
  uint4 ra[4], rb[4];
  f32x4 acc[4][4];
  zero_acc(acc);
#pragma unroll
  for (int i = 0; i < 4; ++i) { ra[i] = loadA(lr + 32 * i, lk); rb[i] = loadB(lr + 32 * i, lk); }
  for (int kt = 0; kt < nk; ++kt) {
    __syncthreads();
#pragma unroll
    for (int i = 0; i < 4; ++i) {
      *(uint4*)(sA + (lr + 32 * i) * 72 + lk) = ra[i];
      *(uint4*)(sB + (lr + 32 * i) * 72 + lk) = rb[i];
    }
    __syncthreads();
    if (kt + 1 < nk) {
#pragma unroll
      for (int i = 0; i < 4; ++i) { ra[i] = loadA(lr + 32 * i, (kt + 1) * 64 + lk); rb[i] = loadB(lr + 32 * i, (kt + 1) * 64 + lk); }
    }
    mma<4, 4>(sA + wm * 64 * 72, 72, sB + wn * 64 * 72, 72, 2, acc, lane);
  }
  epi(acc, wm, wn, lane);
}

template <class LA, class LB, class EP>
DI void gemm_tile2_(int wv_, char* smem, int nk, LA loadA, LB loadB, EP epi) {
  u16* sA = (u16*)smem;
  u16* sB = sA + 128 * 72;
  const int tid = ltid_w(wv_), lane = tid & 63, w = tid >> 6, wm = w >> 1, wn = w & 1;
  const int lr = tid >> 3, lk = (tid & 7) * 8;
  uint4 ra[4], rb[2];
  f32x4 acc[4][2], acc1[4][2];
  zero_acc(acc);
  zero_acc(acc1);
#pragma unroll
  for (int i = 0; i < 4; ++i) ra[i] = loadA(lr + 32 * i, lk);
#pragma unroll
  for (int i = 0; i < 2; ++i) rb[i] = loadB(lr + 32 * i, lk);
  const int nkh = nk >> 1;
  for (int kt = 0; kt < nk; ++kt) {
    __syncthreads();
#pragma unroll
    for (int i = 0; i < 4; ++i) *(uint4*)(sA + (lr + 32 * i) * 72 + lk) = ra[i];
#pragma unroll
    for (int i = 0; i < 2; ++i) *(uint4*)(sB + (lr + 32 * i) * 72 + lk) = rb[i];
    __syncthreads();
    if (kt + 1 < nk) {
#pragma unroll
      for (int i = 0; i < 4; ++i) ra[i] = loadA(lr + 32 * i, (kt + 1) * 64 + lk);
#pragma unroll
      for (int i = 0; i < 2; ++i) rb[i] = loadB(lr + 32 * i, (kt + 1) * 64 + lk);
    }
    if (kt == nkh) {
#pragma unroll
      for (int i = 0; i < 4; ++i)
#pragma unroll
        for (int j = 0; j < 2; ++j) { acc1[i][j] = acc[i][j]; acc[i][j] = f32x4{0.f, 0.f, 0.f, 0.f}; }
    }
    mma<4, 2>(sA + wm * 64 * 72, 72, sB + wn * 32 * 72, 72, 2, acc, lane);
  }
  epi(acc1, acc, wm, wn, lane);
}

DI void rope_pair(f32x4& a, f32x4& b, const float2* tabrow, int q, float sc) {
#pragma unroll
  for (int jj = 0; jj < 4; ++jj) {
    float2 cs = tabrow[q * 4 + jj];
    float x1 = a[jj], x2 = b[jj];
    a[jj] = (x1 * cs.x - x2 * cs.y) * sc;
    b[jj] = (x2 * cs.x + x1 * cs.y) * sc;
  }
}

constexpr int PI_TRL = 3416, PI_TR = 2 * PI_TRL, PI_FOLD = 128, PI_PAD = 2, PI_MOD = 192, PI_DFT = 256, PI_TAB = 256;
constexpr int N_PREP = PI_TR + PI_FOLD + PI_PAD + PI_MOD + PI_DFT + PI_TAB;

DI int swap45(int c) { return (c & 15) | ((c & 16) << 1) | ((c & 32) >> 1); }
DI void tr_tile_(int wv_, char* smem, const float* src, int lds, int k0, int s0, int nvalid, u16* dst, int ldd, int n0, const float* kscale, bool perm = false) {
  float* t = (float*)smem;
  const int tid = ltid_w(wv_);
  __syncthreads();
#pragma unroll 4
  for (int i = 0; i < 16; ++i) {
    int kr = (tid >> 6) + 4 * i, c = tid & 63;
    float v = (c < nvalid) ? src[(size_t)(k0 + kr) * lds + s0 + c] : 0.f;
    if (kscale) v *= kscale[k0 + kr];
    t[c * 65 + kr] = v;
  }
  __syncthreads();
#pragma unroll 4
  for (int i = 0; i < 16; ++i) {
    int c = (tid >> 6) + 4 * i, kr = tid & 63;
    if (c < nvalid) dst[(size_t)(n0 + (perm ? swap45(c) : c)) * ldd + k0 + kr] = f2bf(t[c * 65 + kr]);
  }
}

DI void ph_prep(const Params& p, int item, char* smem) {
  const int tid = ltid();
  if (item < PI_TR) {
    int layer = item / PI_TRL, it = item % PI_TRL;
    char* wt = p.ws + OFF_WT + layer * WT_LAYER;
    if (it < 1008) {
      int ct = it >> 4, kt = it & 15;
      if (ct >= 16 && ct < 20) return;
      int s0 = ct * 64, zc;
      if (s0 < 1536) zc = s0; else if (s0 < 2048) zc = s0 + 256; else if (s0 < 2304) zc = s0 - 1024; else if (s0 < 3584) zc = s0;
      else if (s0 < 3840) zc = s0 - 2048; else zc = s0 - 256;
      int n0 = 512 + zc;
      int nv = 4000 - s0 < 64 ? 4000 - s0 : 64;
      tr_tile_(p.wv, smem, p.w_in + (size_t)layer * 1024 * 4000, 4000, kt * 64, s0, nv, (u16*)(wt + WT_IN), 1024, n0, nullptr, s0 < 512);
      return;
    }
    it -= 1008;
    if (it < 256) { tr_tile_(p.wv, smem, p.w_out + (size_t)layer * 1024 * 1024, 1024, (it & 15) * 64, (it >> 4) * 64, 64, (u16*)(wt + WT_OUT), 1024, (it >> 4) * 64, nullptr); return; }
    it -= 256;
    if (it < 1408) {
      int s0 = (it >> 4) * 64, n0;
      if (s0 < DFF) n0 = (s0 >> 7) * 256 + (s0 & 127); else { int sb = s0 - DFF; n0 = (sb >> 7) * 256 + 128 + (sb & 127); }
      tr_tile_(p.wv, smem, p.w_up + (size_t)layer * 1024 * 5632, 5632, (it & 15) * 64, s0, 64, (u16*)(wt + WT_UP), 1024, n0, nullptr);
      return;
    }
    it -= 1408;
    if (it < 704) { int kt = it % 44, ct = it / 44; tr_tile_(p.wv, smem, p.w_down + (size_t)layer * 2816 * 1024, 1024, kt * 64, ct * 64, 64, (u16*)(wt + WT_DOWN), 2816, ct * 64, nullptr); return; }
    it -= 704;
    if (it < 24) { int kt = it & 3, ct = it >> 2; tr_tile_(p.wv, smem, p.w_qb + (size_t)layer * 256 * 384, 384, kt * 64, ct * 64, 64, (u16*)(wt + WT_QB), 256, ct * 64, p.q_norm + layer * 256); return; }
    it -= 24;
    { int kt = it & 1, ct = it >> 1; tr_tile_(p.wv, smem, p.w_kvb + (size_t)layer * 128 * 512, 512, kt * 64, ct * 64, 64, (u16*)(wt + WT_KVB), 128, ct * 64, p.kv_norm + layer * 128); return; }
  }
  item -= PI_TR;
  if (item < PI_FOLD) {
    int layer = item >> 6, g = (item >> 4) & 3, cs = (item >> 3) & 1, kc = item & 7;
    float* M = (float*)smem;
    float* ct = M + 4096;
    __syncthreads();
    if (tid < 64) ct[tid] = cospif((float)tid / 32.f);
    __syncthreads();
    const float* Wf = p.w_fmix + ((size_t)layer * 4 + g) * 4096;
    for (int i = 0; i < 16; ++i) {
      int idx = tid + 256 * i, c = idx >> 6, e = idx & 63;
      float a = 0.f;
      for (int c2 = 0; c2 < 64; ++c2) {
        int x = (c * c2) & 63;
        float tv = cs ? ct[(x - 16) & 63] : ct[x];
        a += tv * Wf[c2 * 64 + e];
      }
      M[c * 64 + e] = a;
    }
    __syncthreads();
    const float* W = p.w_in + (size_t)layer * 1024 * 4000 + 1024 + g * 64;
    u16* dst = (u16*)(p.ws + OFF_WT + layer * WT_LAYER + WT_IN);
    int e = tid & 63, kq = tid >> 6;
    for (int i = 0; i < 32; ++i) {
      int k = kc * 128 + kq * 32 + i;
      float a = 0.f;
#pragma unroll 8
      for (int c = 0; c < 64; ++c) a += W[(size_t)k * 4000 + c] * M[c * 64 + e];
      dst[(size_t)(cs * 256 + g * 64 + e) * 1024 + k] = f2bf(a);
    }
    return;
  }
  item -= PI_FOLD;
  if (item < PI_PAD) {
    uint4* dst = (uint4*)(p.ws + OFF_WT + item * WT_LAYER + WT_IN + (size_t)4256 * 1024 * 2);
    for (int i = tid; i < 96 * 1024 * 2 / 16; i += 256) dst[i] = make_uint4(0, 0, 0, 0);
    return;
  }
  item -= PI_PAD;
  if (item < PI_MOD) {
    int layer = item / 96, cb = item % 96;
    float* sC = (float*)smem;
    float* sR = sC + 4608;
    int col = cb * 64 + (tid & 63), kq = tid >> 6;
    float acc[36];
#pragma unroll
    for (int b = 0; b < 36; ++b) acc[b] = 0.f;
    const float* wa = p.w_ada + (size_t)layer * 1024 * 6144;
#pragma unroll 1
    for (int kc = 0; kc < 8; ++kc) {
      __syncthreads();
#pragma unroll 2
      for (int i = 0; i < 18; ++i) {
        int idx = tid + 256 * i, qq = idx / 1152, rem = idx % 1152, b = rem >> 5, kk = rem & 31;
        int k = qq * 256 + kc * 32 + kk;
        float c = b < 4 ? p.c_p[b * 1024 + k] : p.c_s[(b - 4) * 1024 + k];
        sC[idx] = fsilu(c);
      }
      __syncthreads();
#pragma unroll 2
      for (int kk = 0; kk < 32; ++kk) {
        float wv = wa[(size_t)(kq * 256 + kc * 32 + kk) * 6144 + col];
#pragma unroll
        for (int b = 0; b < 36; ++b) acc[b] += sC[(kq * 36 + b) * 32 + kk] * wv;
      }
    }
    __syncthreads();
#pragma unroll
    for (int b = 0; b < 36; ++b) sR[(kq * 36 + b) * 64 + (tid & 63)] = acc[b];
    __syncthreads();
    float* mod = (float*)(p.ws + OFF_MOD) + (size_t)layer * 36 * 6144;
    for (int i = 0; i < 9; ++i) {
      int idx = tid + 256 * i, b = idx >> 6, c = idx & 63;
      float s = sR[(0 * 36 + b) * 64 + c] + sR[(1 * 36 + b) * 64 + c] + sR[(2 * 36 + b) * 64 + c] + sR[(3 * 36 + b) * 64 + c];
      mod[b * 6144 + cb * 64 + c] = s + p.b_ada[layer * 6144 + cb * 64 + c];
    }
    return;
  }
  item -= PI_MOD;
  if (item < PI_DFT) {
    float* tab = (float*)smem;
    __syncthreads();
    for (int i = tid; i < 4096; i += 256) tab[i] = cospif((float)i / 2048.f);
    __syncthreads();
    u16* dft = (u16*)(p.ws + OFF_DFT);
    for (int rr = 0; rr < 16; ++rr) {
      int j = item * 16 + rr;
      for (int i = 0; i < 2; ++i) {
        int ch = tid + 256 * i;
        int kb = (ch & 255) * 8;
        bool sn = ch >= 256;
        unsigned wv[4];
#pragma unroll
        for (int e = 0; e < 8; e += 2) {
          int i0 = (j * (kb + e)) & 4095, i1 = (j * (kb + e + 1)) & 4095;
          float v0 = sn ? -tab[(i0 - 1024) & 4095] : tab[i0];
          float v1 = sn ? -tab[(i1 - 1024) & 4095] : tab[i1];
          wv[e >> 1] = pack2(v0, v1);
        }
        *(uint4*)(dft + (size_t)j * 4096 + ch * 8) = make_uint4(wv[0], wv[1], wv[2], wv[3]);
      }
    }
    return;
  }
  item -= PI_DFT;
  {
    float2* tab = (float2*)(p.ws + OFF_TAB);
    for (int idx = tid; idx < 896; idx += 256) {
      int pos = item * 16 + idx / 56, a = idx % 56;
      float inv;
      if (a < 16) inv = powf(500000.f, -(float)a * 2.f / 32.f);
      else if (a < 24) inv = powf(500000.f, -(float)(a - 16) * 2.f / 16.f);
      else inv = powf(10000.f, -(float)(a - 24) * 2.f / 64.f);
      float ang = (float)pos * inv;
      float s, c;
      sincosf(ang, &s, &c);
      tab[pos * 56 + a] = make_float2(c, s);
    }
  }
}

DI void ph_ew(const Params& p, int item, int mode, int layer) {
  const int tid = ltid(), lane = tid & 63, w = tid >> 6;
  const float* mod = (const float*)(p.ws + OFF_MOD);
  for (int i = 0; i < 4; ++i) {
    int tok = item * 16 + w * 4 + i;
    int bi = batch_of_tok(tok);
    const float* xin;
    if (mode == 0 || (mode == 1 && layer == 0)) xin = tok < 16384 ? p.x_p + (size_t)tok * 1024 : p.x_s + (size_t)(tok - 16384) * 1024;
    else xin = p.out + (size_t)tok * 1024;
    float x[16];
#pragma unroll
    for (int h2 = 0; h2 < 2; ++h2) {
      const float4* xp = (const float4*)(xin + lane * 8 + 512 * h2);
      float4 a = xp[0], b = xp[1];
      x[h2 * 8 + 0] = a.x; x[h2 * 8 + 1] = a.y; x[h2 * 8 + 2] = a.z; x[h2 * 8 + 3] = a.w;
      x[h2 * 8 + 4] = b.x; x[h2 * 8 + 5] = b.y; x[h2 * 8 + 6] = b.z; x[h2 * 8 + 7] = b.w;
    }
    if (mode != 0) {
      const u16* y = (const u16*)(p.ws + OFF_RA) + (size_t)tok * 1024;
      float yv[16];
      float ss = 0.f;
#pragma unroll
      for (int h2 = 0; h2 < 2; ++h2) {
        uint4 v = *(const uint4*)(y + lane * 8 + 512 * h2);
        unsigned wv[4] = {v.x, v.y, v.z, v.w};
#pragma unroll
        for (int e = 0; e < 4; ++e) { yv[h2 * 8 + 2 * e] = blo(wv[e]); yv[h2 * 8 + 2 * e + 1] = bhi(wv[e]); }
      }
#pragma unroll
      for (int e = 0; e < 16; ++e) ss += yv[e] * yv[e];
#pragma unroll
      for (int o = 1; o < 64; o <<= 1) ss += __shfl_xor(ss, o);
      float rs = rsqrtf(ss * (1.f / 1024.f) + EPS);
      const float* npost = (mode == 1 ? p.n_post_mix : p.n_post_ffn) + layer * 1024;
      const float* g = mod + ((size_t)layer * 36 + bi) * 6144 + (mode == 1 ? 2048 : 5120);
#pragma unroll
      for (int h2 = 0; h2 < 2; ++h2)
#pragma unroll
        for (int e = 0; e < 8; ++e) {
          int c = lane * 8 + 512 * h2 + e;
          x[h2 * 8 + e] += g[c] * (yv[h2 * 8 + e] * rs * npost[c]);
        }
      float* xo = p.out + (size_t)tok * 1024;
#pragma unroll
      for (int h2 = 0; h2 < 2; ++h2) {
        float4* op = (float4*)(xo + lane * 8 + 512 * h2);
        op[0] = make_float4(x[h2 * 8 + 0], x[h2 * 8 + 1], x[h2 * 8 + 2], x[h2 * 8 + 3]);
        op[1] = make_float4(x[h2 * 8 + 4], x[h2 * 8 + 5], x[h2 * 8 + 6], x[h2 * 8 + 7]);
      }
    }
    if (mode == 2 && layer == 1) continue;
    int nl = mode == 2 ? layer + 1 : layer;
    const float* npre = (mode == 1 ? p.n_pre_ffn : p.n_pre_mix) + nl * 1024;
    const float* mb = mod + ((size_t)nl * 36 + bi) * 6144 + (mode == 1 ? 3072 : 0);
    float ss = 0.f;
#pragma unroll
    for (int e = 0; e < 16; ++e) ss += x[e] * x[e];
#pragma unroll
    for (int o = 1; o < 64; o <<= 1) ss += __shfl_xor(ss, o);
    float rs = rsqrtf(ss * (1.f / 1024.f) + EPS);
    const int umt = tok / 254, urr = tok % 254;
    u16* hd = mode == 1 ? (u16*)(p.ws + OFF_RB + RB_H2) + ((size_t)umt * 256 + urr + 1) * 1024 : (u16*)(p.ws + OFF_RA) + (size_t)tok * 1024;
#pragma unroll
    for (int h2 = 0; h2 < 2; ++h2) {
      unsigned wv[4];
#pragma unroll
      for (int e = 0; e < 8; e += 2) {
        int c = lane * 8 + 512 * h2 + e;
        float v0 = x[h2 * 8 + e] * rs * npre[c] * (1.f + mb[1024 + c]) + mb[c];
        float v1 = x[h2 * 8 + e + 1] * rs * npre[c + 1] * (1.f + mb[1024 + c + 1]) + mb[c + 1];
        wv[e >> 1] = pack2(v0, v1);
      }
      uint4 ov = make_uint4(wv[0], wv[1], wv[2], wv[3]);
      *(uint4*)(hd + lane * 8 + 512 * h2) = ov;
      if (mode == 1) {
        u16* hb = (u16*)(p.ws + OFF_RB + RB_H2);
        if (urr == 0 && umt > 0) *(uint4*)(hb + ((size_t)(umt - 1) * 256 + 255) * 1024 + lane * 8 + 512 * h2) = ov;
        if (urr == 253 && umt + 1 < 323) *(uint4*)(hb + ((size_t)(umt + 1) * 256) * 1024 + lane * 8 + 512 * h2) = ov;
      }
    }
  }
}

DI void ph_win(const Params& p, int item, int layer, char* smem) {
  const int nt = item % 34, tile = item / 34;
  int bi, S, pos0;
  tile_info(tile, bi, S, pos0);
  const u16* h = (const u16*)(p.ws + OFF_RA) + (size_t)tile * 128 * 1024;
  const u16* wt = (const u16*)(p.ws + OFF_WT + layer * WT_LAYER + WT_IN) + (size_t)nt * 128 * 1024;
  u16* z = (u16*)(p.ws + OFF_RB);
  u16* pqt = (u16*)(p.ws + OFF_PQT) + (size_t)tok0_of_batch(bi) * 512;
  const float2* tab = (const float2*)(p.ws + OFF_TAB);
  auto la = [&](int row, int k) { return *(const uint4*)(h + (size_t)row * 1024 + k); };
  auto lb = [&](int n, int k) { return *(const uint4*)(wt + (size_t)n * 1024 + k); };
  auto epi = [&](f32x4 (&acc)[4][4], int wm, int wn, int lane) {
    const int r = lane & 15, q = lane >> 4;
    const int nw0 = nt * 128 + wn * 64;
    const int zc0 = nw0 - 512;
    if (nt >= 4 && zc0 >= ZW) return;
#pragma unroll
    for (int tm = 0; tm < 4; ++tm) {
      int m = wm * 64 + tm * 16 + r;
      int pos = pos0 + m;
      size_t tok = (size_t)tile * 128 + m;
      if (nt < 4) {
#pragma unroll
        for (int tn = 0; tn < 4; ++tn)
#pragma unroll
          for (int jj = 0; jj < 4; ++jj) {
            int n = nw0 + tn * 16 + q * 4 + jj;
            pqt[(size_t)n * S + pos] = f2bf(acc[tm][tn][jj]);
          }
        continue;
      }
      const float2* tr = tab + pos * 56;
      const bool prope = (zc0 >= 1024 && zc0 < 1536) || (zc0 >= 1792 && zc0 < 2816);
      if (zc0 < 512) {
        float sc = zc0 >= 256 ? 0.125f : 1.f;
        rope_pair(acc[tm][0], acc[tm][2], tr + 24, q, sc);
        rope_pair(acc[tm][1], acc[tm][3], tr + 24 + 16, q, sc);
      } else if (prope) {
        const bool isq = (zc0 >= 1280 && zc0 < 1536) || (zc0 >= 1792 && zc0 < 2304);
        float sc = isq ? 0.125f * LOG2E : 1.f;
#pragma unroll
        for (int jj = 0; jj < 4; ++jj) {
          float2 cs = tr[16 + (q & 1) * 4 + jj];
          float v = acc[tm][0][jj];
          float o = __shfl_xor(v, 32);
          acc[tm][0][jj] = q < 2 ? v * cs.x - o * cs.y : v * cs.x + o * cs.y;
        }
#pragma unroll
        for (int tn = 0; tn < 4; ++tn)
#pragma unroll
          for (int jj = 0; jj < 4; ++jj) acc[tm][tn][jj] *= sc;
      } else if (zc0 == Z_KR) {
        rope_pair(acc[tm][0], acc[tm][1], tr, q, 1.f);
      }
      u16* zr = z + tok * ZW + zc0 + q * 4;
      *(uint2*)(zr) = pack4(acc[tm][0]);
      *(uint2*)(zr + 16) = pack4(acc[tm][1]);
      if (zc0 != Z_KR) {
        *(uint2*)(zr + 32) = pack4(acc[tm][2]);
        *(uint2*)(zr + 48) = pack4(acc[tm][3]);
      }
    }
  };
  gemm_tile_(p.wv, smem, 16, la, lb, epi);
}

constexpr int N_DIL = 3840, N_QP = 1920, N_KVP = 2560, N_RST = 144, N_PQF = 2304;
constexpr int N_P2 = N_RST + N_DIL + N_QP + N_KVP + N_PQF;

DI bf16x8 pack8(const f32x4& a, const f32x4& b) {
  uint4 u = make_uint4(pack2(a[0], a[1]), pack2(a[2], a[3]), pack2(b[0], b[1]), pack2(b[2], b[3]));
  return __builtin_bit_cast(bf16x8, u);
}
DI bf16x8 ldvt2(const u16* row, int c0, int c1) {
  uint2 lo = *(const uint2*)(row + c0), hi = *(const uint2*)(row + c1);
  uint4 u = make_uint4(lo.x, lo.y, hi.x, hi.y);
  return __builtin_bit_cast(bf16x8, u);
}

DI void ph_dil(const Params& p, int item, char* smem, bool dry = false) {
  int bi, rem, nbt, S;
  if (item < 768) { bi = item / 192; rem = item % 192; nbt = 64; S = 4096; }
  else { int it = item - 768; bi = 4 + it / 96; rem = it % 96; nbt = 32; S = 2048; }
  const int g = rem / nbt, blk = rem % nbt, dil = 1 << (2 * g), L = S / dil, nblk = L >> 6;
  const int r = blk / nblk, nb = blk % nblk;
  const size_t tokb = tok0_of_batch(bi);
  u16* z = (u16*)(p.ws + OFF_RB);
  u16* sQ = (u16*)smem;
  u16* sK = sQ + 64 * 72;
  u16* sVT = sK + 192 * 72;
  u16* sP = sK;
  const int tid = ltid(), lane = tid & 63, w = tid >> 6;
  const int qq = w * 16 + (lane & 15), q4 = lane >> 4;
  uint4 rq0, rq1, rk0, rk1, rk2, rk3, rk4, rk5, rv0, rv1, rv2, rv3, rv4, rv5;
#define DIL_LOAD(hd_) { const int cq_ = zdq(g) + (hd_)*64, ck_ = zdk(g) + (hd_)*64, cv_ = zdv(g) + (hd_)*64; \
    { int c = tid + 0, row = c >> 3, kc = (c & 7) * 8; rq0 = *(const uint4*)(z + (tokb + r + dil * (nb * 64 + row)) * ZW + cq_ + kc); } \
    { int c = tid + 256, row = c >> 3, kc = (c & 7) * 8; rq1 = *(const uint4*)(z + (tokb + r + dil * (nb * 64 + row)) * ZW + cq_ + kc); } \
    { int c = tid + 0, row = c >> 3, kc = (c & 7) * 8; int t = nb * 64 - 64 + row; rk0 = make_uint4(0, 0, 0, 0); if (t >= 0 && t < L) rk0 = *(const uint4*)(z + (tokb + r + dil * t) * ZW + ck_ + kc); } \
    { int c = tid + 256, row = c >> 3, kc = (c & 7) * 8; int t = nb * 64 - 64 + row; rk1 = make_uint4(0, 0, 0, 0); if (t >= 0 && t < L) rk1 = *(const uint4*)(z + (tokb + r + dil * t) * ZW + ck_ + kc); } \
    { int c = tid + 512, row = c >> 3, kc = (c & 7) * 8; int t = nb * 64 - 64 + row; rk2 = make_uint4(0, 0, 0, 0); if (t >= 0 && t < L) rk2 = *(const uint4*)(z + (tokb + r + dil * t) * ZW + ck_ + kc); } \
    { int c = tid + 768, row = c >> 3, kc = (c & 7) * 8; int t = nb * 64 - 64 + row; rk3 = make_uint4(0, 0, 0, 0); if (t >= 0 && t < L) rk3 = *(const uint4*)(z + (tokb + r + dil * t) * ZW + ck_ + kc); } \
    { int c = tid + 1024, row = c >> 3, kc = (c & 7) * 8; int t = nb * 64 - 64 + row; rk4 = make_uint4(0, 0, 0, 0); if (t >= 0 && t < L) rk4 = *(const uint4*)(z + (tokb + r + dil * t) * ZW + ck_ + kc); } \
    { int c = tid + 1280, row = c >> 3, kc = (c & 7) * 8; int t = nb * 64 - 64 + row; rk5 = make_uint4(0, 0, 0, 0); if (t >= 0 && t < L) rk5 = *(const uint4*)(z + (tokb + r + dil * t) * ZW + ck_ + kc); } \
    { int c = tid + 0, kp = c % 96, kc = (c / 96) * 8; int t0 = nb * 64 - 64 + 2 * kp; rv0 = make_uint4(0, 0, 0, 0); rv1 = make_uint4(0, 0, 0, 0); if (t0 >= 0 && t0 < L) rv0 = *(const uint4*)(z + (tokb + r + dil * t0) * ZW + cv_ + kc); if (t0 + 1 >= 0 && t0 + 1 < L) rv1 = *(const uint4*)(z + (tokb + r + dil * (t0 + 1)) * ZW + cv_ + kc); } \
    { int c = tid + 256, kp = c % 96, kc = (c / 96) * 8; int t0 = nb * 64 - 64 + 2 * kp; rv2 = make_uint4(0, 0, 0, 0); rv3 = make_uint4(0, 0, 0, 0); if (t0 >= 0 && t0 < L) rv2 = *(const uint4*)(z + (tokb + r + dil * t0) * ZW + cv_ + kc); if (t0 + 1 >= 0 && t0 + 1 < L) rv3 = *(const uint4*)(z + (tokb + r + dil * (t0 + 1)) * ZW + cv_ + kc); } \
    { int c = tid + 512, kp = c % 96, kc = (c / 96) * 8; int t0 = nb * 64 - 64 + 2 * kp; rv4 = make_uint4(0, 0, 0, 0); rv5 = make_uint4(0, 0, 0, 0); if (t0 >= 0 && t0 < L) rv4 = *(const uint4*)(z + (tokb + r + dil * t0) * ZW + cv_ + kc); if (t0 + 1 >= 0 && t0 + 1 < L) rv5 = *(const uint4*)(z + (tokb + r + dil * (t0 + 1)) * ZW + cv_ + kc); } \
  }
  DIL_LOAD(0);
#pragma unroll 1
  for (int hd = 0; hd < 4; ++hd) {
    const int colq = zdq(g) + hd * 64;
    __syncthreads();
    { int c = tid + 0, row = c >> 3, kc = (c & 7) * 8; *(uint4*)(sQ + row * 72 + kc) = rq0; }
    { int c = tid + 256, row = c >> 3, kc = (c & 7) * 8; *(uint4*)(sQ + row * 72 + kc) = rq1; }
    { int c = tid + 0, row = c >> 3, kc = (c & 7) * 8; *(uint4*)(sK + row * 72 + kc) = rk0; }
    { int c = tid + 256, row = c >> 3, kc = (c & 7) * 8; *(uint4*)(sK + row * 72 + kc) = rk1; }
    { int c = tid + 512, row = c >> 3, kc = (c & 7) * 8; *(uint4*)(sK + row * 72 + kc) = rk2; }
    { int c = tid + 768, row = c >> 3, kc = (c & 7) * 8; *(uint4*)(sK + row * 72 + kc) = rk3; }
    { int c = tid + 1024, row = c >> 3, kc = (c & 7) * 8; *(uint4*)(sK + row * 72 + kc) = rk4; }
    { int c = tid + 1280, row = c >> 3, kc = (c & 7) * 8; *(uint4*)(sK + row * 72 + kc) = rk5; }
    { int c = tid + 0, kp = c % 96, kc = (c / 96) * 8;
      unsigned w0[4] = {rv0.x, rv0.y, rv0.z, rv0.w}, w1[4] = {rv1.x, rv1.y, rv1.z, rv1.w};
#pragma unroll
      for (int e = 0; e < 4; ++e) {
        *(unsigned*)(sVT + (kc + 2 * e) * 200 + 2 * kp) = (w0[e] & 0xffffu) | (w1[e] << 16);
        *(unsigned*)(sVT + (kc + 2 * e + 1) * 200 + 2 * kp) = (w0[e] >> 16) | (w1[e] & 0xffff0000u);
      } }
    { int c = tid + 256, kp = c % 96, kc = (c / 96) * 8;
      unsigned w0[4] = {rv2.x, rv2.y, rv2.z, rv2.w}, w1[4] = {rv3.x, rv3.y, rv3.z, rv3.w};
#pragma unroll
      for (int e = 0; e < 4; ++e) {
        *(unsigned*)(sVT + (kc + 2 * e) * 200 + 2 * kp) = (w0[e] & 0xffffu) | (w1[e] << 16);
        *(unsigned*)(sVT + (kc + 2 * e + 1) * 200 + 2 * kp) = (w0[e] >> 16) | (w1[e] & 0xffff0000u);
      } }
    { int c = tid + 512, kp = c % 96, kc = (c / 96) * 8;
      unsigned w0[4] = {rv4.x, rv4.y, rv4.z, rv4.w}, w1[4] = {rv5.x, rv5.y, rv5.z, rv5.w};
#pragma unroll
      for (int e = 0; e < 4; ++e) {
        *(unsigned*)(sVT + (kc + 2 * e) * 200 + 2 * kp) = (w0[e] & 0xffffu) | (w1[e] << 16);
        *(unsigned*)(sVT + (kc + 2 * e + 1) * 200 + 2 * kp) = (w0[e] >> 16) | (w1[e] & 0xffff0000u);
      } }
    if (hd < 3) DIL_LOAD(hd + 1);
    __syncthreads();
    f32x4 s[10];
    {
      float zz = 0.f;
      asm volatile("" : "+v"(zz));
#pragma unroll
      for (int t = 0; t < 10; ++t) s[t] = f32x4{zz, zz, zz, zz};
    }
    const int lr = lane & 15;
#pragma unroll
    for (int ks = 0; ks < 2; ++ks) {
      bf16x8 qa = *(const bf16x8*)(sQ + (w * 16 + lr) * 72 + ks * 32 + q4 * 8);
#pragma unroll
      for (int t = 0; t < 9; ++t) {
        bf16x8 kb = *(const bf16x8*)(sK + ((w + t) * 16 + lr) * 72 + ks * 32 + q4 * 8);
        s[t] = __builtin_amdgcn_mfma_f32_16x16x32_bf16(kb, qa, s[t], 0, 0, 0);
      }
    }
    const int klo = max(qq, 64 - nb * 64), khi = min(qq + 128, L - 1 + 64 - nb * 64);
    const unsigned kspan = (unsigned)(khi - klo);
    const int kb0 = w * 16 + q4 * 4 - klo;
    float mx = -1e30f;
#pragma unroll
    for (int t = 0; t < 9; ++t)
#pragma unroll
      for (int jj = 0; jj < 4; ++jj) {
        bool ok = (unsigned)(kb0 + t * 16 + jj) <= kspan;
        float v = ok ? s[t][jj] : -1e30f;
        s[t][jj] = v;
        mx = fmaxf(mx, v);
      }
    mx = fmaxf(mx, __shfl_xor(mx, 16));
    mx = fmaxf(mx, __shfl_xor(mx, 32));
    float den = 0.f;
#pragma unroll
    for (int t = 0; t < 9; ++t)
#pragma unroll
      for (int jj = 0; jj < 4; ++jj) {
        float pv = __builtin_amdgcn_exp2f(s[t][jj] - mx);
        den += pv;
        s[t][jj] = pv;
      }
    den += __shfl_xor(den, 16);
    den += __shfl_xor(den, 32);
    f32x4 o[1][4];
    zero_acc(o);
#pragma unroll
    for (int kp = 0; kp < 5; ++kp) {
      bf16x8 pa = pack8(s[2 * kp], s[2 * kp + 1]);
      const int c0 = w * 16 + kp * 32 + q4 * 4, c1 = kp < 4 ? c0 + 16 : c0;
#pragma unroll
      for (int td = 0; td < 4; ++td) {
        bf16x8 vb = ldvt2(sVT + (td * 16 + lr) * 200, c0, c1);
        o[0][td] = __builtin_amdgcn_mfma_f32_16x16x32_bf16(vb, pa, o[0][td], 0, 0, 0);
      }
    }
    const float inv = 1.f / den;
    const size_t tok = tokb + r + dil * (nb * 64 + qq);
#pragma unroll
    for (int tn = 0; tn < 4; ++tn) {
      f32x4 v = o[0][tn];
      v[0] *= inv; v[1] *= inv; v[2] *= inv; v[3] *= inv;
      if (dry) *(uint2*)((u16*)p.out + tok * 1024 + (colq & 1023) + tn * 16 + q4 * 4) = pack4(v);
      else *(uint2*)(z + tok * ZW + colq + tn * 16 + q4 * 4) = pack4(v);
    }
    if (q4 == 0) ((float*)(p.ws + OFF_LSE))[((size_t)g * NTOK + tok) * 4 + hd] = (mx + log2f(den)) * LN2;
  }
#undef DIL_LOAD
}

DI void row_rstd_(int wv_, float* sR, const u16* base, int ncols) {
  const int tid = ltid_w(wv_), row = tid >> 1, half = tid & 1;
  const u16* b = base + (size_t)row * ZW + half * (ncols >> 1);
  float ss = 0.f;
  for (int c = 0; c < (ncols >> 4); ++c) {
    uint4 v = *(const uint4*)(b + c * 8);
    unsigned wv[4] = {v.x, v.y, v.z, v.w};
#pragma unroll
    for (int e = 0; e < 4; ++e) { float a = blo(wv[e]), d = bhi(wv[e]); ss += a * a + d * d; }
  }
  ss += __shfl_xor(ss, 1);
  if (half == 0) sR[row] = rsqrtf(ss / (float)ncols + EPS);
}

DI void ph_qproj(const Params& p, int item, int layer, char* smem) {
  const int nt = item % 3, tile = item / 3;
  int bi, S, pos0;
  tile_info(tile, bi, S, pos0);
  const u16* z = (const u16*)(p.ws + OFF_RB) + (size_t)tile * 128 * ZW;
  const u16* wt = (const u16*)(p.ws + OFF_WT + layer * WT_LAYER + WT_QB) + (size_t)nt * 128 * 256;
  u16* qm = (u16*)(p.ws + OFF_RA + RA_QM);
  const float2* tab = (const float2*)(p.ws + OFF_TAB);
  float* sR = (float*)(smem + 36864);
  __syncthreads();
  row_rstd_(p.wv, sR, z + Z_CQ, 256);
  auto la = [&](int row, int k) { return *(const uint4*)(z + (size_t)row * ZW + Z_CQ + k); };
  auto lb = [&](int n, int k) { return *(const uint4*)(wt + (size_t)n * 256 + k); };
  auto epi = [&](f32x4 (&acc)[4][4], int wm, int wn, int lane) {
    const int r = lane & 15, q = lane >> 4;
    const int nw0 = nt * 128 + wn * 64;
    const float QS = 0.10206207261596575f * LOG2E;
#pragma unroll
    for (int tm = 0; tm < 4; ++tm) {
      int m = wm * 64 + tm * 16 + r;
      int pos = pos0 + m;
      size_t tok = (size_t)tile * 128 + m;
      float rs = sR[m] * QS;
#pragma unroll
      for (int tn = 0; tn < 4; ++tn)
#pragma unroll
        for (int jj = 0; jj < 4; ++jj) acc[tm][tn][jj] *= rs;
      const float2* tr = tab + pos * 56;
      if (nw0 == 64 || nw0 == 256) rope_pair(acc[tm][0], acc[tm][1], tr, q, 1.f);
      else if (nw0 == 128 || nw0 == 320) rope_pair(acc[tm][2], acc[tm][3], tr, q, 1.f);
      u16* d = qm + tok * 384 + nw0 + q * 4;
#pragma unroll
      for (int tn = 0; tn < 4; ++tn) *(uint2*)(d + tn * 16) = pack4(acc[tm][tn]);
    }
  };
  gemm_tile_(p.wv, smem, 4, la, lb, epi);
}

DI void ph_kvproj(const Params& p, int item, int layer, char* smem) {
  const int nt = item & 3, tile = item >> 2;
  int bi, S, pos0;
  tile_info(tile, bi, S, pos0);
  const u16* z = (const u16*)(p.ws + OFF_RB) + (size_t)tile * 128 * ZW;
  const u16* wt = (const u16*)(p.ws + OFF_WT + layer * WT_LAYER + WT_KVB) + (size_t)nt * 128 * 128;
  u16* kb = (u16*)(p.ws + OFF_RA + RA_KB);
  u16* vt = (u16*)(p.ws + OFF_RA + RA_VT) + (size_t)tok0_of_batch(bi) * 256;
  float* sR = (float*)(smem + 36864);
  __syncthreads();
  row_rstd_(p.wv, sR, z + Z_CKV, 128);
  auto la = [&](int row, int k) { return *(const uint4*)(z + (size_t)row * ZW + Z_CKV + k); };
  auto lb = [&](int n, int k) { return *(const uint4*)(wt + (size_t)n * 128 + k); };
  auto epi = [&](f32x4 (&acc)[4][4], int wm, int wn, int lane) {
    const int r = lane & 15, q = lane >> 4;
#pragma unroll
    for (int tm = 0; tm < 4; ++tm) {
      int m = wm * 64 + tm * 16 + r;
      int pos = pos0 + m;
      const int k5 = pos & 31;
      const int ppos = (pos & ~31) | (8 * ((k5 >> 2) & 3) + 4 * (k5 >> 4) + (k5 & 3));
      size_t tok = (size_t)tile * 128 + m;
      float rs = sR[m];
#pragma unroll
      for (int tn = 0; tn < 4; ++tn)
#pragma unroll
        for (int jj = 0; jj < 4; ++jj) acc[tm][tn][jj] *= rs;
      if (wn == 0) {
        u16* d = kb + tok * 384 + nt * 96 + q * 4;
#pragma unroll
        for (int tn = 0; tn < 4; ++tn) *(uint2*)(d + tn * 16) = pack4(acc[tm][tn]);
      } else {
#pragma unroll
        for (int tn = 0; tn < 4; ++tn)
#pragma unroll
          for (int jj = 0; jj < 4; ++jj) vt[(size_t)(nt * 64 + tn * 16 + q * 4 + jj) * S + ppos] = f2bf(acc[tm][tn][jj]);
      }
    }
    if (wn == 0) {
      int m = wm * 64 + lane;
      size_t tok = (size_t)tile * 128 + m;
      const uint4* src = (const uint4*)(z + (size_t)m * ZW + Z_KR);
      uint4* dst = (uint4*)(kb + tok * 384 + nt * 96 + 64);
#pragma unroll
      for (int e = 0; e < 4; ++e) dst[e] = src[e];
    }
  };
  gemm_tile_(p.wv, smem, 2, la, lb, epi);
}

DI float logsig(float x) { return -log1pf(expf(-x)); }

DI void ph_retscan(const Params& p, int item, int layer, char* smem) {
  const int hd = item & 3, bi = item >> 2;
  const int N = bi < 4 ? 32 : 16;
  const int tb0 = bi < 4 ? bi * 32 : 128 + (bi - 4) * 16;
  const u16* zb = (const u16*)(p.ws + OFF_RB);
  u16* sKf = (u16*)smem;
  u16* sVf = sKf + 64 * 136;
  u16* sKb = sVf + 64 * 136;
  u16* sVb = sKb + 64 * 136;
  const int tid = ltid(), lane = tid & 63, w = tid >> 6;
  const float lf = logsig(p.dec_f[layer * 4 + hd]), lb = logsig(p.dec_b[layer * 4 + hd]);
  const int dir = w >> 1, eh = w & 1;
  const float cd = __expf(128.f * (dir ? lb : lf));
  f32x4 acc[2][4];
  zero_acc(acc);
  const int r = lane & 15, q = lane >> 4;
  for (int step = 0; step < N; ++step) {
    const int nf = step, nb = N - 1 - step;
    __syncthreads();
#pragma unroll
    for (int i = 0; i < 4; ++i) {
      int c = tid + 256 * i, j = c & 127, kc = (c >> 7) * 8;
      const u16* zf = zb + ((size_t)(tb0 + nf) * 128 + j) * ZW + hd * 64 + kc;
      const u16* zr = zb + ((size_t)(tb0 + nb) * 128 + j) * ZW + hd * 64 + kc;
      uint4 kf = *(const uint4*)(zf + Z_RK), vf = *(const uint4*)(zf + Z_RV), kbv = *(const uint4*)(zr + Z_RK), vbv = *(const uint4*)(zr + Z_RV);
      unsigned kfw[4] = {kf.x, kf.y, kf.z, kf.w}, vfw[4] = {vf.x, vf.y, vf.z, vf.w}, kbw[4] = {kbv.x, kbv.y, kbv.z, kbv.w}, vbw[4] = {vbv.x, vbv.y, vbv.z, vbv.w};
      float df = __expf((float)(127 - j) * lf), db = __expf((float)j * lb);
#pragma unroll
      for (int e = 0; e < 8; ++e) {
        float kx = (e & 1) ? bhi(kfw[e >> 1]) : blo(kfw[e >> 1]);
        float ky = (e & 1) ? bhi(kbw[e >> 1]) : blo(kbw[e >> 1]);
        sKf[(kc + e) * 136 + j] = f2bf(kx * df);
        sKb[(kc + e) * 136 + j] = f2bf(ky * db);
        sVf[(kc + e) * 136 + j] = (u16)((vfw[e >> 1] >> ((e & 1) * 16)) & 0xffffu);
        sVb[(kc + e) * 136 + j] = (u16)((vbw[e >> 1] >> ((e & 1) * 16)) & 0xffffu);
      }
    }
    __syncthreads();
    const int n = dir ? nb : nf;
    float* rs = (float*)(p.ws + OFF_RS) + ((size_t)((tb0 + n) * 4 + hd) * 2 + dir) * 4096;
#pragma unroll
    for (int tm = 0; tm < 2; ++tm)
#pragma unroll
      for (int tn = 0; tn < 4; ++tn) {
        int e = eh * 32 + tm * 16 + r, d = tn * 16 + q * 4;
        *(float4*)(rs + e * 64 + d) = make_float4(acc[tm][tn][0], acc[tm][tn][1], acc[tm][tn][2], acc[tm][tn][3]);
        acc[tm][tn][0] *= cd; acc[tm][tn][1] *= cd; acc[tm][tn][2] *= cd; acc[tm][tn][3] *= cd;
      }
    mma<2, 4>((dir ? sVb : sVf) + eh * 32 * 136, 136, dir ? sKb : sKf, 136, 4, acc, lane);
  }
}

DI void ph_pqfold(const Params& p, int item) {
  const int bi = item >> 6, cg8 = item & 63;
  const int S = bi < 4 ? 4096 : 2048, H = S >> 1;
  u16* pq = (u16*)(p.ws + OFF_PQT) + (size_t)tok0_of_batch(bi) * 512;
  const int tid = ltid();
  const int nch = H >> 3;
#pragma unroll 4
  for (int c = tid; c < 8 * nch; c += 256) {
    int row = cg8 * 8 + c / nch, k = (c % nch) * 8;
    u16* rp = pq + (size_t)row * S;
    const float sgn = row < 256 ? 1.f : -1.f;
    uint4 va = *(const uint4*)(rp + k), vb = *(const uint4*)(rp + H + k);
    unsigned wa[4] = {va.x, va.y, va.z, va.w}, wb[4] = {vb.x, vb.y, vb.z, vb.w}, o[4];
#pragma unroll
    for (int e = 0; e < 4; ++e) o[e] = pack2(blo(wa[e]) + sgn * blo(wb[e]), bhi(wa[e]) + sgn * bhi(wb[e]));
    if (k == 0) o[0] = (o[0] & 0xffff0000u) | (wa[0] & 0xffffu);
    *(uint4*)(rp + k) = make_uint4(o[0], o[1], o[2], o[3]);
  }
}

constexpr int N_MLA = 2560, N_FG = 1280, N_RO = 2560, N_COMB = 640, N_FM = 36;
constexpr int N_P3 = N_MLA + N_FG + N_RO + N_COMB + N_FM;

DI void mla_softmax(f32x4 (&s)[4], f32x4 (&o)[4], float& mrun, float& lrun) {
  float mx = -1e30f;
#pragma unroll
  for (int tn = 0; tn < 4; ++tn)
#pragma unroll
    for (int jj = 0; jj < 4; ++jj) mx = fmaxf(mx, s[tn][jj]);
  mx = fmaxf(mx, __shfl_xor(mx, 16));
  mx = fmaxf(mx, __shfl_xor(mx, 32));
  float mn = fmaxf(mrun, mx);
  float alpha = __builtin_amdgcn_exp2f(mrun - mn);
  mrun = mn;
  float ps = 0.f;
#pragma unroll
  for (int tn = 0; tn < 4; ++tn)
#pragma unroll
    for (int jj = 0; jj < 4; ++jj) { float pv = __builtin_amdgcn_exp2f(s[tn][jj] - mn); ps += pv; s[tn][jj] = pv; }
  lrun = lrun * alpha + ps;
#pragma unroll
  for (int tn = 0; tn < 4; ++tn)
#pragma unroll
    for (int jj = 0; jj < 4; ++jj) o[tn][jj] *= alpha;
}
DI void ph_mla(const Params& p, int item, char* smem) {
  int bi, hd, qb, S;
  if (item < 512) { bi = item >> 7; hd = (item >> 5) & 3; qb = item & 31; S = 4096; }
  else { int it = item - 512; bi = 4 + (it >> 6); hd = (it >> 4) & 3; qb = it & 15; S = 2048; }
  const size_t tokb = tok0_of_batch(bi);
  const u16* qm = (const u16*)(p.ws + OFF_RA + RA_QM) + (tokb + qb * 128) * 384 + hd * 96;
  const u16* kb = (const u16*)(p.ws + OFF_RA + RA_KB) + tokb * 384 + hd * 96;
  const u16* vt = (const u16*)(p.ws + OFF_RA + RA_VT) + tokb * 256 + (size_t)hd * 64 * S;
  u16* z = (u16*)(p.ws + OFF_RB);
  constexpr int BUF = 64 * 104 + 64 * 72;
  u16* sKV = (u16*)smem;
  u16* sP = sKV + 2 * BUF;
  const int tid = ltid(), lane = tid & 63, w = tid >> 6, r = lane & 15, q4 = lane >> 4;
  bf16x8 qf[2][3];
#pragma unroll
  for (int tm = 0; tm < 2; ++tm)
#pragma unroll
    for (int ks = 0; ks < 3; ++ks) qf[tm][ks] = *(const bf16x8*)(qm + (size_t)(w * 32 + tm * 16 + r) * 384 + ks * 32 + q4 * 8);
  const int kr0 = tid / 12, kc0 = (tid % 12) * 8, kr1 = (tid + 256) / 12, kc1 = ((tid + 256) % 12) * 8, kr2 = (tid + 512) / 12, kc2 = ((tid + 512) % 12) * 8;
  const int vr0 = tid >> 3, vc0 = (tid & 7) * 8, vr1 = vr0 + 32;
  uint4 rk0, rk1, rk2, rv0, rv1;
#define MLA_LOAD(kt_) { const u16* kb2 = kb + (size_t)(kt_) * 64 * 384; \
    rk0 = *(const uint4*)(kb2 + (size_t)kr0 * 384 + kc0); rk1 = *(const uint4*)(kb2 + (size_t)kr1 * 384 + kc1); rk2 = *(const uint4*)(kb2 + (size_t)kr2 * 384 + kc2); \
    rv0 = *(const uint4*)(vt + (size_t)vr0 * S + (kt_) * 64 + vc0); rv1 = *(const uint4*)(vt + (size_t)vr1 * S + (kt_) * 64 + vc0); }
#define MLA_WRITE(b_) { u16* sK_ = sKV + (b_) * BUF; u16* sV_ = sK_ + 64 * 104; \
    *(uint4*)(sK_ + kr0 * 104 + kc0) = rk0; *(uint4*)(sK_ + kr1 * 104 + kc1) = rk1; *(uint4*)(sK_ + kr2 * 104 + kc2) = rk2; \
    *(uint4*)(sV_ + vr0 * 72 + vc0) = rv0; *(uint4*)(sV_ + vr1 * 72 + vc0) = rv1; }
  const int nkt = S >> 6;
  MLA_LOAD(0);
  __syncthreads();
  MLA_WRITE(0);
  MLA_LOAD(1);
  __syncthreads();
  f32x4 o[2][4];
  zero_acc(o);
  float m0 = -1e30f, m1 = -1e30f, l0 = 0.f, l1 = 0.f;
  for (int kt = 0; kt < nkt; ++kt) {
    const int cur = kt & 1;
    const u16* sK = sKV + cur * BUF;
    const u16* sVT = sK + 64 * 104;
    f32x4 s[2][4];
    zero_acc(s);
    __builtin_amdgcn_s_setprio(1);
#pragma unroll
    for (int ks = 0; ks < 3; ++ks) {
      bf16x8 bfr[4];
#pragma unroll
      for (int i = 0; i < 4; ++i) bfr[i] = *(const bf16x8*)(sK + (i * 16 + r) * 104 + ks * 32 + q4 * 8);
#pragma unroll
      for (int tm = 0; tm < 2; ++tm)
#pragma unroll
        for (int tn = 0; tn < 4; ++tn) s[tm][tn] = __builtin_amdgcn_mfma_f32_16x16x32_bf16(bfr[tn], qf[tm][ks], s[tm][tn], 0, 0, 0);
    }
    __builtin_amdgcn_s_setprio(0);
    mla_softmax(s[0], o[0], m0, l0);
    mla_softmax(s[1], o[1], m1, l1);
    __builtin_amdgcn_s_setprio(1);
#pragma unroll
    for (int kp = 0; kp < 2; ++kp) {
      bf16x8 pa0 = pack8(s[0][2 * kp], s[0][2 * kp + 1]), pa1 = pack8(s[1][2 * kp], s[1][2 * kp + 1]);
#pragma unroll
      for (int td = 0; td < 4; ++td) {
        bf16x8 vb = *(const bf16x8*)(sVT + (td * 16 + r) * 72 + kp * 32 + q4 * 8);
        o[0][td] = __builtin_amdgcn_mfma_f32_16x16x32_bf16(vb, pa0, o[0][td], 0, 0, 0);
        o[1][td] = __builtin_amdgcn_mfma_f32_16x16x32_bf16(vb, pa1, o[1][td], 0, 0, 0);
      }
    }
    __builtin_amdgcn_s_setprio(0);
    if (kt + 1 < nkt) {
      MLA_WRITE(cur ^ 1);
      if (kt + 2 < nkt) MLA_LOAD(kt + 2);
    }
    __syncthreads();
  }
#undef MLA_LOAD
#undef MLA_WRITE
#pragma unroll
  for (int tm = 0; tm < 2; ++tm) {
    float l = tm ? l1 : l0;
    l += __shfl_xor(l, 16);
    l += __shfl_xor(l, 32);
    float inv = 1.f / l;
    size_t tok = tokb + qb * 128 + w * 32 + tm * 16 + r;
#pragma unroll
    for (int tn = 0; tn < 4; ++tn) {
      f32x4 v = o[tm][tn];
      v[0] *= inv; v[1] *= inv; v[2] *= inv; v[3] *= inv;
      *(uint2*)(z + tok * ZW + Z_CQ + hd * 64 + tn * 16 + q4 * 4) = pack4(v);
    }
  }
}

DI void ph_fgemm(const Params& p, int item, char* smem) {
  int bi, mt, nt, S;
  if (item < 256) { bi = item >> 6; mt = (item >> 2) & 15; nt = item & 3; S = 4096; }
  else { int it = item - 256; bi = 4 + (it >> 5); mt = (it >> 2) & 7; nt = it & 3; S = 2048; }
  const size_t tokb = tok0_of_batch(bi);
  const int H = S >> 1;
  const int rmul = S == 4096 ? 1 : 2;
  const u16* dft = (const u16*)(p.ws + OFF_DFT);
  const u16* pq = (const u16*)(p.ws + OFF_PQT) + tokb * 512;
  u16* z = (u16*)(p.ws + OFF_RB);
  auto la = [&](int row, int k) {
    int j = (mt * 128 + row) * rmul;
    int kk = k < H ? k : 2048 + (k - H);
    return *(const uint4*)(dft + (size_t)j * 4096 + kk);
  };
  auto lb = [&](int n, int k) {
    int c = nt * 64 + n;
    return k < H ? *(const uint4*)(pq + (size_t)c * S + k) : *(const uint4*)(pq + (size_t)(256 + c) * S + (k - H));
  };
  const float nrm = rsqrtf((float)S * 64.f);
  auto epi = [&](f32x4 (&a1)[4][2], f32x4 (&a2)[4][2], int wm, int wn, int lane) {
    const int r = lane & 15, q = lane >> 4;
#pragma unroll
    for (int tm = 0; tm < 4; ++tm) {
      int m = wm * 64 + tm * 16 + r;
      int j = mt * 128 + m;
      float sg = (j & 1) ? -1.f : 1.f;
#pragma unroll
      for (int tn = 0; tn < 2; ++tn) {
        int c = nt * 64 + wn * 32 + tn * 16 + q * 4;
        f32x4 v1, v2;
#pragma unroll
        for (int jj = 0; jj < 4; ++jj) {
          float pm = sg * bf2f(pq[(size_t)(c + jj) * S + H]);
          v1[jj] = (a1[tm][tn][jj] + a2[tm][tn][jj] + pm) * nrm;
          v2[jj] = (a1[tm][tn][jj] - a2[tm][tn][jj] + pm) * nrm;
        }
        *(uint2*)(z + (tokb + j) * ZW + Z_DK0 + c) = pack4(v1);
        if (j > 0) *(uint2*)(z + (tokb + S - j) * ZW + Z_DK0 + c) = pack4(v2);
      }
    }
  };
  gemm_tile2_(p.wv, smem, S >> 6, la, lb, epi);
}

DI void ph_fmid(const Params& p, int item) {
  const int bi = item;
  const int S = bi < 4 ? 4096 : 2048, H = S >> 1;
  const size_t tokb = tok0_of_batch(bi);
  const u16* pq = (const u16*)(p.ws + OFF_PQT) + tokb * 512;
  u16* z = (u16*)(p.ws + OFF_RB);
  const int c = ltid();
  const u16* rp = pq + (size_t)c * S;
  float se = 0.f, so = 0.f;
#pragma unroll 8
  for (int k = 0; k < H; k += 8) {
    uint4 v = *(const uint4*)(rp + k);
    unsigned w[4] = {v.x, v.y, v.z, v.w};
#pragma unroll
    for (int e = 0; e < 4; ++e) { se += blo(w[e]); so += bhi(w[e]); }
  }
  float f = (se - so + bf2f(rp[H])) * rsqrtf((float)S * 64.f);
  z[(tokb + H) * ZW + Z_DK0 + c] = f2bf(f);
}

DI void ph_comb(const Params& p, int item) {
  const int tid = ltid();
  const size_t tok = (size_t)item * 128 + (tid >> 1);
  u16* z = (u16*)(p.ws + OFF_RB) + tok * ZW;
  const float* lse = (const float*)(p.ws + OFF_LSE);
#pragma unroll
  for (int hh = 0; hh < 2; ++hh) {
    int hd = (tid & 1) * 2 + hh;
    float l0 = lse[((size_t)0 * NTOK + tok) * 4 + hd], l1 = lse[((size_t)1 * NTOK + tok) * 4 + hd], l2 = lse[((size_t)2 * NTOK + tok) * 4 + hd];
    float mx = fmaxf(l0, fmaxf(l1, l2));
    float w0 = __expf(l0 - mx), w1 = __expf(l1 - mx), w2 = __expf(l2 - mx);
    float inv = 1.f / (w0 + w1 + w2);
    w0 *= inv; w1 *= inv; w2 *= inv;
#pragma unroll
    for (int c8 = 0; c8 < 8; ++c8) {
      u16* a = z + hd * 64 + c8 * 8;
      uint4 v0 = *(const uint4*)(a + 1280), v1 = *(const uint4*)(a + 1792), v2 = *(const uint4*)(a + 2048);
      unsigned x0[4] = {v0.x, v0.y, v0.z, v0.w}, x1[4] = {v1.x, v1.y, v1.z, v1.w}, x2[4] = {v2.x, v2.y, v2.z, v2.w}, o[4];
#pragma unroll
      for (int e = 0; e < 4; ++e)
        o[e] = pack2(w0 * blo(x0[e]) + w1 * blo(x1[e]) + w2 * blo(x2[e]), w0 * bhi(x0[e]) + w1 * bhi(x1[e]) + w2 * bhi(x2[e]));
      *(uint4*)(a + 1280) = make_uint4(o[0], o[1], o[2], o[3]);
    }
  }
}

DI void ph_retout(const Params& p, int item, int layer, char* smem, bool dry = false) {
  const int hd = item & 3, tile = item >> 2;
  u16* z = (u16*)(p.ws + OFF_RB) + (size_t)tile * 128 * ZW;
  const float* rs = (const float*)(p.ws + OFF_RS) + (size_t)item * 2 * 4096;
  u16* sQ = (u16*)smem;
  u16* sK = sQ + 128 * 72;
  u16* sVT = sK + 128 * 72;
  u16* sSf = sVT + 64 * 136;
  u16* sSb = sSf + 64 * 72;
  u16* sS = sSf;
  const int tid = ltid(), lane = tid & 63, w = tid >> 6, r = lane & 15, q4 = lane >> 4;
  const float lf = logsig(p.dec_f[layer * 4 + hd]), lb = logsig(p.dec_b[layer * 4 + hd]);
  __syncthreads();
#pragma unroll
  for (int i = 0; i < 4; ++i) {
    int c = tid + 256 * i, row = c >> 3, kc = (c & 7) * 8;
    *(uint4*)(sQ + row * 72 + kc) = *(const uint4*)(z + (size_t)row * ZW + Z_RQ + hd * 64 + kc);
    *(uint4*)(sK + row * 72 + kc) = *(const uint4*)(z + (size_t)row * ZW + Z_RK + hd * 64 + kc);
  }
#pragma unroll
  for (int i = 0; i < 2; ++i) {
    int c = tid + 256 * i, jp = c & 63, kc = (c >> 6) * 8;
    uint4 v0 = *(const uint4*)(z + (size_t)(2 * jp) * ZW + Z_RV + hd * 64 + kc);
    uint4 v1 = *(const uint4*)(z + (size_t)(2 * jp + 1) * ZW + Z_RV + hd * 64 + kc);
    unsigned w0[4] = {v0.x, v0.y, v0.z, v0.w}, w1[4] = {v1.x, v1.y, v1.z, v1.w};
#pragma unroll
    for (int e = 0; e < 4; ++e) {
      *(unsigned*)(sVT + (kc + 2 * e) * 136 + 2 * jp) = (w0[e] & 0xffffu) | (w1[e] << 16);
      *(unsigned*)(sVT + (kc + 2 * e + 1) * 136 + 2 * jp) = (w0[e] >> 16) | (w1[e] & 0xffff0000u);
    }
  }
#pragma unroll
  for (int i = 0; i < 4; ++i) {
    int c = tid + 256 * i, e = c >> 4, d = (c & 15) * 4;
    float4 a = *(const float4*)(rs + e * 64 + d), b = *(const float4*)(rs + 4096 + e * 64 + d);
    *(uint2*)(sSf + e * 72 + d) = make_uint2(pack2(a.x, a.y), pack2(a.z, a.w));
    *(uint2*)(sSb + e * 72 + d) = make_uint2(pack2(b.x, b.y), pack2(b.z, b.w));
  }
  __syncthreads();
  f32x4 oc[2][1][4];
#pragma unroll
  for (int h = 0; h < 2; ++h) {
    f32x4 cf[1][4], cb[1][4];
    zero_acc(cf);
    zero_acc(cb);
    mma<1, 4>(sQ + (h * 64 + w * 16) * 72, 72, sSf, 72, 2, cf, lane);
    mma<1, 4>(sQ + (h * 64 + w * 16) * 72, 72, sSb, 72, 2, cb, lane);
    int i = h * 64 + w * 16 + r;
    float rf = __expf((float)(i + 1) * lf), rb = __expf((float)(128 - i) * lb);
#pragma unroll
    for (int tn = 0; tn < 4; ++tn)
#pragma unroll
      for (int jj = 0; jj < 4; ++jj) oc[h][0][tn][jj] = rf * cf[0][tn][jj] + rb * cb[0][tn][jj];
  }
#pragma unroll
  for (int h = 0; h < 2; ++h) {
    const int i = h * 64 + w * 16 + r;
    {
      f32x4 s[1][8];
      zero_acc(s);
      mma<1, 8>(sQ + (h * 64 + w * 16) * 72, 72, sK, 72, 2, s, lane);
#pragma unroll
      for (int tn = 0; tn < 8; ++tn)
#pragma unroll
        for (int jj = 0; jj < 4; ++jj) {
          int j = tn * 16 + q4 * 4 + jj;
          float dcy = i >= j ? __expf((float)(i - j) * lf) : __expf((float)(j - i) * lb);
          s[0][tn][jj] *= dcy;
        }
#pragma unroll
      for (int kp = 0; kp < 4; ++kp) {
        bf16x8 pa = pack8(s[0][2 * kp], s[0][2 * kp + 1]);
#pragma unroll
        for (int td = 0; td < 4; ++td) {
          bf16x8 vb = ldvt2(sVT + (td * 16 + r) * 136, kp * 32 + q4 * 4, kp * 32 + 16 + q4 * 4);
          oc[h][0][td] = __builtin_amdgcn_mfma_f32_16x16x32_bf16(vb, pa, oc[h][0][td], 0, 0, 0);
        }
      }
    }
    float ss = 0.f;
#pragma unroll
    for (int tn = 0; tn < 4; ++tn)
#pragma unroll
      for (int jj = 0; jj < 4; ++jj) ss += oc[h][0][tn][jj] * oc[h][0][tn][jj];
    ss += __shfl_xor(ss, 16);
    ss += __shfl_xor(ss, 32);
    float rn = rsqrtf(ss * (1.f / 64.f) + EPS);
#pragma unroll
    for (int tn = 0; tn < 4; ++tn) {
      u16* gp = z + (size_t)i * ZW + Z_RG + hd * 64 + tn * 16 + q4 * 4;
      uint2 gv = *(const uint2*)gp;
      float g0 = blo(gv.x), g1 = bhi(gv.x), g2 = blo(gv.y), g3 = bhi(gv.y);
      f32x4 v = oc[h][0][tn];
      v[0] *= rn * fsilu(g0);
      v[1] *= rn * fsilu(g1);
      v[2] *= rn * fsilu(g2);
      v[3] *= rn * fsilu(g3);
      if (dry) *(uint2*)((u16*)p.out + ((size_t)tile * 128 + i) * 1024 + hd * 64 + tn * 16 + q4 * 4) = pack4(v);
      else *(uint2*)gp = pack4(v);
    }
  }
}

DI void ph_wout(const Params& p, int item, int layer, char* smem) {
  const int nt = item & 7, tile = item >> 3;
  const u16* z = (const u16*)(p.ws + OFF_RB) + (size_t)tile * 128 * ZW;
  const u16* wt = (const u16*)(p.ws + OFF_WT + layer * WT_LAYER + WT_OUT) + (size_t)nt * 128 * 1024;
  u16* y = (u16*)(p.ws + OFF_RA) + (size_t)tile * 128 * 1024 + nt * 128;
  auto la = [&](int row, int k) { return *(const uint4*)(z + (size_t)row * ZW + Z_RG + k); };
  auto lb = [&](int n, int k) { return *(const uint4*)(wt + (size_t)n * 1024 + k); };
  auto epi = [&](f32x4 (&acc)[4][4], int wm, int wn, int lane) {
    const int r = lane & 15, q = lane >> 4;
#pragma unroll
    for (int tm = 0; tm < 4; ++tm) {
      int m = wm * 64 + tm * 16 + r;
#pragma unroll
      for (int tn = 0; tn < 4; ++tn) *(uint2*)(y + (size_t)m * 1024 + wn * 64 + tn * 16 + q * 4) = pack4(acc[tm][tn]);
    }
  };
  gemm_tile_(p.wv, smem, 16, la, lb, epi);
}

constexpr int N_UPM = 676;
DI void ph_up(const Params& p, int item, int layer, char* smem) {
  const int nt = item % 44, mtile = item / 44;
  int bi, mt, S;
  if (mtile < 132) { bi = mtile / 33; mt = mtile % 33; S = 4096; }
  else { int t = mtile - 132; bi = 4 + t / 17; mt = t % 17; S = 2048; }
  const size_t tokb = tok0_of_batch(bi);
  const u16* h2 = (const u16*)(p.ws + OFF_RB + RB_H2) + tokb * 1024;
  const u16* wt = (const u16*)(p.ws + OFF_WT + layer * WT_LAYER + WT_UP);
  u16* gated = (u16*)(p.ws + OFF_RB + RB_GATED) + tokb * DFF;
  const int pbase = 126 * mt - 1;
  auto la = [&](int row, int k) {
    int pos = pbase + row;
    uint4 v = make_uint4(0, 0, 0, 0);
    if (pos >= 0 && pos < S) v = *(const uint4*)(h2 + (size_t)pos * 1024 + k);
    return v;
  };
  auto lb = [&](int n, int k) {
    int nn = n < 64 ? nt * 64 + n : DFF + nt * 64 + (n - 64);
    return *(const uint4*)(wt + (size_t)nn * 1024 + k);
  };
  auto epi = [&](f32x4 (&acc)[4][4], int wm, int wn, int lane) {
    const int r = lane & 15, q = lane >> 4, tid = ltid();
    u16* sU = (u16*)smem;
    __syncthreads();
#pragma unroll
    for (int tm = 0; tm < 4; ++tm) {
      int m = wm * 64 + tm * 16 + r;
#pragma unroll
      for (int tn = 0; tn < 4; ++tn) *(uint2*)(sU + m * 136 + wn * 64 + tn * 16 + q * 4) = pack4(acc[tm][tn]);
    }
    __syncthreads();
    const int c2 = (tid & 31) * 2, rb = tid >> 5;
    const int na = nt * 64 + c2, nb = DFF + na;
    const float* cw = p.conv_w + (size_t)layer * 3 * 5632;
    const float* cbias = p.conv_b + (size_t)layer * 5632;
    float wa[3][2], wb[3][2], ba[2], bb[2];
#pragma unroll
    for (int t = 0; t < 3; ++t) { wa[t][0] = cw[t * 5632 + na]; wa[t][1] = cw[t * 5632 + na + 1]; wb[t][0] = cw[t * 5632 + nb]; wb[t][1] = cw[t * 5632 + nb + 1]; }
    ba[0] = cbias[na]; ba[1] = cbias[na + 1]; bb[0] = cbias[nb]; bb[1] = cbias[nb + 1];
    for (int i = 0; i < 16; ++i) {
      int rr = rb + 8 * i;
      int pos = pbase + rr;
      if (rr >= 1 && rr <= 126 && pos < S) {
        float a0 = ba[0], a1 = ba[1], b0 = bb[0], b1 = bb[1];
#pragma unroll
        for (int t = 0; t < 3; ++t) {
          unsigned ua = *(const unsigned*)(sU + (rr - 1 + t) * 136 + c2);
          unsigned ub = *(const unsigned*)(sU + (rr - 1 + t) * 136 + 64 + c2);
          a0 += wa[t][0] * blo(ua); a1 += wa[t][1] * bhi(ua);
          b0 += wb[t][0] * blo(ub); b1 += wb[t][1] * bhi(ub);
        }
        float g0 = fsilu(a0) * b0, g1 = fsilu(a1) * b1;
        *(unsigned*)(gated + (size_t)pos * DFF + na) = pack2(g0, g1);
      }
    }
  };
  gemm_tile_(p.wv, smem, 16, la, lb, epi);
}

DI void ph_down(const Params& p, int item, int layer, char* smem) {
  const int nt = item & 7, tile = item >> 3;
  const u16* a = (const u16*)(p.ws + OFF_RB + RB_GATED) + (size_t)tile * 128 * DFF;
  const u16* wt = (const u16*)(p.ws + OFF_WT + layer * WT_LAYER + WT_DOWN) + (size_t)nt * 128 * DFF;
  u16* y = (u16*)(p.ws + OFF_RA) + (size_t)tile * 128 * 1024 + nt * 128;
  auto la = [&](int row, int k) { return *(const uint4*)(a + (size_t)row * DFF + k); };
  auto lb = [&](int n, int k) { return *(const uint4*)(wt + (size_t)n * DFF + k); };
  auto epi = [&](f32x4 (&acc)[4][4], int wm, int wn, int lane) {
    const int r = lane & 15, q = lane >> 4;
#pragma unroll
    for (int tm = 0; tm < 4; ++tm) {
      int m = wm * 64 + tm * 16 + r;
#pragma unroll
      for (int tn = 0; tn < 4; ++tn) *(uint2*)(y + (size_t)m * 1024 + wn * 64 + tn * 16 + q * 4) = pack4(acc[tm][tn]);
    }
  };
  gemm_tile_(p.wv, smem, 44, la, lb, epi);
}


namespace g8 {
#define G8_LAS __attribute__((address_space(3)))
constexpr int BM = 256, BK = 64, HALF = 128, HTB = HALF * BK * 2, STAGE_BYTES = 8 * HTB, NXCD = 8, WGM = 8;
DI int lds_byte(int r, int c) { const int st = (r >> 4) * 2 + (c >> 5), rr = r & 15, cc = c & 31, ob = rr * 64 + cc * 2; return st * 1024 + (ob ^ (((ob >> 9) & 1) << 5)); }
DI void stage_rc(int b, int& R, int& C) { const int st = b / 1024, sb = b % 1024, swz = sb ^ (((sb >> 9) & 1) << 5); R = (st >> 1) * 16 + swz / 64; C = (st & 1) * 32 + (swz % 64) / 2; }
struct Unit { int pm, pn; };
struct Order {
  int nM, nN, nwg, G, c;
  DI bool next(int i, Unit& u) const {
    const long L = (long)i * G + c;
    if (L >= nwg) return false;
    int wgid = (int)L;
    { const int q = nwg / NXCD, r = nwg % NXCD, xcd = wgid % NXCD, off = wgid / NXCD; wgid = (xcd < r ? xcd * (q + 1) : r * (q + 1) + (xcd - r) * q) + off; }
    const int nig = WGM * nN, gid = wgid / nig, fm = gid * WGM, gsz = (nM - fm) < WGM ? (nM - fm) : WGM;
    u.pm = fm + ((wgid % nig) % gsz);
    u.pn = (wgid % nig) / gsz;
    return true;
  }
};
template <int lda, int ldb, int K, int nM, int nN, class Epi>
DI void gemm_phase(int wv_, G8_LAS unsigned char* lds, const u16* A, const u16* Bt, const Epi& E) {
  int tid_ = (wv_ << 6) | lane_now();
  asm volatile("" : "+v"(tid_));
  const int tid = tid_, wid = __builtin_amdgcn_readfirstlane(tid >> 6), lane = tid & 63, wr = wid >> 2, wc = wid & 3, fr = lane & 15, fq = lane >> 4;
  const int nt = K / BK;
  Order S;
  S.nM = nM; S.nN = nN; S.nwg = nM * nN; S.G = gridDim.x; S.c = blockIdx.x;
  unsigned voffA[2], voffB[2];
#pragma unroll
  for (int i = 0; i < 2; ++i) { int R, C; stage_rc(tid * 16 + i * 8192, R, C); voffA[i] = (unsigned)(R * lda + C) * 2u; voffB[i] = (unsigned)(R * ldb + C) * 2u; }
  const size_t kstep = (size_t)(BK * 2);
  const size_t hstepA = (size_t)HALF * lda * 2, tstepA = 2 * hstepA, hstepB = (size_t)HALF * ldb * 2, tstepB = 2 * hstepB;
  const unsigned ldsw = (unsigned)wid * 1024u;
  const int aoff = lds_byte(wr * 64 + fr, fq * 8), boff = lds_byte(wc * 32 + fr, fq * 8);
#define G8_SA(b, h) (((b) * 2 + (h)) * HTB)
#define G8_SB(b, h) ((4 + (b) * 2 + (h)) * HTB)
#define G8_STAGE(bufoff, gbase, voff) do { _Pragma("unroll") for (int _i = 0; _i < 2; ++_i) \
    __builtin_amdgcn_global_load_lds((const unsigned*)((const char*)(gbase) + (voff)[_i]), (G8_LAS unsigned*)(lds + (bufoff) + ldsw + _i * 8192), 16, 0, 0); } while (0)
#define G8_LDA(dst, b, h) do { _Pragma("unroll") for (int m = 0; m < 4; ++m) _Pragma("unroll") for (int k = 0; k < 2; ++k) dst[m][k] = *(const G8_LAS bf16x8*)(lds + G8_SA(b, h) + aoff + m * 2048 + k * 1024); } while (0)
#define G8_LDB(dst, b, h) do { _Pragma("unroll") for (int n = 0; n < 2; ++n) _Pragma("unroll") for (int k = 0; k < 2; ++k) dst[n][k] = *(const G8_LAS bf16x8*)(lds + G8_SB(b, h) + boff + n * 2048 + k * 1024); } while (0)
#define G8_MMA(ai, bj, At, Bt) do { __builtin_amdgcn_s_setprio(1); _Pragma("unroll") for (int m = 0; m < 4; ++m) _Pragma("unroll") for (int n = 0; n < 2; ++n) _Pragma("unroll") for (int k = 0; k < 2; ++k) \
    acc[ai][bj][m][n] = __builtin_amdgcn_mfma_f32_16x16x32_bf16(Bt[n][k], At[m][k], acc[ai][bj][m][n], 0, 0, 0); __builtin_amdgcn_s_setprio(0); } while (0)
#define G8_WAIT_V(n) asm volatile("s_waitcnt vmcnt(" #n ")" ::: "memory")
#define G8_WAIT_L(n) asm volatile("s_waitcnt lgkmcnt(" #n ")" ::: "memory")
#define G8_BAR __builtin_amdgcn_s_barrier()
#define G8_SCHED __builtin_amdgcn_sched_barrier(0)
  Unit cur, nxt;
  int ui = 0;
  if (!S.next(0, cur)) return;
  f32x4 acc[2][2][4][2];
  float zz_ = 0.f;
  asm volatile("" : "+v"(zz_));
#pragma unroll
  for (int a = 0; a < 2; ++a)
#pragma unroll
    for (int b = 0; b < 2; ++b)
#pragma unroll
      for (int m = 0; m < 4; ++m)
#pragma unroll
        for (int n = 0; n < 2; ++n) acc[a][b][m][n] = (f32x4){zz_, zz_, zz_, zz_};
  bf16x8 At[4][2], B0[2][2], B1[2][2];
  const char* cA = (const char*)A + (size_t)cur.pm * tstepA;
  const char* cB = (const char*)Bt + (size_t)cur.pn * tstepB;
  G8_STAGE(G8_SB(0, 0), cB, voffB); G8_STAGE(G8_SA(0, 0), cA, voffA); G8_STAGE(G8_SB(0, 1), cB + hstepB, voffB); G8_STAGE(G8_SA(0, 1), cA + hstepA, voffA);
  if (wr == 1) G8_BAR;
  G8_WAIT_V(4); G8_BAR;
  G8_STAGE(G8_SB(1, 0), cB + kstep, voffB); G8_STAGE(G8_SA(1, 0), cA + kstep, voffA); G8_STAGE(G8_SB(1, 1), cB + hstepB + kstep, voffB);
  G8_WAIT_V(6); G8_BAR;
  for (;;) {
    const bool has_next = S.next(ui + 1, nxt);
    const char* nA = has_next ? (const char*)A + (size_t)nxt.pm * tstepA : cA;
    const char* nB = has_next ? (const char*)Bt + (size_t)nxt.pn * tstepB : cB;
    for (int t = 0; t < nt; t += 2) {
      const bool last = (t == nt - 2);
      const char* a1 = cA + (size_t)(t + 1) * kstep;
      const char* a2 = last ? nA : cA + (size_t)(t + 2) * kstep;
      const char* b2 = last ? nB : cB + (size_t)(t + 2) * kstep;
      const char* a3 = a2 + kstep;
      const char* b3 = b2 + kstep;
      G8_LDB(B0, 0, 0); G8_SCHED; G8_LDA(At, 0, 0); G8_STAGE(G8_SA(1, 1), a1 + hstepA, voffA);
      G8_WAIT_L(8); G8_BAR; G8_WAIT_L(0); G8_MMA(0, 0, At, B0); G8_BAR; G8_SCHED;
      G8_LDB(B1, 0, 1); G8_STAGE(G8_SB(0, 0), b2, voffB);
      G8_BAR; G8_WAIT_L(0); G8_MMA(0, 1, At, B1); G8_BAR;
      G8_LDA(At, 0, 1); G8_STAGE(G8_SA(0, 0), a2, voffA);
      G8_BAR; G8_WAIT_L(0); G8_MMA(1, 0, At, B0); G8_BAR; G8_SCHED;
      G8_STAGE(G8_SB(0, 1), b2 + hstepB, voffB);
      G8_WAIT_V(6); G8_BAR; G8_MMA(1, 1, At, B1); G8_BAR;
      G8_LDB(B0, 1, 0); G8_SCHED; G8_LDA(At, 1, 0); G8_STAGE(G8_SA(0, 1), a2 + hstepA, voffA);
      G8_WAIT_L(8); G8_BAR; G8_WAIT_L(0); G8_MMA(0, 0, At, B0); G8_BAR; G8_SCHED;
      G8_LDB(B1, 1, 1); G8_STAGE(G8_SB(1, 0), b3, voffB);
      G8_BAR; G8_WAIT_L(0); G8_MMA(0, 1, At, B1); G8_BAR;
      G8_LDA(At, 1, 1); G8_STAGE(G8_SA(1, 0), a3, voffA);
      G8_BAR; G8_WAIT_L(0); G8_MMA(1, 0, At, B0); G8_BAR; G8_SCHED;
      G8_STAGE(G8_SB(1, 1), b3 + hstepB, voffB);
      G8_WAIT_V(6); G8_BAR; G8_MMA(1, 1, At, B1); G8_BAR;
    }
    E(acc, cur, wr, wc, fr, fq);
    if (!has_next) break;
#pragma unroll
    for (int a = 0; a < 2; ++a)
#pragma unroll
      for (int b = 0; b < 2; ++b)
#pragma unroll
        for (int m = 0; m < 4; ++m)
#pragma unroll
          for (int n = 0; n < 2; ++n) acc[a][b][m][n] = (f32x4){zz_, zz_, zz_, zz_};
    cur = nxt; cA = nA; cB = nB; ++ui;
  }
  G8_WAIT_V(0);
  if (wr == 0) G8_BAR;
  G8_BAR;
}
struct EpiStore {
  u16* O; int ldc;
  DI void operator()(const f32x4 (&acc)[2][2][4][2], const Unit& u, int wr, int wc, int fr, int fq) const {
#pragma unroll
    for (int ai = 0; ai < 2; ++ai)
#pragma unroll
      for (int m = 0; m < 4; ++m) {
        u16* rowp = O + (size_t)(u.pm * BM + ai * HALF + wr * 64 + m * 16 + fr) * ldc + u.pn * BM + wc * 32 + fq * 4;
#pragma unroll
        for (int bj = 0; bj < 2; ++bj)
#pragma unroll
          for (int n = 0; n < 2; ++n) *(uint2*)(rowp + bj * HALF + n * 16) = pack4(acc[ai][bj][m][n]);
      }
  }
};
}


struct EpiWin {
  u16* z; u16* pqt; const float2* tab;
  DI void operator()(f32x4 (&acc)[2][2][4][2], const g8::Unit& u, int wr, int wc, int fr, int fq) const {
#pragma unroll
    for (int ai = 0; ai < 2; ++ai) {
      int bi, S, pos0;
      tile_info(u.pm * 2 + ai, bi, S, pos0);
      u16* pq = pqt + (size_t)tok0_of_batch(bi) * 512;
#pragma unroll
      for (int m = 0; m < 4; ++m) {
        const int rl = wr * 64 + m * 16 + fr;
        const int pos = pos0 + rl;
        const int fpos = pos <= (S >> 1) ? pos : 3 * (S >> 1) - pos;
        const size_t tok = (size_t)(u.pm * 2 + ai) * 128 + rl;
        const float2* tr = tab + pos * 56;
#pragma unroll
        for (int bj = 0; bj < 2; ++bj) {
          const int W0 = u.pn * 256 + bj * 128 + wc * 32;
          f32x4 a0 = acc[ai][bj][m][0], a1 = acc[ai][bj][m][1];
          if (W0 < 512) {
#pragma unroll
            for (int e = 0; e < 4; ++e) {
              pq[(size_t)(W0 + fq * 4 + e) * S + fpos] = f2bf(a0[e]);
              pq[(size_t)(W0 + 16 + fq * 4 + e) * S + fpos] = f2bf(a1[e]);
            }
            continue;
          }
          const int zw = W0 - 512;
          if (zw >= ZW) continue;
          const int zh = zw & ~63;
          if (zh < 512) {
            const float sc = zh >= 256 ? 0.125f : 1.f;
            const int i0 = 16 * (wc & 1) + 4 * fq;
            rope_pair(a0, a1, tr + 24 + 16 * (wc & 1), fq, sc);
            *(uint2*)(z + tok * ZW + zh + i0) = pack4(a0);
            *(uint2*)(z + tok * ZW + zh + 32 + i0) = pack4(a1);
            continue;
          }
          const bool prope = (zh >= 1024 && zh < 1536) || (zh >= 1792 && zh < 2816);
          if (prope) {
            const bool isq = (zh >= 1280 && zh < 1536) || (zh >= 1792 && zh < 2304);
            const float sc = isq ? 0.125f * LOG2E : 1.f;
            if ((wc & 1) == 0) {
#pragma unroll
              for (int e = 0; e < 4; ++e) {
                float2 cs = tr[16 + (fq & 1) * 4 + e];
                float v = a0[e];
                float o = __shfl_xor(v, 32);
                a0[e] = fq < 2 ? v * cs.x - o * cs.y : v * cs.x + o * cs.y;
              }
            }
#pragma unroll
            for (int e = 0; e < 4; ++e) { a0[e] *= sc; a1[e] *= sc; }
          } else if (zw == Z_KR) {
            rope_pair(a0, a1, tr, fq, 1.f);
          }
          *(uint2*)(z + tok * ZW + zw + fq * 4) = pack4(a0);
          *(uint2*)(z + tok * ZW + zw + 16 + fq * 4) = pack4(a1);
        }
      }
    }
  }
};


struct EpiUp {
  u16* gated; const float* cw; const float* cbias; char* xbuf; int wv;
  DI void operator()(f32x4 (&acc)[2][2][4][2], const g8::Unit& u, int wr, int wc, int fr, int fq) const {
    u16* sX = (u16*)xbuf;
    int tid_ = (wv << 6) | lane_now();
    asm volatile("" : "+v"(tid_));
    const int row = tid_ >> 1, hf = tid_ & 1;
    const int T = 254 * u.pm - 1 + row;
    const bool live = row >= 1 && row <= 254 && T < NTOK;
    int pos = 0, S = 4096;
    if (live) { if (T < 16384) { pos = T & 4095; } else { pos = (T - 16384) & 2047; S = 2048; } }
    const bool hasp = pos > 0, hasn = pos < S - 1;
    if (wr == 0) __builtin_amdgcn_s_barrier();
#pragma unroll 1
    for (int wcj = 0; wcj < 4; ++wcj)
#pragma unroll
    for (int nj = 0; nj < 2; ++nj) {
      if (wc == wcj) {
#pragma unroll
        for (int ai = 0; ai < 2; ++ai)
#pragma unroll
          for (int m = 0; m < 4; ++m) {
            int r = ai * 128 + wr * 64 + m * 16 + fr;
            *(uint2*)(sX + r * 32 + fq * 4) = pack4(acc[ai][0][m][nj]);
            *(uint2*)(sX + r * 32 + 16 + fq * 4) = pack4(acc[ai][1][m][nj]);
          }
      }
      __syncthreads();
      if (live) {
        const int ca = u.pn * 128 + wcj * 32 + nj * 16 + hf * 8;
        float oa[8], ob[8];
#pragma unroll
        for (int e = 0; e < 8; ++e) { oa[e] = cbias[ca + e]; ob[e] = cbias[DFF + ca + e]; }
#pragma unroll
        for (int t = 0; t < 3; ++t) {
          if ((t == 0 && !hasp) || (t == 2 && !hasn)) continue;
          uint4 va = *(const uint4*)(sX + (row - 1 + t) * 32 + hf * 8);
          uint4 vb = *(const uint4*)(sX + (row - 1 + t) * 32 + 16 + hf * 8);
          unsigned wa[4] = {va.x, va.y, va.z, va.w}, wb[4] = {vb.x, vb.y, vb.z, vb.w};
#pragma unroll
          for (int e = 0; e < 8; ++e) {
            float ua = (e & 1) ? bhi(wa[e >> 1]) : blo(wa[e >> 1]);
            float ub = (e & 1) ? bhi(wb[e >> 1]) : blo(wb[e >> 1]);
            oa[e] += cw[t * 5632 + ca + e] * ua;
            ob[e] += cw[t * 5632 + DFF + ca + e] * ub;
          }
        }
        unsigned o[4];
#pragma unroll
        for (int e = 0; e < 8; e += 2) {
          float g0 = fsilu(oa[e]) * ob[e], g1 = fsilu(oa[e + 1]) * ob[e + 1];
          o[e >> 1] = pack2(g0, g1);
        }
        *(uint4*)(gated + (size_t)T * DFF + ca) = make_uint4(o[0], o[1], o[2], o[3]);
      }
      __syncthreads();
    }
    if (wr == 1) __builtin_amdgcn_s_barrier();
  }
};


#define XB_TMO      128
#define XB_XCNT(j)  (256  + 64 * (j))
#define XB_XSUB(j)  (1280 + 64 * (j))
#define XB_XGEN(j)  (2304 + 64 * (j))
#define XB_TOP      3328
#define XB_TOPGEN   3392
#define XCD_BAR_WORDS 3456
#define XB_SPIN_CAP (1u << 18)
#define XLAS __attribute__((address_space(3)))
DI unsigned xb_ld(unsigned* p) { return __hip_atomic_load(p, __ATOMIC_RELAXED, __HIP_MEMORY_SCOPE_AGENT); }
DI unsigned xb_add(unsigned* p, unsigned v) { return __hip_atomic_fetch_add(p, v, __ATOMIC_RELAXED, __HIP_MEMORY_SCOPE_AGENT); }
DI unsigned xb_xcc_id() { return (unsigned)__builtin_amdgcn_s_getreg((3 << 11) | 20) & 0xFu; }
#define XB_SPIN(cond, bar) do { unsigned _sp = 0; while (cond) { __builtin_amdgcn_s_sleep(1); \
    if ((++_sp & 255u) == 0u) { if (xb_ld(&(bar)[XB_TMO])) break; if (_sp > XB_SPIN_CAP) { atomicAdd(&(bar)[XB_TMO], 1u); break; } } } } while (0)
struct XcdBarrier { unsigned* bar; unsigned x; volatile XLAS unsigned* st; };
DI XcdBarrier xcd_barrier_post(unsigned* bar, volatile XLAS unsigned* st) {
  XcdBarrier b; b.bar = bar; b.x = xb_xcc_id(); b.st = st;
  if (threadIdx.x == 0) (void)xb_add(&bar[XB_XCNT(b.x)], 1u);
  return b;
}
DI void xcd_barrier_complete(unsigned* bar, unsigned x, unsigned& nloc, unsigned& nx) {
  const unsigned G = gridDim.x * gridDim.y * gridDim.z;
  unsigned sum, cnt, mine, sp = 0u;
  for (;;) {
    sum = 0u; cnt = 0u; mine = 0u;
#pragma unroll
    for (unsigned j = 0; j < 16; ++j) { const unsigned c = xb_ld(&bar[XB_XCNT(j)]); sum += c; cnt += (c > 0u) ? 1u : 0u; mine = (j == x) ? c : mine; }
    if (sum == G) break;
    __builtin_amdgcn_s_sleep(1);
    if ((++sp & 255u) == 0u) { if (xb_ld(&bar[XB_TMO])) break; if (sp > XB_SPIN_CAP) { atomicAdd(&bar[XB_TMO], 1u); break; } }
  }
  nloc = mine > 0u ? mine : 1u; nx = cnt > 0u ? cnt : 1u;
}
DI void xcd_barrier(const XcdBarrier& b) {
  asm volatile("s_waitcnt vmcnt(0)" ::: "memory");
  __syncthreads();
  if (threadIdx.x == 0) {
    unsigned* bar = b.bar;
    __builtin_amdgcn_s_waitcnt(0);
    unsigned nloc = b.st[0], nx = b.st[1];
    if (nloc == 0u) { xcd_barrier_complete(bar, b.x, nloc, nx); b.st[0] = nloc; b.st[1] = nx; }
    const unsigned old = xb_add(&bar[XB_XSUB(b.x)], 1u);
    const unsigned gen = old / nloc;
    if (old + 1u == (gen + 1u) * nloc) {
      __builtin_amdgcn_fence(__ATOMIC_RELEASE, "agent");
      asm volatile("s_waitcnt vmcnt(0)" ::: "memory");
      const unsigned og = xb_add(&bar[XB_TOP], 1u);
      const unsigned tg = og / nx;
      if (og + 1u == (tg + 1u) * nx) xb_add(&bar[XB_TOPGEN], 1u);
      else XB_SPIN(xb_ld(&bar[XB_TOPGEN]) == tg, bar);
      __builtin_amdgcn_fence(__ATOMIC_ACQUIRE, "agent");
      xb_add(&bar[XB_XGEN(b.x)], 1u);
      asm volatile("s_waitcnt vmcnt(0)" ::: "memory");
    } else {
      XB_SPIN(xb_ld(&bar[XB_XGEN(b.x)]) == gen, bar);
      __builtin_amdgcn_fence(__ATOMIC_ACQUIRE, "agent");
      asm volatile("s_waitcnt vmcnt(0)" ::: "memory");
    }
  }
  __syncthreads();
}

#define GSYNC() do { xcd_barrier(xb); if (PROBE & 128) xcd_barrier(xb); } while (0)
template <int layer>
DI void run_layer(const Params& pp, const XcdBarrier& xb, char* smem_all, int wv0) {
  const int hb = wv0 >> 2;
  char* smem = smem_all + hb * HALF_LDS;
  const int vb = blockIdx.x * 2 + hb, nvb = gridDim.x * 2;
#define PH_BEGIN Params p = pp; p.wv = wv0; asm volatile("" : "+s"(p.ws), "+s"(p.out), "+s"(p.wv));
  {
    PH_BEGIN
    __syncthreads();
    EpiWin E{(u16*)(p.ws + OFF_RB), (u16*)(p.ws + OFF_PQT), (const float2*)(p.ws + OFF_TAB)};
    for (int rep_ = 0; rep_ < 1 + (((PROBE >> 8) & 1) && layer == 0 ? 1 : 0); ++rep_)
    g8::gemm_phase<1024, 1024, 1024, 320, 17>(p.wv, (G8_LAS unsigned char*)smem_all, (const u16*)(p.ws + OFF_RA), (const u16*)(p.ws + OFF_WT + layer * WT_LAYER + WT_IN), E);
  }
  GSYNC();
  {
    PH_BEGIN
    int* ctr = (int*)(p.ws + OFF_CTR) + layer * 2 + 0;
    volatile int* slot = (volatile int*)(smem_all + 2 * HALF_LDS);
    for (;;) {
      __syncthreads();
      if (p.wv == 0 && lane_now() == 0) *slot = atomicAdd(ctr, 2);
      __syncthreads();
      const int it = *slot + hb;
      if (it >= N_P2) break;
      int i = it;
      if (i < N_RST) { ph_retscan(p, i, layer, smem); continue; }
      i -= N_RST;
      if (i < N_DIL) { if ((PROBE & 2) && layer == 0) ph_dil(p, i, smem, true); ph_dil(p, i, smem); continue; }
      i -= N_DIL;
      if (i < N_QP) { ph_qproj(p, i, layer, smem); continue; }
      i -= N_QP;
      if (i < N_KVP) { ph_kvproj(p, i, layer, smem); continue; }
      i -= N_KVP;
      ph_pqfold(p, i);
    }
  }
  GSYNC();
  {
    PH_BEGIN
    int* ctr = (int*)(p.ws + OFF_CTR) + layer * 2 + 1;
    volatile int* slot = (volatile int*)(smem_all + 2 * HALF_LDS);
    for (;;) {
      __syncthreads();
      if (p.wv == 0 && lane_now() == 0) *slot = atomicAdd(ctr, 2);
      __syncthreads();
      const int it = *slot + hb;
      if (it >= N_P3) break;
      int i = it;
      if (i < N_FM) { ph_fmid(p, i); continue; }
      i -= N_FM;
      if (i < N_MLA) { if ((PROBE & 4) && layer == 0) ph_mla(p, i, smem); ph_mla(p, i, smem); continue; }
      i -= N_MLA;
      if (i < N_FG) { ph_fgemm(p, i, smem); continue; }
      i -= N_FG;
      if (i < N_RO) { ph_retout(p, i, layer, smem); continue; }
      i -= N_RO;
      ph_comb(p, i);
    }
  }
  GSYNC();
  {
    PH_BEGIN
    __syncthreads();
    g8::EpiStore E{(u16*)(p.ws + OFF_RA), 1024};
    for (int rep_ = 0; rep_ < 1 + (((PROBE >> 9) & 1) && layer == 0 ? 1 : 0); ++rep_)
    g8::gemm_phase<ZW, 1024, 1024, 320, 4>(p.wv, (G8_LAS unsigned char*)smem_all, (const u16*)(p.ws + OFF_RB) + Z_RG, (const u16*)(p.ws + OFF_WT + layer * WT_LAYER + WT_OUT), E);
  }
  GSYNC();
  {
    PH_BEGIN
    for (int it = vb; it < 5120; it += nvb) { if ((PROBE & 32) && layer == 0) ph_ew(p, it, 1, layer); ph_ew(p, it, 1, layer); }
  }
  GSYNC();
  {
    PH_BEGIN
    __syncthreads();
    EpiUp E{(u16*)(p.ws + OFF_RB + RB_GATED), p.conv_w + (size_t)layer * 3 * 5632, p.conv_b + (size_t)layer * 5632, smem_all + 131072, p.wv};
    for (int rep_ = 0; rep_ < 1 + (((PROBE >> 10) & 1) && layer == 0 ? 1 : 0); ++rep_)
    g8::gemm_phase<1024, 1024, 1024, 323, 22>(p.wv, (G8_LAS unsigned char*)smem_all, (const u16*)(p.ws + OFF_RB + RB_H2), (const u16*)(p.ws + OFF_WT + layer * WT_LAYER + WT_UP), E);
  }
  GSYNC();
  {
    PH_BEGIN
    __syncthreads();
    g8::EpiStore E{(u16*)(p.ws + OFF_RA), 1024};
    for (int rep_ = 0; rep_ < 1 + (((PROBE >> 11) & 1) && layer == 0 ? 1 : 0); ++rep_)
    g8::gemm_phase<DFF, DFF, DFF, 320, 4>(p.wv, (G8_LAS unsigned char*)smem_all, (const u16*)(p.ws + OFF_RB + RB_GATED), (const u16*)(p.ws + OFF_WT + layer * WT_LAYER + WT_DOWN), E);
  }
  GSYNC();
  {
    PH_BEGIN
    for (int it = vb; it < 5120; it += nvb) ph_ew(p, it, 2, layer);
  }
}

__global__ void __launch_bounds__(512, 2) mega(Params pp) {
  extern __shared__ __attribute__((aligned(16))) char smem_all[];
  cg::grid_group grid = cg::this_grid();
  const int wv0 = __builtin_amdgcn_readfirstlane(threadIdx.x >> 6);
  volatile XLAS unsigned* xst = (volatile XLAS unsigned*)(smem_all + 2 * HALF_LDS + 16);
  if (threadIdx.x < 2) xst[threadIdx.x] = 0u;
  __syncthreads();
  XcdBarrier xb = xcd_barrier_post((unsigned*)(pp.ws + OFF_BAR), xst);
  {
    const int hb = wv0 >> 2;
    char* smem = smem_all + hb * HALF_LDS;
    const int vb = blockIdx.x * 2 + hb, nvb = gridDim.x * 2;
    {
      PH_BEGIN
      for (int rep = 0; rep < 1 + (PROBE & 1); ++rep)
        for (int it = vb; it < N_PREP; it += nvb) ph_prep(p, it, smem);
    }
    grid.sync();
    {
      PH_BEGIN
      for (int it = vb; it < 5120; it += nvb) ph_ew(p, it, 0, 0);
    }
    GSYNC();
  }
  run_layer<0>(pp, xb, smem_all, wv0);
  GSYNC();
  run_layer<1>(pp, xb, smem_all, wv0);
}

extern "C" void kernel_launch(void* const* d_in, const int* in_sizes, int n_in, void* d_out, int out_size, void* d_ws,
                              size_t ws_size, hipStream_t stream) {
  static int grid_blocks = 0;
  if (!grid_blocks) {
    hipFuncSetAttribute((const void*)mega, hipFuncAttributeMaxDynamicSharedMemorySize, DYN_LDS);
    int dev = 0, cus = 0, per_cu = 0;
    hipGetDevice(&dev);
    hipDeviceGetAttribute(&cus, hipDeviceAttributeMultiprocessorCount, dev);
    hipOccupancyMaxActiveBlocksPerMultiprocessor(&per_cu, mega, 512, DYN_LDS);
    if (per_cu > 1) per_cu = 1;
    if (per_cu < 1) per_cu = 1;
    grid_blocks = cus * per_cu;
  }
  if (ws_size < WS_NEED) { fprintf(stderr, "workspace too small: %zu < %zu\n", ws_size, (size_t)WS_NEED); return; }
  Params p{};
  const float** f = (const float**)&p;
  for (int i = 0; i < 23; ++i) f[i] = (const float*)d_in[i];
  p.out = (float*)d_out;
  p.ws = (char*)d_ws;
#if 0
#else
  hipMemsetAsync((char*)d_ws + OFF_CTR, 0, 4096 + 16384, stream);
  p.ph_lo = 0;
  p.ph_hi = 20;
  void* args[] = {&p};
  hipError_t e = hipLaunchCooperativeKernel((void*)mega, dim3(grid_blocks), dim3(512), args, DYN_LDS, stream);
  if (e != hipSuccess) fprintf(stderr, "cooperative launch failed: %s (grid %d)\n", hipGetErrorString(e), grid_blocks);
#endif
}
```

```cpp
#include <hip/hip_runtime.h>
#include <hip/hip_cooperative_groups.h>
#include <cstdio>
namespace cg = cooperative_groups;

#ifndef PROBE
#define PROBE 0
#endif
#ifndef MULTI
#define MULTI 0
#endif

#define DI __device__ __forceinline__
typedef unsigned short u16;
typedef __attribute__((ext_vector_type(8))) short bf16x8;
typedef __attribute__((ext_vector_type(4))) float f32x4;

constexpr int NTOK = 81920;
constexpr int ZW = 3744;
constexpr int Z_RQ = 0, Z_RK = 256, Z_RV = 512, Z_RG = 768, Z_DK0 = 1024, Z_DQ0 = 1280, Z_CQ = 1536, Z_CKV = 3584, Z_KR = 3712;
__device__ __forceinline__ int zdq(int g) { return g == 0 ? 1280 : 1792 + (g - 1) * 256; }
__device__ __forceinline__ int zdk(int g) { return g == 0 ? 1024 : 2304 + (g - 1) * 256; }
__device__ __forceinline__ int zdv(int g) { return 2816 + g * 256; }
constexpr int DFF = 2816;
constexpr float EPS = 1e-6f;
constexpr float LOG2E = 1.4426950408889634f;
constexpr float LN2 = 0.6931471805599453f;

constexpr size_t OFF_RA = 0;
constexpr size_t OFF_RB = 167772160ull;
constexpr size_t OFF_PQT = OFF_RB + 613416960ull;
constexpr size_t OFF_RS = OFF_RB + 697303040ull;
constexpr size_t OFF_WT = OFF_RS + 83886080ull;
constexpr size_t WT_LAYER = 28639232ull;
constexpr size_t WT_IN = 0, WT_OUT = 8912896ull, WT_UP = 11010048ull, WT_DOWN = 22544384ull, WT_QB = 28311552ull, WT_KVB = 28508160ull;
constexpr size_t OFF_DFT = OFF_WT + 2 * WT_LAYER;
constexpr size_t OFF_TAB = OFF_DFT + 33554432ull;
constexpr size_t OFF_MOD = OFF_TAB + 1835008ull;
constexpr size_t OFF_LSE = OFF_MOD + 1769472ull;
constexpr size_t OFF_CTR = OFF_LSE + 3932160ull;
constexpr size_t OFF_BAR = OFF_CTR + 4096ull;
constexpr size_t WS_NEED = OFF_BAR + 16384ull;
constexpr size_t RA_QM = 0, RA_KB = 62914560ull, RA_VT = 125829120ull;
constexpr size_t RB_H2 = 0, RB_GATED = 169345024ull;

constexpr int HALF_LDS = 73728;
constexpr int DYN_LDS = 2 * HALF_LDS + 64;

struct Params {
  const float *x_p, *x_s, *c_p, *c_s, *w_ada, *b_ada, *n_pre_mix, *w_in, *dec_f, *dec_b, *w_fmix, *q_norm, *w_qb, *kv_norm,
      *w_kvb, *w_out, *n_post_mix, *n_pre_ffn, *w_up, *conv_w, *conv_b, *w_down, *n_post_ffn;
  float* out;
  char* ws;
  int ph_lo, ph_hi, wv, pad_;
};

DI int lane_now() { int l; asm volatile("v_mbcnt_lo_u32_b32 %0, -1, 0\n\tv_mbcnt_hi_u32_b32 %0, -1, %0" : "=v"(l)); return l; }
DI int ltid_w(int wv) { int t = ((wv & 3) << 6) | lane_now(); asm volatile("" : "+v"(t)); return t; }
#define ltid() ltid_w(p.wv)
DI u16 f2bf(float x) { __bf16 h = (__bf16)x; return __builtin_bit_cast(u16, h); }
DI float bf2f(unsigned b) { return __uint_as_float(b << 16); }
typedef __bf16 bf16x2_t __attribute__((ext_vector_type(2)));
typedef float f32x2_t __attribute__((ext_vector_type(2)));
DI unsigned pack2(float a, float b) { f32x2_t v = {a, b}; bf16x2_t r = __builtin_convertvector(v, bf16x2_t); return __builtin_bit_cast(unsigned, r); }
DI float fsilu(float a) { return a * __builtin_amdgcn_rcpf(1.f + __expf(-a)); }
DI uint2 pack4(const f32x4& v) { return make_uint2(pack2(v[0], v[1]), pack2(v[2], v[3])); }
DI float blo(unsigned w) { return __uint_as_float(w << 16); }
DI float bhi(unsigned w) { return __uint_as_float(w & 0xffff0000u); }
DI int tok0_of_batch(int bi) { return bi < 4 ? bi * 4096 : 16384 + (bi - 4) * 2048; }
DI void tile_info(int tile, int& bi, int& S, int& pos0) {
  if (tile < 128) { bi = tile >> 5; S = 4096; pos0 = (tile & 31) << 7; }
  else { int t = tile - 128; bi = 4 + (t >> 4); S = 2048; pos0 = (t & 15) << 7; }
}
DI int batch_of_tok(int tok) { return tok < 16384 ? (tok >> 12) : 4 + ((tok - 16384) >> 11); }

template <int TM, int TN>
DI void mma(const u16* sA, int lda, const u16* sB, int ldb, int ksteps, f32x4 (&acc)[TM][TN], int lane) {
  const int r = lane & 15, q = lane >> 4;
  for (int ks = 0; ks < ksteps; ++ks) {
    bf16x8 a[TM], b[TN];
#pragma unroll
    for (int i = 0; i < TM; ++i) a[i] = *(const bf16x8*)(sA + (i * 16 + r) * lda + ks * 32 + q * 8);
#pragma unroll
    for (int i = 0; i < TN; ++i) b[i] = *(const bf16x8*)(sB + (i * 16 + r) * ldb + ks * 32 + q * 8);
#pragma unroll
    for (int i = 0; i < TM; ++i)
#pragma unroll
      for (int j = 0; j < TN; ++j) acc[i][j] = __builtin_amdgcn_mfma_f32_16x16x32_bf16(b[j], a[i], acc[i][j], 0, 0, 0);
  }
}
template <int TM, int TN>
DI void zero_acc(f32x4 (&acc)[TM][TN]) {
  float zz = 0.f;
  asm volatile("" : "+v"(zz));
#pragma unroll
  for (int i = 0; i < TM; ++i)
#pragma unroll
    for (int j = 0; j < TN; ++j) acc[i][j] = f32x4{zz, zz, zz, zz};
}

template <class LA, class LB, class EP>
DI void gemm_tile_(int wv_, char* smem, int nk, LA loadA, LB loadB, EP epi) {
  u16* sA = (u16*)smem;
  u16* sB = sA + 128 * 72;
  const int tid = ltid_w(wv_), lane = tid & 63, w = tid >> 6, wm = w >> 1, wn = w & 1;
  const int lr = tid >> 3, lk = (tid & 7) * 8;
  uint4 ra[4], rb[4];
  f32x4 acc[4][4];
  zero_acc(acc);
#pragma unroll
  for (int i = 0; i < 4; ++i) { ra[i] = loadA(lr + 32 * i, lk); rb[i] = loadB(lr + 32 * i, lk); }
  for (int kt = 0; kt < nk; ++kt) {
    __syncthreads();
#pragma unroll
    for (int i = 0; i < 4; ++i) {
      *(uint4*)(sA + (lr + 32 * i) * 72 + lk) = ra[i];
      *(uint4*)(sB + (lr + 32 * i) * 72 + lk) = rb[i];
    }
    __syncthreads();
    if (kt + 1 < nk) {
#pragma unroll
      for (int i = 0; i < 4; ++i) { ra[i] = loadA(lr + 32 * i, (kt + 1) * 64 + lk); rb[i] = loadB(lr + 32 * i, (kt + 1) * 64 + lk); }
    }
    mma<4, 4>(sA + wm * 64 * 72, 72, sB + wn * 64 * 72, 72, 2, acc, lane);
  }
  epi(acc, wm, wn, lane);
}

template <class LA, class LB, class EP>
DI void gemm_tile2_(int wv_, char* smem, int nk, LA loadA, LB loadB, EP epi) {
  u16* sA = (u16*)smem;
  u16* sB = sA + 128 * 72;
  const int tid = ltid_w(wv_), lane = tid & 63, w = tid >> 6, wm = w >> 1, wn = w & 1;
  const int lr = tid >> 3, lk = (tid & 7) * 8;
  uint4 ra[4], rb[2];
  f32x4 acc[4][2], acc1[4][2];
  zero_acc(acc);
  zero_acc(acc1);
#pragma unroll
  for (int i = 0; i < 4; ++i) ra[i] = loadA(lr + 32 * i, lk);
#pragma unroll
  for (int i = 0; i < 2; ++i) rb[i] = loadB(lr + 32 * i, lk);
  const int nkh = nk >> 1;
  for (int kt = 0; kt < nk; ++kt) {
    __syncthreads();
#pragma unroll
    for (int i = 0; i < 4; ++i) *(uint4*)(sA + (lr + 32 * i) * 72 + lk) = ra[i];
#pragma unroll
    for (int i = 0; i < 2; ++i) *(uint4*)(sB + (lr + 32 * i) * 72 + lk) = rb[i];
    __syncthreads();
    if (kt + 1 < nk) {
#pragma unroll
      for (int i = 0; i < 4; ++i) ra[i] = loadA(lr + 32 * i, (kt + 1) * 64 + lk);
#pragma unroll
      for (int i = 0; i < 2; ++i) rb[i] = loadB(lr + 32 * i, (kt + 1) * 64 + lk);
    }
    if (kt == nkh) {
#pragma unroll
      for (int i = 0; i < 4; ++i)
#pragma unroll
        for (int j = 0; j < 2; ++j) { acc1[i][j] = acc[i][j]; acc[i][j] = f32x4{0.f, 0.f, 0.f, 0.f}; }
    }
    mma<4, 2>(sA + wm * 64 * 72, 72, sB + wn * 32 * 72, 72, 2, acc, lane);
  }
  epi(acc1, acc, wm, wn, lane);
}

DI void rope_pair(f32x4& a, f32x4& b, const float2* tabrow, int q, float sc) {
#pragma unroll
  for (int jj = 0; jj < 4; ++jj) {
    float2 cs = tabrow[q * 4 + jj];
    float x1 = a[jj], x2 = b[jj];
    a[jj] = (x1 * cs.x - x2 * cs.y) * sc;
    b[jj] = (x2 * cs.x + x1 * cs.y) * sc;
  }
}

constexpr int PI_TRL = 3416, PI_TR = 2 * PI_TRL, PI_FOLD = 128, PI_PAD = 2, PI_MOD = 192, PI_DFT = 256, PI_TAB = 256;
constexpr int N_PREP = PI_TR + PI_FOLD + PI_PAD + PI_MOD + PI_DFT + PI_TAB;

DI int swap45(int c) { return (c & 15) | ((c & 16) << 1) | ((c & 32) >> 1); }
DI void tr_tile_(int wv_, char* smem, const float* src, int lds, int k0, int s0, int nvalid, u16* dst, int ldd, int n0, const float* kscale, bool perm = false) {
  float* t = (float*)smem;
  const int tid = ltid_w(wv_);
  __syncthreads();
#pragma unroll 4
  for (int i = 0; i < 16; ++i) {
    int kr = (tid >> 6) + 4 * i, c = tid & 63;
    float v = (c < nvalid) ? src[(size_t)(k0 + kr) * lds + s0 + c] : 0.f;
    if (kscale) v *= kscale[k0 + kr];
    t[c * 65 + kr] = v;
  }
  __syncthreads();
#pragma unroll 4
  for (int i = 0; i < 16; ++i) {
    int c = (tid >> 6) + 4 * i, kr = tid & 63;
    if (c < nvalid) dst[(size_t)(n0 + (perm ? swap45(c) : c)) * ldd + k0 + kr] = f2bf(t[c * 65 + kr]);
  }
}

DI void ph_prep(const Params& p, int item, char* smem) {
  const int tid = ltid();
  if (item < PI_TR) {
    int layer = item / PI_TRL, it = item % PI_TRL;
    char* wt = p.ws + OFF_WT + layer * WT_LAYER;
    if (it < 1008) {
      int ct = it >> 4, kt = it & 15;
      if (ct >= 16 && ct < 20) return;
      int s0 = ct * 64, zc;
      if (s0 < 1536) zc = s0; else if (s0 < 2048) zc = s0 + 256; else if (s0 < 2304) zc = s0 - 1024; else if (s0 < 3584) zc = s0;
      else if (s0 < 3840) zc = s0 - 2048; else zc = s0 - 256;
      int n0 = 512 + zc;
      int nv = 4000 - s0 < 64 ? 4000 - s0 : 64;
      tr_tile_(p.wv, smem, p.w_in + (size_t)layer * 1024 * 4000, 4000, kt * 64, s0, nv, (u16*)(wt + WT_IN), 1024, n0, nullptr, s0 < 512);
      return;
    }
    it -= 1008;
    if (it < 256) { tr_tile_(p.wv, smem, p.w_out + (size_t)layer * 1024 * 1024, 1024, (it & 15) * 64, (it >> 4) * 64, 64, (u16*)(wt + WT_OUT), 1024, (it >> 4) * 64, nullptr); return; }
    it -= 256;
    if (it < 1408) {
      int s0 = (it >> 4) * 64, n0;
      if (s0 < DFF) n0 = (s0 >> 7) * 256 + (s0 & 127); else { int sb = s0 - DFF; n0 = (sb >> 7) * 256 + 128 + (sb & 127); }
      tr_tile_(p.wv, smem, p.w_up + (size_t)layer * 1024 * 5632, 5632, (it & 15) * 64, s0, 64, (u16*)(wt + WT_UP), 1024, n0, nullptr);
      return;
    }
    it -= 1408;
    if (it < 704) { int kt = it % 44, ct = it / 44; tr_tile_(p.wv, smem, p.w_down + (size_t)layer * 2816 * 1024, 1024, kt * 64, ct * 64, 64, (u16*)(wt + WT_DOWN), 2816, ct * 64, nullptr); return; }
    it -= 704;
    if (it < 24) { int kt = it & 3, ct = it >> 2; tr_tile_(p.wv, smem, p.w_qb + (size_t)layer * 256 * 384, 384, kt * 64, ct * 64, 64, (u16*)(wt + WT_QB), 256, ct * 64, p.q_norm + layer * 256); return; }
    it -= 24;
    { int kt = it & 1, ct = it >> 1; tr_tile_(p.wv, smem, p.w_kvb + (size_t)layer * 128 * 512, 512, kt * 64, ct * 64, 64, (u16*)(wt + WT_KVB), 128, ct * 64, p.kv_norm + layer * 128); return; }
  }
  item -= PI_TR;
  if (item < PI_FOLD) {
    int layer = item >> 6, g = (item >> 4) & 3, cs = (item >> 3) & 1, kc = item & 7;
    float* M = (float*)smem;
    float* ct = M + 4096;
    __syncthreads();
    if (tid < 64) ct[tid] = cospif((float)tid / 32.f);
    __syncthreads();
    const float* Wf = p.w_fmix + ((size_t)layer * 4 + g) * 4096;
    for (int i = 0; i < 16; ++i) {
      int idx = tid + 256 * i, c = idx >> 6, e = idx & 63;
      float a = 0.f;
      for (int c2 = 0; c2 < 64; ++c2) {
        int x = (c * c2) & 63;
        float tv = cs ? ct[(x - 16) & 63] : ct[x];
        a += tv * Wf[c2 * 64 + e];
      }
      M[c * 64 + e] = a;
    }
    __syncthreads();
    const float* W = p.w_in + (size_t)layer * 1024 * 4000 + 1024 + g * 64;
    u16* dst = (u16*)(p.ws + OFF_WT + layer * WT_LAYER + WT_IN);
    int e = tid & 63, kq = tid >> 6;
    for (int i = 0; i < 32; ++i) {
      int k = kc * 128 + kq * 32 + i;
      float a = 0.f;
#pragma unroll 8
      for (int c = 0; c < 64; ++c) a += W[(size_t)k * 4000 + c] * M[c * 64 + e];
      dst[(size_t)(cs * 256 + g * 64 + e) * 1024 + k] = f2bf(a);
    }
    return;
  }
  item -= PI_FOLD;
  if (item < PI_PAD) {
    uint4* dst = (uint4*)(p.ws + OFF_WT + item * WT_LAYER + WT_IN + (size_t)4256 * 1024 * 2);
    for (int i = tid; i < 96 * 1024 * 2 / 16; i += 256) dst[i] = make_uint4(0, 0, 0, 0);
    return;
  }
  item -= PI_PAD;
  if (item < PI_MOD) {
    int layer = item / 96, cb = item % 96;
    float* sC = (float*)smem;
    float* sR = sC + 4608;
    int col = cb * 64 + (tid & 63), kq = tid >> 6;
    float acc[36];
#pragma unroll
    for (int b = 0; b < 36; ++b) acc[b] = 0.f;
    const float* wa = p.w_ada + (size_t)layer * 1024 * 6144;
#pragma unroll 1
    for (int kc = 0; kc < 8; ++kc) {
      __syncthreads();
#pragma unroll 2
      for (int i = 0; i < 18; ++i) {
        int idx = tid + 256 * i, qq = idx / 1152, rem = idx % 1152, b = rem >> 5, kk = rem & 31;
        int k = qq * 256 + kc * 32 + kk;
        float c = b < 4 ? p.c_p[b * 1024 + k] : p.c_s[(b - 4) * 1024 + k];
        sC[idx] = fsilu(c);
      }
      __syncthreads();
#pragma unroll 2
      for (int kk = 0; kk < 32; ++kk) {
        float wv = wa[(size_t)(kq * 256 + kc * 32 + kk) * 6144 + col];
#pragma unroll
        for (int b = 0; b < 36; ++b) acc[b] += sC[(kq * 36 + b) * 32 + kk] * wv;
      }
    }
    __syncthreads();
#pragma unroll
    for (int b = 0; b < 36; ++b) sR[(kq * 36 + b) * 64 + (tid & 63)] = acc[b];
    __syncthreads();
    float* mod = (float*)(p.ws + OFF_MOD) + (size_t)layer * 36 * 6144;
    for (int i = 0; i < 9; ++i) {
      int idx = tid + 256 * i, b = idx >> 6, c = idx & 63;
      float s = sR[(0 * 36 + b) * 64 + c] + sR[(1 * 36 + b) * 64 + c] + sR[(2 * 36 + b) * 64 + c] + sR[(3 * 36 + b) * 64 + c];
      mod[b * 6144 + cb * 64 + c] = s + p.b_ada[layer * 6144 + cb * 64 + c];
    }
    return;
  }
  item -= PI_MOD;
  if (item < PI_DFT) {
    float* tab = (float*)smem;
    __syncthreads();
    for (int i = tid; i < 4096; i += 256) tab[i] = cospif((float)i / 2048.f);
    __syncthreads();
    u16* dft = (u16*)(p.ws + OFF_DFT);
    for (int rr = 0; rr < 16; ++rr) {
      int j = item * 16 + rr;
      for (int i = 0; i < 2; ++i) {
        int ch = tid + 256 * i;
        int kb = (ch & 255) * 8;
        bool sn = ch >= 256;
        unsigned wv[4];
#pragma unroll
        for (int e = 0; e < 8; e += 2) {
          int i0 = (j * (kb + e)) & 4095, i1 = (j * (kb + e + 1)) & 4095;
          float v0 = sn ? -tab[(i0 - 1024) & 4095] : tab[i0];
          float v1 = sn ? -tab[(i1 - 1024) & 4095] : tab[i1];
          wv[e >> 1] = pack2(v0, v1);
        }
        *(uint4*)(dft + (size_t)j * 4096 + ch * 8) = make_uint4(wv[0], wv[1], wv[2], wv[3]);
      }
    }
    return;
  }
  item -= PI_DFT;
  {
    float2* tab = (float2*)(p.ws + OFF_TAB);
    for (int idx = tid; idx < 896; idx += 256) {
      int pos = item * 16 + idx / 56, a = idx % 56;
      float inv;
      if (a < 16) inv = powf(500000.f, -(float)a * 2.f / 32.f);
      else if (a < 24) inv = powf(500000.f, -(float)(a - 16) * 2.f / 16.f);
      else inv = powf(10000.f, -(float)(a - 24) * 2.f / 64.f);
      float ang = (float)pos * inv;
      float s, c;
      sincosf(ang, &s, &c);
      tab[pos * 56 + a] = make_float2(c, s);
    }
  }
}

DI void ph_ew(const Params& p, int item, int mode, int layer) {
  const int tid = ltid(), lane = tid & 63, w = tid >> 6;
  const float* mod = (const float*)(p.ws + OFF_MOD);
  for (int i = 0; i < 4; ++i) {
    int tok = item * 16 + w * 4 + i;
    int bi = batch_of_tok(tok);
    const float* xin;
    if (mode == 0 || (mode == 1 && layer == 0)) xin = tok < 16384 ? p.x_p + (size_t)tok * 1024 : p.x_s + (size_t)(tok - 16384) * 1024;
    else xin = p.out + (size_t)tok * 1024;
    float x[16];
#pragma unroll
    for (int h2 = 0; h2 < 2; ++h2) {
      const float4* xp = (const float4*)(xin + lane * 8 + 512 * h2);
      float4 a = xp[0], b = xp[1];
      x[h2 * 8 + 0] = a.x; x[h2 * 8 + 1] = a.y; x[h2 * 8 + 2] = a.z; x[h2 * 8 + 3] = a.w;
      x[h2 * 8 + 4] = b.x; x[h2 * 8 + 5] = b.y; x[h2 * 8 + 6] = b.z; x[h2 * 8 + 7] = b.w;
    }
    if (mode != 0) {
      const u16* y = (const u16*)(p.ws + OFF_RA) + (size_t)tok * 1024;
      float yv[16];
      float ss = 0.f;
#pragma unroll
      for (int h2 = 0; h2 < 2; ++h2) {
        uint4 v = *(const uint4*)(y + lane * 8 + 512 * h2);
        unsigned wv[4] = {v.x, v.y, v.z, v.w};
#pragma unroll
        for (int e = 0; e < 4; ++e) { yv[h2 * 8 + 2 * e] = blo(wv[e]); yv[h2 * 8 + 2 * e + 1] = bhi(wv[e]); }
      }
#pragma unroll
      for (int e = 0; e < 16; ++e) ss += yv[e] * yv[e];
#pragma unroll
      for (int o = 1; o < 64; o <<= 1) ss += __shfl_xor(ss, o);
      float rs = rsqrtf(ss * (1.f / 1024.f) + EPS);
      const float* npost = (mode == 1 ? p.n_post_mix : p.n_post_ffn) + layer * 1024;
      const float* g = mod + ((size_t)layer * 36 + bi) * 6144 + (mode == 1 ? 2048 : 5120);
#pragma unroll
      for (int h2 = 0; h2 < 2; ++h2)
#pragma unroll
        for (int e = 0; e < 8; ++e) {
          int c = lane * 8 + 512 * h2 + e;
          x[h2 * 8 + e] += g[c] * (yv[h2 * 8 + e] * rs * npost[c]);
        }
      float* xo = p.out + (size_t)tok * 1024;
#pragma unroll
      for (int h2 = 0; h2 < 2; ++h2) {
        float4* op = (float4*)(xo + lane * 8 + 512 * h2);
        op[0] = make_float4(x[h2 * 8 + 0], x[h2 * 8 + 1], x[h2 * 8 + 2], x[h2 * 8 + 3]);
        op[1] = make_float4(x[h2 * 8 + 4], x[h2 * 8 + 5], x[h2 * 8 + 6], x[h2 * 8 + 7]);
      }
    }
    if (mode == 2 && layer == 1) continue;
    int nl = mode == 2 ? layer + 1 : layer;
    const float* npre = (mode == 1 ? p.n_pre_ffn : p.n_pre_mix) + nl * 1024;
    const float* mb = mod + ((size_t)nl * 36 + bi) * 6144 + (mode == 1 ? 3072 : 0);
    float ss = 0.f;
#pragma unroll
    for (int e = 0; e < 16; ++e) ss += x[e] * x[e];
#pragma unroll
    for (int o = 1; o < 64; o <<= 1) ss += __shfl_xor(ss, o);
    float rs = rsqrtf(ss * (1.f / 1024.f) + EPS);
    const int umt = tok / 254, urr = tok % 254;
    u16* hd = mode == 1 ? (u16*)(p.ws + OFF_RB + RB_H2) + ((size_t)umt * 256 + urr + 1) * 1024 : (u16*)(p.ws + OFF_RA) + (size_t)tok * 1024;
#pragma unroll
    for (int h2 = 0; h2 < 2; ++h2) {
      unsigned wv[4];
#pragma unroll
      for (int e = 0; e < 8; e += 2) {
        int c = lane * 8 + 512 * h2 + e;
        float v0 = x[h2 * 8 + e] * rs * npre[c] * (1.f + mb[1024 + c]) + mb[c];
        float v1 = x[h2 * 8 + e + 1] * rs * npre[c + 1] * (1.f + mb[1024 + c + 1]) + mb[c + 1];
        wv[e >> 1] = pack2(v0, v1);
      }
      uint4 ov = make_uint4(wv[0], wv[1], wv[2], wv[3]);
      *(uint4*)(hd + lane * 8 + 512 * h2) = ov;
      if (mode == 1) {
        u16* hb = (u16*)(p.ws + OFF_RB + RB_H2);
        if (urr == 0 && umt > 0) *(uint4*)(hb + ((size_t)(umt - 1) * 256 + 255) * 1024 + lane * 8 + 512 * h2) = ov;
        if (urr == 253 && umt + 1 < 323) *(uint4*)(hb + ((size_t)(umt + 1) * 256) * 1024 + lane * 8 + 512 * h2) = ov;
      }
    }
  }
}

DI void ph_win(const Params& p, int item, int layer, char* smem) {
  const int nt = item % 34, tile = item / 34;
  int bi, S, pos0;
  tile_info(tile, bi, S, pos0);
  const u16* h = (const u16*)(p.ws + OFF_RA) + (size_t)tile * 128 * 1024;
  const u16* wt = (const u16*)(p.ws + OFF_WT + layer * WT_LAYER + WT_IN) + (size_t)nt * 128 * 1024;
  u16* z = (u16*)(p.ws + OFF_RB);
  u16* pqt = (u16*)(p.ws + OFF_PQT) + (size_t)tok0_of_batch(bi) * 512;
  const float2* tab = (const float2*)(p.ws + OFF_TAB);
  auto la = [&](int row, int k) { return *(const uint4*)(h + (size_t)row * 1024 + k); };
  auto lb = [&](int n, int k) { return *(const uint4*)(wt + (size_t)n * 1024 + k); };
  auto epi = [&](f32x4 (&acc)[4][4], int wm, int wn, int lane) {
    const int r = lane & 15, q = lane >> 4;
    const int nw0 = nt * 128 + wn * 64;
    const int zc0 = nw0 - 512;
    if (nt >= 4 && zc0 >= ZW) return;
#pragma unroll
    for (int tm = 0; tm < 4; ++tm) {
      int m = wm * 64 + tm * 16 + r;
      int pos = pos0 + m;
      size_t tok = (size_t)tile * 128 + m;
      if (nt < 4) {
#pragma unroll
        for (int tn = 0; tn < 4; ++tn)
#pragma unroll
          for (int jj = 0; jj < 4; ++jj) {
            int n = nw0 + tn * 16 + q * 4 + jj;
            pqt[(size_t)n * S + pos] = f2bf(acc[tm][tn][jj]);
          }
        continue;
      }
      const float2* tr = tab + pos * 56;
      const bool prope = (zc0 >= 1024 && zc0 < 1536) || (zc0 >= 1792 && zc0 < 2816);
      if (zc0 < 512) {
        float sc = zc0 >= 256 ? 0.125f : 1.f;
        rope_pair(acc[tm][0], acc[tm][2], tr + 24, q, sc);
        rope_pair(acc[tm][1], acc[tm][3], tr + 24 + 16, q, sc);
      } else if (prope) {
        const bool isq = (zc0 >= 1280 && zc0 < 1536) || (zc0 >= 1792 && zc0 < 2304);
        float sc = isq ? 0.125f * LOG2E : 1.f;
#pragma unroll
        for (int jj = 0; jj < 4; ++jj) {
          float2 cs = tr[16 + (q & 1) * 4 + jj];
          float v = acc[tm][0][jj];
          float o = __shfl_xor(v, 32);
          acc[tm][0][jj] = q < 2 ? v * cs.x - o * cs.y : v * cs.x + o * cs.y;
        }
#pragma unroll
        for (int tn = 0; tn < 4; ++tn)
#pragma unroll
          for (int jj = 0; jj < 4; ++jj) acc[tm][tn][jj] *= sc;
      } else if (zc0 == Z_KR) {
        rope_pair(acc[tm][0], acc[tm][1], tr, q, 1.f);
      }
      u16* zr = z + tok * ZW + zc0 + q * 4;
      *(uint2*)(zr) = pack4(acc[tm][0]);
      *(uint2*)(zr + 16) = pack4(acc[tm][1]);
      if (zc0 != Z_KR) {
        *(uint2*)(zr + 32) = pack4(acc[tm][2]);
        *(uint2*)(zr + 48) = pack4(acc[tm][3]);
      }
    }
  };
  gemm_tile_(p.wv, smem, 16, la, lb, epi);
}

constexpr int N_DIL = 3840, N_QP = 1920, N_KVP = 2560, N_RST = 144, N_PQF = 2304;
constexpr int N_P2 = N_RST + N_DIL + N_QP + N_KVP + N_PQF;

DI bf16x8 pack8(const f32x4& a, const f32x4& b) {
  uint4 u = make_uint4(pack2(a[0], a[1]), pack2(a[2], a[3]), pack2(b[0], b[1]), pack2(b[2], b[3]));
  return __builtin_bit_cast(bf16x8, u);
}
DI bf16x8 ldvt2(const u16* row, int c0, int c1) {
  uint2 lo = *(const uint2*)(row + c0), hi = *(const uint2*)(row + c1);
  uint4 u = make_uint4(lo.x, lo.y, hi.x, hi.y);
  return __builtin_bit_cast(bf16x8, u);
}

DI void ph_dil(const Params& p, int item, char* smem, bool dry = false) {
  int bi, rem, nbt, S;
  if (item < 768) { bi = item / 192; rem = item % 192; nbt = 64; S = 4096; }
  else { int it = item - 768; bi = 4 + it / 96; rem = it % 96; nbt = 32; S = 2048; }
  const int g = rem / nbt, blk = rem % nbt, dil = 1 << (2 * g), L = S / dil, nblk = L >> 6;
  const int r = blk / nblk, nb = blk % nblk;
  const size_t tokb = tok0_of_batch(bi);
  u16* z = (u16*)(p.ws + OFF_RB);
  u16* sQ = (u16*)smem;
  u16* sK = sQ + 64 * 72;
  u16* sVT = sK + 192 * 72;
  u16* sP = sK;
  const int tid = ltid(), lane = tid & 63, w = tid >> 6;
  const int qq = w * 16 + (lane & 15), q4 = lane >> 4;
  uint4 rq0, rq1, rk0, rk1, rk2, rk3, rk4, rk5, rv0, rv1, rv2, rv3, rv4, rv5;
#define DIL_LOAD(hd_) { const int cq_ = zdq(g) + (hd_)*64, ck_ = zdk(g) + (hd_)*64, cv_ = zdv(g) + (hd_)*64; \
    { int c = tid + 0, row = c >> 3, kc = (c & 7) * 8; rq0 = *(const uint4*)(z + (tokb + r + dil * (nb * 64 + row)) * ZW + cq_ + kc); } \
    { int c = tid + 256, row = c >> 3, kc = (c & 7) * 8; rq1 = *(const uint4*)(z + (tokb + r + dil * (nb * 64 + row)) * ZW + cq_ + kc); } \
    { int c = tid + 0, row = c >> 3, kc = (c & 7) * 8; int t = nb * 64 - 64 + row; rk0 = make_uint4(0, 0, 0, 0); if (t >= 0 && t < L) rk0 = *(const uint4*)(z + (tokb + r + dil * t) * ZW + ck_ + kc); } \
    { int c = tid + 256, row = c >> 3, kc = (c & 7) * 8; int t = nb * 64 - 64 + row; rk1 = make_uint4(0, 0, 0, 0); if (t >= 0 && t < L) rk1 = *(const uint4*)(z + (tokb + r + dil * t) * ZW + ck_ + kc); } \
    { int c = tid + 512, row = c >> 3, kc = (c & 7) * 8; int t = nb * 64 - 64 + row; rk2 = make_uint4(0, 0, 0, 0); if (t >= 0 && t < L) rk2 = *(const uint4*)(z + (tokb + r + dil * t) * ZW + ck_ + kc); } \
    { int c = tid + 768, row = c >> 3, kc = (c & 7) * 8; int t = nb * 64 - 64 + row; rk3 = make_uint4(0, 0, 0, 0); if (t >= 0 && t < L) rk3 = *(const uint4*)(z + (tokb + r + dil * t) * ZW + ck_ + kc); } \
    { int c = tid + 1024, row = c >> 3, kc = (c & 7) * 8; int t = nb * 64 - 64 + row; rk4 = make_uint4(0, 0, 0, 0); if (t >= 0 && t < L) rk4 = *(const uint4*)(z + (tokb + r + dil * t) * ZW + ck_ + kc); } \
    { int c = tid + 1280, row = c >> 3, kc = (c & 7) * 8; int t = nb * 64 - 64 + row; rk5 = make_uint4(0, 0, 0, 0); if (t >= 0 && t < L) rk5 = *(const uint4*)(z + (tokb + r + dil * t) * ZW + ck_ + kc); } \
    { int c = tid + 0, kp = c % 96, kc = (c / 96) * 8; int t0 = nb * 64 - 64 + 2 * kp; rv0 = make_uint4(0, 0, 0, 0); rv1 = make_uint4(0, 0, 0, 0); if (t0 >= 0 && t0 < L) rv0 = *(const uint4*)(z + (tokb + r + dil * t0) * ZW + cv_ + kc); if (t0 + 1 >= 0 && t0 + 1 < L) rv1 = *(const uint4*)(z + (tokb + r + dil * (t0 + 1)) * ZW + cv_ + kc); } \
    { int c = tid + 256, kp = c % 96, kc = (c / 96) * 8; int t0 = nb * 64 - 64 + 2 * kp; rv2 = make_uint4(0, 0, 0, 0); rv3 = make_uint4(0, 0, 0, 0); if (t0 >= 0 && t0 < L) rv2 = *(const uint4*)(z + (tokb + r + dil * t0) * ZW + cv_ + kc); if (t0 + 1 >= 0 && t0 + 1 < L) rv3 = *(const uint4*)(z + (tokb + r + dil * (t0 + 1)) * ZW + cv_ + kc); } \
    { int c = tid + 512, kp = c % 96, kc = (c / 96) * 8; int t0 = nb * 64 - 64 + 2 * kp; rv4 = make_uint4(0, 0, 0, 0); rv5 = make_uint4(0, 0, 0, 0); if (t0 >= 0 && t0 < L) rv4 = *(const uint4*)(z + (tokb + r + dil * t0) * ZW + cv_ + kc); if (t0 + 1 >= 0 && t0 + 1 < L) rv5 = *(const uint4*)(z + (tokb + r + dil * (t0 + 1)) * ZW + cv_ + kc); } \
  }
  DIL_LOAD(0);
#pragma unroll 1
  for (int hd = 0; hd < 4; ++hd) {
    const int colq = zdq(g) + hd * 64;
    __syncthreads();
    { int c = tid + 0, row = c >> 3, kc = (c & 7) * 8; *(uint4*)(sQ + row * 72 + kc) = rq0; }
    { int c = tid + 256, row = c >> 3, kc = (c & 7) * 8; *(uint4*)(sQ + row * 72 + kc) = rq1; }
    { int c = tid + 0, row = c >> 3, kc = (c & 7) * 8; *(uint4*)(sK + row * 72 + kc) = rk0; }
    { int c = tid + 256, row = c >> 3, kc = (c & 7) * 8; *(uint4*)(sK + row * 72 + kc) = rk1; }
    { int c = tid + 512, row = c >> 3, kc = (c & 7) * 8; *(uint4*)(sK + row * 72 + kc) = rk2; }
    { int c = tid + 768, row = c >> 3, kc = (c & 7) * 8; *(uint4*)(sK + row * 72 + kc) = rk3; }
    { int c = tid + 1024, row = c >> 3, kc = (c & 7) * 8; *(uint4*)(sK + row * 72 + kc) = rk4; }
    { int c = tid + 1280, row = c >> 3, kc = (c & 7) * 8; *(uint4*)(sK + row * 72 + kc) = rk5; }
    { int c = tid + 0, kp = c % 96, kc = (c / 96) * 8;
      unsigned w0[4] = {rv0.x, rv0.y, rv0.z, rv0.w}, w1[4] = {rv1.x, rv1.y, rv1.z, rv1.w};
#pragma unroll
      for (int e = 0; e < 4; ++e) {
        *(unsigned*)(sVT + (kc + 2 * e) * 200 + 2 * kp) = (w0[e] & 0xffffu) | (w1[e] << 16);
        *(unsigned*)(sVT + (kc + 2 * e + 1) * 200 + 2 * kp) = (w0[e] >> 16) | (w1[e] & 0xffff0000u);
      } }
    { int c = tid + 256, kp = c % 96, kc = (c / 96) * 8;
      unsigned w0[4] = {rv2.x, rv2.y, rv2.z, rv2.w}, w1[4] = {rv3.x, rv3.y, rv3.z, rv3.w};
#pragma unroll
      for (int e = 0; e < 4; ++e) {
        *(unsigned*)(sVT + (kc + 2 * e) * 200 + 2 * kp) = (w0[e] & 0xffffu) | (w1[e] << 16);
        *(unsigned*)(sVT + (kc + 2 * e + 1) * 200 + 2 * kp) = (w0[e] >> 16) | (w1[e] & 0xffff0000u);
      } }
    { int c = tid + 512, kp = c % 96, kc = (c / 96) * 8;
      unsigned w0[4] = {rv4.x, rv4.y, rv4.z, rv4.w}, w1[4] = {rv5.x, rv5.y, rv5.z, rv5.w};
#pragma unroll
      for (int e = 0; e < 4; ++e) {
        *(unsigned*)(sVT + (kc + 2 * e) * 200 + 2 * kp) = (w0[e] & 0xffffu) | (w1[e] << 16);
        *(unsigned*)(sVT + (kc + 2 * e + 1) * 200 + 2 * kp) = (w0[e] >> 16) | (w1[e] & 0xffff0000u);
      } }
    if (hd < 3) DIL_LOAD(hd + 1);
    __syncthreads();
    f32x4 s[10];
    {
      float zz = 0.f;
      asm volatile("" : "+v"(zz));
#pragma unroll
      for (int t = 0; t < 10; ++t) s[t] = f32x4{zz, zz, zz, zz};
    }
    const int lr = lane & 15;
#pragma unroll
    for (int ks = 0; ks < 2; ++ks) {
      bf16x8 qa = *(const bf16x8*)(sQ + (w * 16 + lr) * 72 + ks * 32 + q4 * 8);
#pragma unroll
      for (int t = 0; t < 9; ++t) {
        bf16x8 kb = *(const bf16x8*)(sK + ((w + t) * 16 + lr) * 72 + ks * 32 + q4 * 8);
        s[t] = __builtin_amdgcn_mfma_f32_16x16x32_bf16(kb, qa, s[t], 0, 0, 0);
      }
    }
    const int klo = max(qq, 64 - nb * 64), khi = min(qq + 128, L - 1 + 64 - nb * 64);
    const unsigned kspan = (unsigned)(khi - klo);
    const int kb0 = w * 16 + q4 * 4 - klo;
    float mx = -1e30f;
#pragma unroll
    for (int t = 0; t < 9; ++t)
#pragma unroll
      for (int jj = 0; jj < 4; ++jj) {
        bool ok = (unsigned)(kb0 + t * 16 + jj) <= kspan;
        float v = ok ? s[t][jj] : -1e30f;
        s[t][jj] = v;
        mx = fmaxf(mx, v);
      }
    mx = fmaxf(mx, __shfl_xor(mx, 16));
    mx = fmaxf(mx, __shfl_xor(mx, 32));
    float den = 0.f;
#pragma unroll
    for (int t = 0; t < 9; ++t)
#pragma unroll
      for (int jj = 0; jj < 4; ++jj) {
        float pv = __builtin_amdgcn_exp2f(s[t][jj] - mx);
        den += pv;
        s[t][jj] = pv;
      }
    den += __shfl_xor(den, 16);
    den += __shfl_xor(den, 32);
    f32x4 o[1][4];
    zero_acc(o);
#pragma unroll
    for (int kp = 0; kp < 5; ++kp) {
      bf16x8 pa = pack8(s[2 * kp], s[2 * kp + 1]);
      const int c0 = w * 16 + kp * 32 + q4 * 4, c1 = kp < 4 ? c0 + 16 : c0;
#pragma unroll
      for (int td = 0; td < 4; ++td) {
        bf16x8 vb = ldvt2(sVT + (td * 16 + lr) * 200, c0, c1);
        o[0][td] = __builtin_amdgcn_mfma_f32_16x16x32_bf16(vb, pa, o[0][td], 0, 0, 0);
      }
    }
    const float inv = 1.f / den;
    const size_t tok = tokb + r + dil * (nb * 64 + qq);
#pragma unroll
    for (int tn = 0; tn < 4; ++tn) {
      f32x4 v = o[0][tn];
      v[0] *= inv; v[1] *= inv; v[2] *= inv; v[3] *= inv;
      if (dry) *(uint2*)((u16*)p.out + tok * 1024 + (colq & 1023) + tn * 16 + q4 * 4) = pack4(v);
      else *(uint2*)(z + tok * ZW + colq + tn * 16 + q4 * 4) = pack4(v);
    }
    if (q4 == 0) ((float*)(p.ws + OFF_LSE))[((size_t)g * NTOK + tok) * 4 + hd] = (mx + log2f(den)) * LN2;
  }
#undef DIL_LOAD
}

DI void row_rstd_(int wv_, float* sR, const u16* base, int ncols) {
  const int tid = ltid_w(wv_), row = tid >> 1, half = tid & 1;
  const u16* b = base + (size_t)row * ZW + half * (ncols >> 1);
  float ss = 0.f;
  for (int c = 0; c < (ncols >> 4); ++c) {
    uint4 v = *(const uint4*)(b + c * 8);
    unsigned wv[4] = {v.x, v.y, v.z, v.w};
#pragma unroll
    for (int e = 0; e < 4; ++e) { float a = blo(wv[e]), d = bhi(wv[e]); ss += a * a + d * d; }
  }
  ss += __shfl_xor(ss, 1);
  if (half == 0) sR[row] = rsqrtf(ss / (float)ncols + EPS);
}

DI void ph_qproj(const Params& p, int item, int layer, char* smem) {
  const int nt = item % 3, tile = item / 3;
  int bi, S, pos0;
  tile_info(tile, bi, S, pos0);
  const u16* z = (const u16*)(p.ws + OFF_RB) + (size_t)tile * 128 * ZW;
  const u16* wt = (const u16*)(p.ws + OFF_WT + layer * WT_LAYER + WT_QB) + (size_t)nt * 128 * 256;
  u16* qm = (u16*)(p.ws + OFF_RA + RA_QM);
  const float2* tab = (const float2*)(p.ws + OFF_TAB);
  float* sR = (float*)(smem + 36864);
  __syncthreads();
  row_rstd_(p.wv, sR, z + Z_CQ, 256);
  auto la = [&](int row, int k) { return *(const uint4*)(z + (size_t)row * ZW + Z_CQ + k); };
  auto lb = [&](int n, int k) { return *(const uint4*)(wt + (size_t)n * 256 + k); };
  auto epi = [&](f32x4 (&acc)[4][4], int wm, int wn, int lane) {
    const int r = lane & 15, q = lane >> 4;
    const int nw0 = nt * 128 + wn * 64;
    const float QS = 0.10206207261596575f * LOG2E;
#pragma unroll
    for (int tm = 0; tm < 4; ++tm) {
      int m = wm * 64 + tm * 16 + r;
      int pos = pos0 + m;
      size_t tok = (size_t)tile * 128 + m;
      float rs = sR[m] * QS;
#pragma unroll
      for (int tn = 0; tn < 4; ++tn)
#pragma unroll
        for (int jj = 0; jj < 4; ++jj) acc[tm][tn][jj] *= rs;
      const float2* tr = tab + pos * 56;
      if (nw0 == 64 || nw0 == 256) rope_pair(acc[tm][0], acc[tm][1], tr, q, 1.f);
      else if (nw0 == 128 || nw0 == 320) rope_pair(acc[tm][2], acc[tm][3], tr, q, 1.f);
      u16* d = qm + tok * 384 + nw0 + q * 4;
#pragma unroll
      for (int tn = 0; tn < 4; ++tn) *(uint2*)(d + tn * 16) = pack4(acc[tm][tn]);
    }
  };
  gemm_tile_(p.wv, smem, 4, la, lb, epi);
}

DI void ph_kvproj(const Params& p, int item, int layer, char* smem) {
  const int nt = item & 3, tile = item >> 2;
  int bi, S, pos0;
  tile_info(tile, bi, S, pos0);
  const u16* z = (const u16*)(p.ws + OFF_RB) + (size_t)tile * 128 * ZW;
  const u16* wt = (const u16*)(p.ws + OFF_WT + layer * WT_LAYER + WT_KVB) + (size_t)nt * 128 * 128;
  u16* kb = (u16*)(p.ws + OFF_RA + RA_KB);
  u16* vt = (u16*)(p.ws + OFF_RA + RA_VT) + (size_t)tok0_of_batch(bi) * 256;
  float* sR = (float*)(smem + 36864);
  __syncthreads();
  row_rstd_(p.wv, sR, z + Z_CKV, 128);
  auto la = [&](int row, int k) { return *(const uint4*)(z + (size_t)row * ZW + Z_CKV + k); };
  auto lb = [&](int n, int k) { return *(const uint4*)(wt + (size_t)n * 128 + k); };
  auto epi = [&](f32x4 (&acc)[4][4], int wm, int wn, int lane) {
    const int r = lane & 15, q = lane >> 4;
#pragma unroll
    for (int tm = 0; tm < 4; ++tm) {
      int m = wm * 64 + tm * 16 + r;
      int pos = pos0 + m;
      const int k5 = pos & 31;
      const int ppos = (pos & ~31) | (8 * ((k5 >> 2) & 3) + 4 * (k5 >> 4) + (k5 & 3));
      size_t tok = (size_t)tile * 128 + m;
      float rs = sR[m];
#pragma unroll
      for (int tn = 0; tn < 4; ++tn)
#pragma unroll
        for (int jj = 0; jj < 4; ++jj) acc[tm][tn][jj] *= rs;
      if (wn == 0) {
        u16* d = kb + tok * 384 + nt * 96 + q * 4;
#pragma unroll
        for (int tn = 0; tn < 4; ++tn) *(uint2*)(d + tn * 16) = pack4(acc[tm][tn]);
      } else {
#pragma unroll
        for (int tn = 0; tn < 4; ++tn)
#pragma unroll
          for (int jj = 0; jj < 4; ++jj) vt[(size_t)(nt * 64 + tn * 16 + q * 4 + jj) * S + ppos] = f2bf(acc[tm][tn][jj]);
      }
    }
    if (wn == 0) {
      int m = wm * 64 + lane;
      size_t tok = (size_t)tile * 128 + m;
      const uint4* src = (const uint4*)(z + (size_t)m * ZW + Z_KR);
      uint4* dst = (uint4*)(kb + tok * 384 + nt * 96 + 64);
#pragma unroll
      for (int e = 0; e < 4; ++e) dst[e] = src[e];
    }
  };
  gemm_tile_(p.wv, smem, 2, la, lb, epi);
}

DI float logsig(float x) { return -log1pf(expf(-x)); }

DI void ph_retscan(const Params& p, int item, int layer, char* smem) {
  const int hd = item & 3, bi = item >> 2;
  const int N = bi < 4 ? 32 : 16;
  const int tb0 = bi < 4 ? bi * 32 : 128 + (bi - 4) * 16;
  const u16* zb = (const u16*)(p.ws + OFF_RB);
  u16* sKf = (u16*)smem;
  u16* sVf = sKf + 64 * 136;
  u16* sKb = sVf + 64 * 136;
  u16* sVb = sKb + 64 * 136;
  const int tid = ltid(), lane = tid & 63, w = tid >> 6;
  const float lf = logsig(p.dec_f[layer * 4 + hd]), lb = logsig(p.dec_b[layer * 4 + hd]);
  const int dir = w >> 1, eh = w & 1;
  const float cd = __expf(128.f * (dir ? lb : lf));
  f32x4 acc[2][4];
  zero_acc(acc);
  const int r = lane & 15, q = lane >> 4;
  for (int step = 0; step < N; ++step) {
    const int nf = step, nb = N - 1 - step;
    __syncthreads();
#pragma unroll
    for (int i = 0; i < 4; ++i) {
      int c = tid + 256 * i, j = c & 127, kc = (c >> 7) * 8;
      const u16* zf = zb + ((size_t)(tb0 + nf) * 128 + j) * ZW + hd * 64 + kc;
      const u16* zr = zb + ((size_t)(tb0 + nb) * 128 + j) * ZW + hd * 64 + kc;
      uint4 kf = *(const uint4*)(zf + Z_RK), vf = *(const uint4*)(zf + Z_RV), kbv = *(const uint4*)(zr + Z_RK), vbv = *(const uint4*)(zr + Z_RV);
      unsigned kfw[4] = {kf.x, kf.y, kf.z, kf.w}, vfw[4] = {vf.x, vf.y, vf.z, vf.w}, kbw[4] = {kbv.x, kbv.y, kbv.z, kbv.w}, vbw[4] = {vbv.x, vbv.y, vbv.z, vbv.w};
      float df = __expf((float)(127 - j) * lf), db = __expf((float)j * lb);
#pragma unroll
      for (int e = 0; e < 8; ++e) {
        float kx = (e & 1) ? bhi(kfw[e >> 1]) : blo(kfw[e >> 1]);
        float ky = (e & 1) ? bhi(kbw[e >> 1]) : blo(kbw[e >> 1]);
        sKf[(kc + e) * 136 + j] = f2bf(kx * df);
        sKb[(kc + e) * 136 + j] = f2bf(ky * db);
        sVf[(kc + e) * 136 + j] = (u16)((vfw[e >> 1] >> ((e & 1) * 16)) & 0xffffu);
        sVb[(kc + e) * 136 + j] = (u16)((vbw[e >> 1] >> ((e & 1) * 16)) & 0xffffu);
      }
    }
    __syncthreads();
    const int n = dir ? nb : nf;
    float* rs = (float*)(p.ws + OFF_RS) + ((size_t)((tb0 + n) * 4 + hd) * 2 + dir) * 4096;
#pragma unroll
    for (int tm = 0; tm < 2; ++tm)
#pragma unroll
      for (int tn = 0; tn < 4; ++tn) {
        int e = eh * 32 + tm * 16 + r, d = tn * 16 + q * 4;
        *(float4*)(rs + e * 64 + d) = make_float4(acc[tm][tn][0], acc[tm][tn][1], acc[tm][tn][2], acc[tm][tn][3]);
        acc[tm][tn][0] *= cd; acc[tm][tn][1] *= cd; acc[tm][tn][2] *= cd; acc[tm][tn][3] *= cd;
      }
    mma<2, 4>((dir ? sVb : sVf) + eh * 32 * 136, 136, dir ? sKb : sKf, 136, 4, acc, lane);
  }
}

DI void ph_pqfold(const Params& p, int item) {
  const int bi = item >> 6, cg8 = item & 63;
  const int S = bi < 4 ? 4096 : 2048, H = S >> 1;
  u16* pq = (u16*)(p.ws + OFF_PQT) + (size_t)tok0_of_batch(bi) * 512;
  const int tid = ltid();
  const int nch = H >> 3;
#pragma unroll 4
  for (int c = tid; c < 8 * nch; c += 256) {
    int row = cg8 * 8 + c / nch, k = (c % nch) * 8;
    u16* rp = pq + (size_t)row * S;
    const float sgn = row < 256 ? 1.f : -1.f;
    uint4 va = *(const uint4*)(rp + k), vb = *(const uint4*)(rp + H + k);
    unsigned wa[4] = {va.x, va.y, va.z, va.w}, wb[4] = {vb.x, vb.y, vb.z, vb.w}, o[4];
#pragma unroll
    for (int e = 0; e < 4; ++e) o[e] = pack2(blo(wa[e]) + sgn * blo(wb[e]), bhi(wa[e]) + sgn * bhi(wb[e]));
    if (k == 0) o[0] = (o[0] & 0xffff0000u) | (wa[0] & 0xffffu);
    *(uint4*)(rp + k) = make_uint4(o[0], o[1], o[2], o[3]);
  }
}

constexpr int N_MLA = 2560, N_FG = 1280, N_RO = 2560, N_COMB = 640, N_FM = 36;
constexpr int N_P3 = N_MLA + N_FG + N_RO + N_COMB + N_FM;

DI void mla_softmax(f32x4 (&s)[4], f32x4 (&o)[4], float& mrun, float& lrun) {
  float mx = -1e30f;
#pragma unroll
  for (int tn = 0; tn < 4; ++tn)
#pragma unroll
    for (int jj = 0; jj < 4; ++jj) mx = fmaxf(mx, s[tn][jj]);
  mx = fmaxf(mx, __shfl_xor(mx, 16));
  mx = fmaxf(mx, __shfl_xor(mx, 32));
  float mn = fmaxf(mrun, mx);
  float alpha = __builtin_amdgcn_exp2f(mrun - mn);
  mrun = mn;
  float ps = 0.f;
#pragma unroll
  for (int tn = 0; tn < 4; ++tn)
#pragma unroll
    for (int jj = 0; jj < 4; ++jj) { float pv = __builtin_amdgcn_exp2f(s[tn][jj] - mn); ps += pv; s[tn][jj] = pv; }
  lrun = lrun * alpha + ps;
#pragma unroll
  for (int tn = 0; tn < 4; ++tn)
#pragma unroll
    for (int jj = 0; jj < 4; ++jj) o[tn][jj] *= alpha;
}
DI void ph_mla(const Params& p, int item, char* smem) {
  int bi, hd, qb, S;
  if (item < 512) { bi = item >> 7; hd = (item >> 5) & 3; qb = item & 31; S = 4096; }
  else { int it = item - 512; bi = 4 + (it >> 6); hd = (it >> 4) & 3; qb = it & 15; S = 2048; }
  const size_t tokb = tok0_of_batch(bi);
  const u16* qm = (const u16*)(p.ws + OFF_RA + RA_QM) + (tokb + qb * 128) * 384 + hd * 96;
  const u16* kb = (const u16*)(p.ws + OFF_RA + RA_KB) + tokb * 384 + hd * 96;
  const u16* vt = (const u16*)(p.ws + OFF_RA + RA_VT) + tokb * 256 + (size_t)hd * 64 * S;
  u16* z = (u16*)(p.ws + OFF_RB);
  constexpr int BUF = 64 * 104 + 64 * 72;
  u16* sKV = (u16*)smem;
  u16* sP = sKV + 2 * BUF;
  const int tid = ltid(), lane = tid & 63, w = tid >> 6, r = lane & 15, q4 = lane >> 4;
  bf16x8 qf[2][3];
#pragma unroll
  for (int tm = 0; tm < 2; ++tm)
#pragma unroll
    for (int ks = 0; ks < 3; ++ks) qf[tm][ks] = *(const bf16x8*)(qm + (size_t)(w * 32 + tm * 16 + r) * 384 + ks * 32 + q4 * 8);
  const int kr0 = tid / 12, kc0 = (tid % 12) * 8, kr1 = (tid + 256) / 12, kc1 = ((tid + 256) % 12) * 8, kr2 = (tid + 512) / 12, kc2 = ((tid + 512) % 12) * 8;
  const int vr0 = tid >> 3, vc0 = (tid & 7) * 8, vr1 = vr0 + 32;
  uint4 rk0, rk1, rk2, rv0, rv1;
#define MLA_LOAD(kt_) { const u16* kb2 = kb + (size_t)(kt_) * 64 * 384; \
    rk0 = *(const uint4*)(kb2 + (size_t)kr0 * 384 + kc0); rk1 = *(const uint4*)(kb2 + (size_t)kr1 * 384 + kc1); rk2 = *(const uint4*)(kb2 + (size_t)kr2 * 384 + kc2); \
    rv0 = *(const uint4*)(vt + (size_t)vr0 * S + (kt_) * 64 + vc0); rv1 = *(const uint4*)(vt + (size_t)vr1 * S + (kt_) * 64 + vc0); }
#define MLA_WRITE(b_) { u16* sK_ = sKV + (b_) * BUF; u16* sV_ = sK_ + 64 * 104; \
    *(uint4*)(sK_ + kr0 * 104 + kc0) = rk0; *(uint4*)(sK_ + kr1 * 104 + kc1) = rk1; *(uint4*)(sK_ + kr2 * 104 + kc2) = rk2; \
    *(uint4*)(sV_ + vr0 * 72 + vc0) = rv0; *(uint4*)(sV_ + vr1 * 72 + vc0) = rv1; }
  const int nkt = S >> 6;
  MLA_LOAD(0);
  __syncthreads();
  MLA_WRITE(0);
  MLA_LOAD(1);
  __syncthreads();
  f32x4 o[2][4];
  zero_acc(o);
  float m0 = -1e30f, m1 = -1e30f, l0 = 0.f, l1 = 0.f;
  for (int kt = 0; kt < nkt; ++kt) {
    const int cur = kt & 1;
    const u16* sK = sKV + cur * BUF;
    const u16* sVT = sK + 64 * 104;
    f32x4 s[2][4];
    zero_acc(s);
#pragma unroll
    for (int ks = 0; ks < 3; ++ks) {
      bf16x8 bfr[4];
#pragma unroll
      for (int i = 0; i < 4; ++i) bfr[i] = *(const bf16x8*)(sK + (i * 16 + r) * 104 + ks * 32 + q4 * 8);
#pragma unroll
      for (int tm = 0; tm < 2; ++tm)
#pragma unroll
        for (int tn = 0; tn < 4; ++tn) s[tm][tn] = __builtin_amdgcn_mfma_f32_16x16x32_bf16(bfr[tn], qf[tm][ks], s[tm][tn], 0, 0, 0);
    }
    mla_softmax(s[0], o[0], m0, l0);
    mla_softmax(s[1], o[1], m1, l1);
#pragma unroll
    for (int kp = 0; kp < 2; ++kp) {
      bf16x8 pa0 = pack8(s[0][2 * kp], s[0][2 * kp + 1]), pa1 = pack8(s[1][2 * kp], s[1][2 * kp + 1]);
#pragma unroll
      for (int td = 0; td < 4; ++td) {
        bf16x8 vb = *(const bf16x8*)(sVT + (td * 16 + r) * 72 + kp * 32 + q4 * 8);
        o[0][td] = __builtin_amdgcn_mfma_f32_16x16x32_bf16(vb, pa0, o[0][td], 0, 0, 0);
        o[1][td] = __builtin_amdgcn_mfma_f32_16x16x32_bf16(vb, pa1, o[1][td], 0, 0, 0);
      }
    }
    if (kt + 1 < nkt) {
      MLA_WRITE(cur ^ 1);
      if (kt + 2 < nkt) MLA_LOAD(kt + 2);
    }
    __syncthreads();
  }
#undef MLA_LOAD
#undef MLA_WRITE
#pragma unroll
  for (int tm = 0; tm < 2; ++tm) {
    float l = tm ? l1 : l0;
    l += __shfl_xor(l, 16);
    l += __shfl_xor(l, 32);
    float inv = 1.f / l;
    size_t tok = tokb + qb * 128 + w * 32 + tm * 16 + r;
#pragma unroll
    for (int tn = 0; tn < 4; ++tn) {
      f32x4 v = o[tm][tn];
      v[0] *= inv; v[1] *= inv; v[2] *= inv; v[3] *= inv;
      *(uint2*)(z + tok * ZW + Z_CQ + hd * 64 + tn * 16 + q4 * 4) = pack4(v);
    }
  }
}

DI void ph_fgemm(const Params& p, int item, char* smem) {
  int bi, mt, nt, S;
  if (item < 256) { bi = item >> 6; mt = (item >> 2) & 15; nt = item & 3; S = 4096; }
  else { int it = item - 256; bi = 4 + (it >> 5); mt = (it >> 2) & 7; nt = it & 3; S = 2048; }
  const size_t tokb = tok0_of_batch(bi);
  const int H = S >> 1;
  const int rmul = S == 4096 ? 1 : 2;
  const u16* dft = (const u16*)(p.ws + OFF_DFT);
  const u16* pq = (const u16*)(p.ws + OFF_PQT) + tokb * 512;
  u16* z = (u16*)(p.ws + OFF_RB);
  auto la = [&](int row, int k) {
    int j = (mt * 128 + row) * rmul;
    int kk = k < H ? k : 2048 + (k - H);
    return *(const uint4*)(dft + (size_t)j * 4096 + kk);
  };
  auto lb = [&](int n, int k) {
    int c = nt * 64 + n;
    return k < H ? *(const uint4*)(pq + (size_t)c * S + k) : *(const uint4*)(pq + (size_t)(256 + c) * S + (k - H));
  };
  const float nrm = rsqrtf((float)S * 64.f);
  auto epi = [&](f32x4 (&a1)[4][2], f32x4 (&a2)[4][2], int wm, int wn, int lane) {
    const int r = lane & 15, q = lane >> 4;
#pragma unroll
    for (int tm = 0; tm < 4; ++tm) {
      int m = wm * 64 + tm * 16 + r;
      int j = mt * 128 + m;
      float sg = (j & 1) ? -1.f : 1.f;
#pragma unroll
      for (int tn = 0; tn < 2; ++tn) {
        int c = nt * 64 + wn * 32 + tn * 16 + q * 4;
        f32x4 v1, v2;
#pragma unroll
        for (int jj = 0; jj < 4; ++jj) {
          float pm = sg * bf2f(pq[(size_t)(c + jj) * S + H]);
          v1[jj] = (a1[tm][tn][jj] + a2[tm][tn][jj] + pm) * nrm;
          v2[jj] = (a1[tm][tn][jj] - a2[tm][tn][jj] + pm) * nrm;
        }
        *(uint2*)(z + (tokb + j) * ZW + Z_DK0 + c) = pack4(v1);
        if (j > 0) *(uint2*)(z + (tokb + S - j) * ZW + Z_DK0 + c) = pack4(v2);
      }
    }
  };
  gemm_tile2_(p.wv, smem, S >> 6, la, lb, epi);
}

DI void ph_fmid(const Params& p, int item) {
  const int bi = item;
  const int S = bi < 4 ? 4096 : 2048, H = S >> 1;
  const size_t tokb = tok0_of_batch(bi);
  const u16* pq = (const u16*)(p.ws + OFF_PQT) + tokb * 512;
  u16* z = (u16*)(p.ws + OFF_RB);
  const int c = ltid();
  const u16* rp = pq + (size_t)c * S;
  float se = 0.f, so = 0.f;
#pragma unroll 8
  for (int k = 0; k < H; k += 8) {
    uint4 v = *(const uint4*)(rp + k);
    unsigned w[4] = {v.x, v.y, v.z, v.w};
#pragma unroll
    for (int e = 0; e < 4; ++e) { se += blo(w[e]); so += bhi(w[e]); }
  }
  float f = (se - so + bf2f(rp[H])) * rsqrtf((float)S * 64.f);
  z[(tokb + H) * ZW + Z_DK0 + c] = f2bf(f);
}

DI void ph_comb(const Params& p, int item) {
  const int tid = ltid();
  const size_t tok = (size_t)item * 128 + (tid >> 1);
  u16* z = (u16*)(p.ws + OFF_RB) + tok * ZW;
  const float* lse = (const float*)(p.ws + OFF_LSE);
#pragma unroll
  for (int hh = 0; hh < 2; ++hh) {
    int hd = (tid & 1) * 2 + hh;
    float l0 = lse[((size_t)0 * NTOK + tok) * 4 + hd], l1 = lse[((size_t)1 * NTOK + tok) * 4 + hd], l2 = lse[((size_t)2 * NTOK + tok) * 4 + hd];
    float mx = fmaxf(l0, fmaxf(l1, l2));
    float w0 = __expf(l0 - mx), w1 = __expf(l1 - mx), w2 = __expf(l2 - mx);
    float inv = 1.f / (w0 + w1 + w2);
    w0 *= inv; w1 *= inv; w2 *= inv;
#pragma unroll
    for (int c8 = 0; c8 < 8; ++c8) {
      u16* a = z + hd * 64 + c8 * 8;
      uint4 v0 = *(const uint4*)(a + 1280), v1 = *(const uint4*)(a + 1792), v2 = *(const uint4*)(a + 2048);
      unsigned x0[4] = {v0.x, v0.y, v0.z, v0.w}, x1[4] = {v1.x, v1.y, v1.z, v1.w}, x2[4] = {v2.x, v2.y, v2.z, v2.w}, o[4];
#pragma unroll
      for (int e = 0; e < 4; ++e)
        o[e] = pack2(w0 * blo(x0[e]) + w1 * blo(x1[e]) + w2 * blo(x2[e]), w0 * bhi(x0[e]) + w1 * bhi(x1[e]) + w2 * bhi(x2[e]));
      *(uint4*)(a + 1280) = make_uint4(o[0], o[1], o[2], o[3]);
    }
  }
}

DI void ph_retout(const Params& p, int item, int layer, char* smem, bool dry = false) {
  const int hd = item & 3, tile = item >> 2;
  u16* z = (u16*)(p.ws + OFF_RB) + (size_t)tile * 128 * ZW;
  const float* rs = (const float*)(p.ws + OFF_RS) + (size_t)item * 2 * 4096;
  u16* sQ = (u16*)smem;
  u16* sK = sQ + 128 * 72;
  u16* sVT = sK + 128 * 72;
  u16* sSf = sVT + 64 * 136;
  u16* sSb = sSf + 64 * 72;
  u16* sS = sSf;
  const int tid = ltid(), lane = tid & 63, w = tid >> 6, r = lane & 15, q4 = lane >> 4;
  const float lf = logsig(p.dec_f[layer * 4 + hd]), lb = logsig(p.dec_b[layer * 4 + hd]);
  __syncthreads();
#pragma unroll
  for (int i = 0; i < 4; ++i) {
    int c = tid + 256 * i, row = c >> 3, kc = (c & 7) * 8;
    *(uint4*)(sQ + row * 72 + kc) = *(const uint4*)(z + (size_t)row * ZW + Z_RQ + hd * 64 + kc);
    *(uint4*)(sK + row * 72 + kc) = *(const uint4*)(z + (size_t)row * ZW + Z_RK + hd * 64 + kc);
  }
#pragma unroll
  for (int i = 0; i < 2; ++i) {
    int c = tid + 256 * i, jp = c & 63, kc = (c >> 6) * 8;
    uint4 v0 = *(const uint4*)(z + (size_t)(2 * jp) * ZW + Z_RV + hd * 64 + kc);
    uint4 v1 = *(const uint4*)(z + (size_t)(2 * jp + 1) * ZW + Z_RV + hd * 64 + kc);
    unsigned w0[4] = {v0.x, v0.y, v0.z, v0.w}, w1[4] = {v1.x, v1.y, v1.z, v1.w};
#pragma unroll
    for (int e = 0; e < 4; ++e) {
      *(unsigned*)(sVT + (kc + 2 * e) * 136 + 2 * jp) = (w0[e] & 0xffffu) | (w1[e] << 16);
      *(unsigned*)(sVT + (kc + 2 * e + 1) * 136 + 2 * jp) = (w0[e] >> 16) | (w1[e] & 0xffff0000u);
    }
  }
#pragma unroll
  for (int i = 0; i < 4; ++i) {
    int c = tid + 256 * i, e = c >> 4, d = (c & 15) * 4;
    float4 a = *(const float4*)(rs + e * 64 + d), b = *(const float4*)(rs + 4096 + e * 64 + d);
    *(uint2*)(sSf + e * 72 + d) = make_uint2(pack2(a.x, a.y), pack2(a.z, a.w));
    *(uint2*)(sSb + e * 72 + d) = make_uint2(pack2(b.x, b.y), pack2(b.z, b.w));
  }
  __syncthreads();
  f32x4 oc[2][1][4];
#pragma unroll
  for (int h = 0; h < 2; ++h) {
    f32x4 cf[1][4], cb[1][4];
    zero_acc(cf);
    zero_acc(cb);
    mma<1, 4>(sQ + (h * 64 + w * 16) * 72, 72, sSf, 72, 2, cf, lane);
    mma<1, 4>(sQ + (h * 64 + w * 16) * 72, 72, sSb, 72, 2, cb, lane);
    int i = h * 64 + w * 16 + r;
    float rf = __expf((float)(i + 1) * lf), rb = __expf((float)(128 - i) * lb);
#pragma unroll
    for (int tn = 0; tn < 4; ++tn)
#pragma unroll
      for (int jj = 0; jj < 4; ++jj) oc[h][0][tn][jj] = rf * cf[0][tn][jj] + rb * cb[0][tn][jj];
  }
#pragma unroll
  for (int h = 0; h < 2; ++h) {
    const int i = h * 64 + w * 16 + r;
    {
      f32x4 s[1][8];
      zero_acc(s);
      mma<1, 8>(sQ + (h * 64 + w * 16) * 72, 72, sK, 72, 2, s, lane);
#pragma unroll
      for (int tn = 0; tn < 8; ++tn)
#pragma unroll
        for (int jj = 0; jj < 4; ++jj) {
          int j = tn * 16 + q4 * 4 + jj;
          float dcy = i >= j ? __expf((float)(i - j) * lf) : __expf((float)(j - i) * lb);
          s[0][tn][jj] *= dcy;
        }
#pragma unroll
      for (int kp = 0; kp < 4; ++kp) {
        bf16x8 pa = pack8(s[0][2 * kp], s[0][2 * kp + 1]);
#pragma unroll
        for (int td = 0; td < 4; ++td) {
          bf16x8 vb = ldvt2(sVT + (td * 16 + r) * 136, kp * 32 + q4 * 4, kp * 32 + 16 + q4 * 4);
          oc[h][0][td] = __builtin_amdgcn_mfma_f32_16x16x32_bf16(vb, pa, oc[h][0][td], 0, 0, 0);
        }
      }
    }
    float ss = 0.f;
#pragma unroll
    for (int tn = 0; tn < 4; ++tn)
#pragma unroll
      for (int jj = 0; jj < 4; ++jj) ss += oc[h][0][tn][jj] * oc[h][0][tn][jj];
    ss += __shfl_xor(ss, 16);
    ss += __shfl_xor(ss, 32);
    float rn = rsqrtf(ss * (1.f / 64.f) + EPS);
#pragma unroll
    for (int tn = 0; tn < 4; ++tn) {
      u16* gp = z + (size_t)i * ZW + Z_RG + hd * 64 + tn * 16 + q4 * 4;
      uint2 gv = *(const uint2*)gp;
      float g0 = blo(gv.x), g1 = bhi(gv.x), g2 = blo(gv.y), g3 = bhi(gv.y);
      f32x4 v = oc[h][0][tn];
      v[0] *= rn * fsilu(g0);
      v[1] *= rn * fsilu(g1);
      v[2] *= rn * fsilu(g2);
      v[3] *= rn * fsilu(g3);
      if (dry) *(uint2*)((u16*)p.out + ((size_t)tile * 128 + i) * 1024 + hd * 64 + tn * 16 + q4 * 4) = pack4(v);
      else *(uint2*)gp = pack4(v);
    }
  }
}

DI void ph_wout(const Params& p, int item, int layer, char* smem) {
  const int nt = item & 7, tile = item >> 3;
  const u16* z = (const u16*)(p.ws + OFF_RB) + (size_t)tile * 128 * ZW;
  const u16* wt = (const u16*)(p.ws + OFF_WT + layer * WT_LAYER + WT_OUT) + (size_t)nt * 128 * 1024;
  u16* y = (u16*)(p.ws + OFF_RA) + (size_t)tile * 128 * 1024 + nt * 128;
  auto la = [&](int row, int k) { return *(const uint4*)(z + (size_t)row * ZW + Z_RG + k); };
  auto lb = [&](int n, int k) { return *(const uint4*)(wt + (size_t)n * 1024 + k); };
  auto epi = [&](f32x4 (&acc)[4][4], int wm, int wn, int lane) {
    const int r = lane & 15, q = lane >> 4;
#pragma unroll
    for (int tm = 0; tm < 4; ++tm) {
      int m = wm * 64 + tm * 16 + r;
#pragma unroll
      for (int tn = 0; tn < 4; ++tn) *(uint2*)(y + (size_t)m * 1024 + wn * 64 + tn * 16 + q * 4) = pack4(acc[tm][tn]);
    }
  };
  gemm_tile_(p.wv, smem, 16, la, lb, epi);
}

constexpr int N_UPM = 676;
DI void ph_up(const Params& p, int item, int layer, char* smem) {
  const int nt = item % 44, mtile = item / 44;
  int bi, mt, S;
  if (mtile < 132) { bi = mtile / 33; mt = mtile % 33; S = 4096; }
  else { int t = mtile - 132; bi = 4 + t / 17; mt = t % 17; S = 2048; }
  const size_t tokb = tok0_of_batch(bi);
  const u16* h2 = (const u16*)(p.ws + OFF_RB + RB_H2) + tokb * 1024;
  const u16* wt = (const u16*)(p.ws + OFF_WT + layer * WT_LAYER + WT_UP);
  u16* gated = (u16*)(p.ws + OFF_RB + RB_GATED) + tokb * DFF;
  const int pbase = 126 * mt - 1;
  auto la = [&](int row, int k) {
    int pos = pbase + row;
    uint4 v = make_uint4(0, 0, 0, 0);
    if (pos >= 0 && pos < S) v = *(const uint4*)(h2 + (size_t)pos * 1024 + k);
    return v;
  };
  auto lb = [&](int n, int k) {
    int nn = n < 64 ? nt * 64 + n : DFF + nt * 64 + (n - 64);
    return *(const uint4*)(wt + (size_t)nn * 1024 + k);
  };
  auto epi = [&](f32x4 (&acc)[4][4], int wm, int wn, int lane) {
    const int r = lane & 15, q = lane >> 4, tid = ltid();
    u16* sU = (u16*)smem;
    __syncthreads();
#pragma unroll
    for (int tm = 0; tm < 4; ++tm) {
      int m = wm * 64 + tm * 16 + r;
#pragma unroll
      for (int tn = 0; tn < 4; ++tn) *(uint2*)(sU + m * 136 + wn * 64 + tn * 16 + q * 4) = pack4(acc[tm][tn]);
    }
    __syncthreads();
    const int c2 = (tid & 31) * 2, rb = tid >> 5;
    const int na = nt * 64 + c2, nb = DFF + na;
    const float* cw = p.conv_w + (size_t)layer * 3 * 5632;
    const float* cbias = p.conv_b + (size_t)layer * 5632;
    float wa[3][2], wb[3][2], ba[2], bb[2];
#pragma unroll
    for (int t = 0; t < 3; ++t) { wa[t][0] = cw[t * 5632 + na]; wa[t][1] = cw[t * 5632 + na + 1]; wb[t][0] = cw[t * 5632 + nb]; wb[t][1] = cw[t * 5632 + nb + 1]; }
    ba[0] = cbias[na]; ba[1] = cbias[na + 1]; bb[0] = cbias[nb]; bb[1] = cbias[nb + 1];
    for (int i = 0; i < 16; ++i) {
      int rr = rb + 8 * i;
      int pos = pbase + rr;
      if (rr >= 1 && rr <= 126 && pos < S) {
        float a0 = ba[0], a1 = ba[1], b0 = bb[0], b1 = bb[1];
#pragma unroll
        for (int t = 0; t < 3; ++t) {
          unsigned ua = *(const unsigned*)(sU + (rr - 1 + t) * 136 + c2);
          unsigned ub = *(const unsigned*)(sU + (rr - 1 + t) * 136 + 64 + c2);
          a0 += wa[t][0] * blo(ua); a1 += wa[t][1] * bhi(ua);
          b0 += wb[t][0] * blo(ub); b1 += wb[t][1] * bhi(ub);
        }
        float g0 = fsilu(a0) * b0, g1 = fsilu(a1) * b1;
        *(unsigned*)(gated + (size_t)pos * DFF + na) = pack2(g0, g1);
      }
    }
  };
  gemm_tile_(p.wv, smem, 16, la, lb, epi);
}

DI void ph_down(const Params& p, int item, int layer, char* smem) {
  const int nt = item & 7, tile = item >> 3;
  const u16* a = (const u16*)(p.ws + OFF_RB + RB_GATED) + (size_t)tile * 128 * DFF;
  const u16* wt = (const u16*)(p.ws + OFF_WT + layer * WT_LAYER + WT_DOWN) + (size_t)nt * 128 * DFF;
  u16* y = (u16*)(p.ws + OFF_RA) + (size_t)tile * 128 * 1024 + nt * 128;
  auto la = [&](int row, int k) { return *(const uint4*)(a + (size_t)row * DFF + k); };
  auto lb = [&](int n, int k) { return *(const uint4*)(wt + (size_t)n * DFF + k); };
  auto epi = [&](f32x4 (&acc)[4][4], int wm, int wn, int lane) {
    const int r = lane & 15, q = lane >> 4;
#pragma unroll
    for (int tm = 0; tm < 4; ++tm) {
      int m = wm * 64 + tm * 16 + r;
#pragma unroll
      for (int tn = 0; tn < 4; ++tn) *(uint2*)(y + (size_t)m * 1024 + wn * 64 + tn * 16 + q * 4) = pack4(acc[tm][tn]);
    }
  };
  gemm_tile_(p.wv, smem, 44, la, lb, epi);
}


namespace g8 {
#define G8_LAS __attribute__((address_space(3)))
constexpr int BM = 256, BK = 64, HALF = 128, HTB = HALF * BK * 2, STAGE_BYTES = 8 * HTB, NXCD = 8, WGM = 8;
DI int lds_byte(int r, int c) { const int st = (r >> 4) * 2 + (c >> 5), rr = r & 15, cc = c & 31, ob = rr * 64 + cc * 2; return st * 1024 + (ob ^ (((ob >> 9) & 1) << 5)); }
DI void stage_rc(int b, int& R, int& C) { const int st = b / 1024, sb = b % 1024, swz = sb ^ (((sb >> 9) & 1) << 5); R = (st >> 1) * 16 + swz / 64; C = (st & 1) * 32 + (swz % 64) / 2; }
struct Unit { int pm, pn; };
struct Order {
  int nM, nN, nwg, G, c;
  DI bool next(int i, Unit& u) const {
    const long L = (long)i * G + c;
    if (L >= nwg) return false;
    int wgid = (int)L;
    { const int q = nwg / NXCD, r = nwg % NXCD, xcd = wgid % NXCD, off = wgid / NXCD; wgid = (xcd < r ? xcd * (q + 1) : r * (q + 1) + (xcd - r) * q) + off; }
    const int nig = WGM * nN, gid = wgid / nig, fm = gid * WGM, gsz = (nM - fm) < WGM ? (nM - fm) : WGM;
    u.pm = fm + ((wgid % nig) % gsz);
    u.pn = (wgid % nig) / gsz;
    return true;
  }
};
template <int lda, int ldb, int K, int nM, int nN, class Epi>
DI void gemm_phase(int wv_, G8_LAS unsigned char* lds, const u16* A, const u16* Bt, const Epi& E) {
  int tid_ = (wv_ << 6) | lane_now();
  asm volatile("" : "+v"(tid_));
  const int tid = tid_, wid = __builtin_amdgcn_readfirstlane(tid >> 6), lane = tid & 63, wr = wid >> 2, wc = wid & 3, fr = lane & 15, fq = lane >> 4;
  const int nt = K / BK;
  Order S;
  S.nM = nM; S.nN = nN; S.nwg = nM * nN; S.G = gridDim.x; S.c = blockIdx.x;
  unsigned voffA[2], voffB[2];
#pragma unroll
  for (int i = 0; i < 2; ++i) { int R, C; stage_rc(tid * 16 + i * 8192, R, C); voffA[i] = (unsigned)(R * lda + C) * 2u; voffB[i] = (unsigned)(R * ldb + C) * 2u; }
  const size_t kstep = (size_t)(BK * 2);
  const size_t hstepA = (size_t)HALF * lda * 2, tstepA = 2 * hstepA, hstepB = (size_t)HALF * ldb * 2, tstepB = 2 * hstepB;
  const unsigned ldsw = (unsigned)wid * 1024u;
  const int aoff = lds_byte(wr * 64 + fr, fq * 8), boff = lds_byte(wc * 32 + fr, fq * 8);
#define G8_SA(b, h) (((b) * 2 + (h)) * HTB)
#define G8_SB(b, h) ((4 + (b) * 2 + (h)) * HTB)
#define G8_STAGE(bufoff, gbase, voff) do { _Pragma("unroll") for (int _i = 0; _i < 2; ++_i) \
    __builtin_amdgcn_global_load_lds((const unsigned*)((const char*)(gbase) + (voff)[_i]), (G8_LAS unsigned*)(lds + (bufoff) + ldsw + _i * 8192), 16, 0, 0); } while (0)
#define G8_LDA(dst, b, h) do { _Pragma("unroll") for (int m = 0; m < 4; ++m) _Pragma("unroll") for (int k = 0; k < 2; ++k) dst[m][k] = *(const G8_LAS bf16x8*)(lds + G8_SA(b, h) + aoff + m * 2048 + k * 1024); } while (0)
#define G8_LDB(dst, b, h) do { _Pragma("unroll") for (int n = 0; n < 2; ++n) _Pragma("unroll") for (int k = 0; k < 2; ++k) dst[n][k] = *(const G8_LAS bf16x8*)(lds + G8_SB(b, h) + boff + n * 2048 + k * 1024); } while (0)
#define G8_MMA(ai, bj, At, Bt) do { __builtin_amdgcn_s_setprio(1); _Pragma("unroll") for (int m = 0; m < 4; ++m) _Pragma("unroll") for (int n = 0; n < 2; ++n) _Pragma("unroll") for (int k = 0; k < 2; ++k) \
    acc[ai][bj][m][n] = __builtin_amdgcn_mfma_f32_16x16x32_bf16(Bt[n][k], At[m][k], acc[ai][bj][m][n], 0, 0, 0); __builtin_amdgcn_s_setprio(0); } while (0)
#define G8_WAIT_V(n) asm volatile("s_waitcnt vmcnt(" #n ")" ::: "memory")
#define G8_WAIT_L(n) asm volatile("s_waitcnt lgkmcnt(" #n ")" ::: "memory")
#define G8_BAR __builtin_amdgcn_s_barrier()
#define G8_SCHED __builtin_amdgcn_sched_barrier(0)
  Unit cur, nxt;
  int ui = 0;
  if (!S.next(0, cur)) return;
  f32x4 acc[2][2][4][2];
  float zz_ = 0.f;
  asm volatile("" : "+v"(zz_));
#pragma unroll
  for (int a = 0; a < 2; ++a)
#pragma unroll
    for (int b = 0; b < 2; ++b)
#pragma unroll
      for (int m = 0; m < 4; ++m)
#pragma unroll
        for (int n = 0; n < 2; ++n) acc[a][b][m][n] = (f32x4){zz_, zz_, zz_, zz_};
  bf16x8 At[4][2], B0[2][2], B1[2][2];
  const char* cA = (const char*)A + (size_t)cur.pm * tstepA;
  const char* cB = (const char*)Bt + (size_t)cur.pn * tstepB;
  G8_STAGE(G8_SB(0, 0), cB, voffB); G8_STAGE(G8_SA(0, 0), cA, voffA); G8_STAGE(G8_SB(0, 1), cB + hstepB, voffB); G8_STAGE(G8_SA(0, 1), cA + hstepA, voffA);
  if (wr == 1) G8_BAR;
  G8_WAIT_V(4); G8_BAR;
  G8_STAGE(G8_SB(1, 0), cB + kstep, voffB); G8_STAGE(G8_SA(1, 0), cA + kstep, voffA); G8_STAGE(G8_SB(1, 1), cB + hstepB + kstep, voffB);
  G8_WAIT_V(6); G8_BAR;
  for (;;) {
    const bool has_next = S.next(ui + 1, nxt);
    const char* nA = has_next ? (const char*)A + (size_t)nxt.pm * tstepA : cA;
    const char* nB = has_next ? (const char*)Bt + (size_t)nxt.pn * tstepB : cB;
    for (int t = 0; t < nt; t += 2) {
      const bool last = (t == nt - 2);
      const char* a1 = cA + (size_t)(t + 1) * kstep;
      const char* a2 = last ? nA : cA + (size_t)(t + 2) * kstep;
      const char* b2 = last ? nB : cB + (size_t)(t + 2) * kstep;
      const char* a3 = a2 + kstep;
      const char* b3 = b2 + kstep;
      G8_LDB(B0, 0, 0); G8_SCHED; G8_LDA(At, 0, 0); G8_STAGE(G8_SA(1, 1), a1 + hstepA, voffA);
      G8_WAIT_L(8); G8_BAR; G8_WAIT_L(0); G8_MMA(0, 0, At, B0); G8_BAR; G8_SCHED;
      G8_LDB(B1, 0, 1); G8_STAGE(G8_SB(0, 0), b2, voffB);
      G8_BAR; G8_WAIT_L(0); G8_MMA(0, 1, At, B1); G8_BAR;
      G8_LDA(At, 0, 1); G8_STAGE(G8_SA(0, 0), a2, voffA);
      G8_BAR; G8_WAIT_L(0); G8_MMA(1, 0, At, B0); G8_BAR; G8_SCHED;
      G8_STAGE(G8_SB(0, 1), b2 + hstepB, voffB);
      G8_WAIT_V(6); G8_BAR; G8_MMA(1, 1, At, B1); G8_BAR;
      G8_LDB(B0, 1, 0); G8_SCHED; G8_LDA(At, 1, 0); G8_STAGE(G8_SA(0, 1), a2 + hstepA, voffA);
      G8_WAIT_L(8); G8_BAR; G8_WAIT_L(0); G8_MMA(0, 0, At, B0); G8_BAR; G8_SCHED;
      G8_LDB(B1, 1, 1); G8_STAGE(G8_SB(1, 0), b3, voffB);
      G8_BAR; G8_WAIT_L(0); G8_MMA(0, 1, At, B1); G8_BAR;
      G8_LDA(At, 1, 1); G8_STAGE(G8_SA(1, 0), a3, voffA);
      G8_BAR; G8_WAIT_L(0); G8_MMA(1, 0, At, B0); G8_BAR; G8_SCHED;
      G8_STAGE(G8_SB(1, 1), b3 + hstepB, voffB);
      G8_WAIT_V(6); G8_BAR; G8_MMA(1, 1, At, B1); G8_BAR;
    }
    E(acc, cur, wr, wc, fr, fq);
    if (!has_next) break;
#pragma unroll
    for (int a = 0; a < 2; ++a)
#pragma unroll
      for (int b = 0; b < 2; ++b)
#pragma unroll
        for (int m = 0; m < 4; ++m)
#pragma unroll
          for (int n = 0; n < 2; ++n) acc[a][b][m][n] = (f32x4){zz_, zz_, zz_, zz_};
    cur = nxt; cA = nA; cB = nB; ++ui;
  }
  G8_WAIT_V(0);
  if (wr == 0) G8_BAR;
  G8_BAR;
}
struct EpiStore {
  u16* O; int ldc;
  DI void operator()(const f32x4 (&acc)[2][2][4][2], const Unit& u, int wr, int wc, int fr, int fq) const {
#pragma unroll
    for (int ai = 0; ai < 2; ++ai)
#pragma unroll
      for (int m = 0; m < 4; ++m) {
        u16* rowp = O + (size_t)(u.pm * BM + ai * HALF + wr * 64 + m * 16 + fr) * ldc + u.pn * BM + wc * 32 + fq * 4;
#pragma unroll
        for (int bj = 0; bj < 2; ++bj)
#pragma unroll
          for (int n = 0; n < 2; ++n) *(uint2*)(rowp + bj * HALF + n * 16) = pack4(acc[ai][bj][m][n]);
      }
  }
};
}


struct EpiWin {
  u16* z; u16* pqt; const float2* tab;
  DI void operator()(f32x4 (&acc)[2][2][4][2], const g8::Unit& u, int wr, int wc, int fr, int fq) const {
#pragma unroll
    for (int ai = 0; ai < 2; ++ai) {
      int bi, S, pos0;
      tile_info(u.pm * 2 + ai, bi, S, pos0);
      u16* pq = pqt + (size_t)tok0_of_batch(bi) * 512;
#pragma unroll
      for (int m = 0; m < 4; ++m) {
        const int rl = wr * 64 + m * 16 + fr;
        const int pos = pos0 + rl;
        const int fpos = pos <= (S >> 1) ? pos : 3 * (S >> 1) - pos;
        const size_t tok = (size_t)(u.pm * 2 + ai) * 128 + rl;
        const float2* tr = tab + pos * 56;
#pragma unroll
        for (int bj = 0; bj < 2; ++bj) {
          const int W0 = u.pn * 256 + bj * 128 + wc * 32;
          f32x4 a0 = acc[ai][bj][m][0], a1 = acc[ai][bj][m][1];
          if (W0 < 512) {
#pragma unroll
            for (int e = 0; e < 4; ++e) {
              pq[(size_t)(W0 + fq * 4 + e) * S + fpos] = f2bf(a0[e]);
              pq[(size_t)(W0 + 16 + fq * 4 + e) * S + fpos] = f2bf(a1[e]);
            }
            continue;
          }
          const int zw = W0 - 512;
          if (zw >= ZW) continue;
          const int zh = zw & ~63;
          if (zh < 512) {
            const float sc = zh >= 256 ? 0.125f : 1.f;
            const int i0 = 16 * (wc & 1) + 4 * fq;
            rope_pair(a0, a1, tr + 24 + 16 * (wc & 1), fq, sc);
            *(uint2*)(z + tok * ZW + zh + i0) = pack4(a0);
            *(uint2*)(z + tok * ZW + zh + 32 + i0) = pack4(a1);
            continue;
          }
          const bool prope = (zh >= 1024 && zh < 1536) || (zh >= 1792 && zh < 2816);
          if (prope) {
            const bool isq = (zh >= 1280 && zh < 1536) || (zh >= 1792 && zh < 2304);
            const float sc = isq ? 0.125f * LOG2E : 1.f;
            if ((wc & 1) == 0) {
#pragma unroll
              for (int e = 0; e < 4; ++e) {
                float2 cs = tr[16 + (fq & 1) * 4 + e];
                float v = a0[e];
                float o = __shfl_xor(v, 32);
                a0[e] = fq < 2 ? v * cs.x - o * cs.y : v * cs.x + o * cs.y;
              }
            }
#pragma unroll
            for (int e = 0; e < 4; ++e) { a0[e] *= sc; a1[e] *= sc; }
          } else if (zw == Z_KR) {
            rope_pair(a0, a1, tr, fq, 1.f);
          }
          *(uint2*)(z + tok * ZW + zw + fq * 4) = pack4(a0);
          *(uint2*)(z + tok * ZW + zw + 16 + fq * 4) = pack4(a1);
        }
      }
    }
  }
};


struct EpiUp {
  u16* gated; const float* cw; const float* cbias; char* xbuf; int wv;
  DI void operator()(f32x4 (&acc)[2][2][4][2], const g8::Unit& u, int wr, int wc, int fr, int fq) const {
    u16* sX = (u16*)xbuf;
    int tid_ = (wv << 6) | lane_now();
    asm volatile("" : "+v"(tid_));
    const int row = tid_ >> 1, hf = tid_ & 1;
    const int T = 254 * u.pm - 1 + row;
    const bool live = row >= 1 && row <= 254 && T < NTOK;
    int pos = 0, S = 4096;
    if (live) { if (T < 16384) { pos = T & 4095; } else { pos = (T - 16384) & 2047; S = 2048; } }
    const bool hasp = pos > 0, hasn = pos < S - 1;
    if (wr == 0) __builtin_amdgcn_s_barrier();
#pragma unroll 1
    for (int wcj = 0; wcj < 4; ++wcj)
#pragma unroll
    for (int nj = 0; nj < 2; ++nj) {
      if (wc == wcj) {
#pragma unroll
        for (int ai = 0; ai < 2; ++ai)
#pragma unroll
          for (int m = 0; m < 4; ++m) {
            int r = ai * 128 + wr * 64 + m * 16 + fr;
            *(uint2*)(sX + r * 32 + fq * 4) = pack4(acc[ai][0][m][nj]);
            *(uint2*)(sX + r * 32 + 16 + fq * 4) = pack4(acc[ai][1][m][nj]);
          }
      }
      __syncthreads();
      if (live) {
        const int ca = u.pn * 128 + wcj * 32 + nj * 16 + hf * 8;
        float oa[8], ob[8];
#pragma unroll
        for (int e = 0; e < 8; ++e) { oa[e] = cbias[ca + e]; ob[e] = cbias[DFF + ca + e]; }
#pragma unroll
        for (int t = 0; t < 3; ++t) {
          if ((t == 0 && !hasp) || (t == 2 && !hasn)) continue;
          uint4 va = *(const uint4*)(sX + (row - 1 + t) * 32 + hf * 8);
          uint4 vb = *(const uint4*)(sX + (row - 1 + t) * 32 + 16 + hf * 8);
          unsigned wa[4] = {va.x, va.y, va.z, va.w}, wb[4] = {vb.x, vb.y, vb.z, vb.w};
#pragma unroll
          for (int e = 0; e < 8; ++e) {
            float ua = (e & 1) ? bhi(wa[e >> 1]) : blo(wa[e >> 1]);
            float ub = (e & 1) ? bhi(wb[e >> 1]) : blo(wb[e >> 1]);
            oa[e] += cw[t * 5632 + ca + e] * ua;
            ob[e] += cw[t * 5632 + DFF + ca + e] * ub;
          }
        }
        unsigned o[4];
#pragma unroll
        for (int e = 0; e < 8; e += 2) {
          float g0 = fsilu(oa[e]) * ob[e], g1 = fsilu(oa[e + 1]) * ob[e + 1];
          o[e >> 1] = pack2(g0, g1);
        }
        *(uint4*)(gated + (size_t)T * DFF + ca) = make_uint4(o[0], o[1], o[2], o[3]);
      }
      __syncthreads();
    }
    if (wr == 1) __builtin_amdgcn_s_barrier();
  }
};


#define XB_TMO      128
#define XB_XCNT(j)  (256  + 64 * (j))
#define XB_XSUB(j)  (1280 + 64 * (j))
#define XB_XGEN(j)  (2304 + 64 * (j))
#define XB_TOP      3328
#define XB_TOPGEN   3392
#define XCD_BAR_WORDS 3456
#define XB_SPIN_CAP (1u << 18)
#define XLAS __attribute__((address_space(3)))
DI unsigned xb_ld(unsigned* p) { return __hip_atomic_load(p, __ATOMIC_RELAXED, __HIP_MEMORY_SCOPE_AGENT); }
DI unsigned xb_add(unsigned* p, unsigned v) { return __hip_atomic_fetch_add(p, v, __ATOMIC_RELAXED, __HIP_MEMORY_SCOPE_AGENT); }
DI unsigned xb_xcc_id() { return (unsigned)__builtin_amdgcn_s_getreg((3 << 11) | 20) & 0xFu; }
#define XB_SPIN(cond, bar) do { unsigned _sp = 0; while (cond) { __builtin_amdgcn_s_sleep(1); \
    if ((++_sp & 255u) == 0u) { if (xb_ld(&(bar)[XB_TMO])) break; if (_sp > XB_SPIN_CAP) { atomicAdd(&(bar)[XB_TMO], 1u); break; } } } } while (0)
struct XcdBarrier { unsigned* bar; unsigned x; volatile XLAS unsigned* st; };
DI XcdBarrier xcd_barrier_post(unsigned* bar, volatile XLAS unsigned* st) {
  XcdBarrier b; b.bar = bar; b.x = xb_xcc_id(); b.st = st;
  if (threadIdx.x == 0) (void)xb_add(&bar[XB_XCNT(b.x)], 1u);
  return b;
}
DI void xcd_barrier_complete(unsigned* bar, unsigned x, unsigned& nloc, unsigned& nx) {
  const unsigned G = gridDim.x * gridDim.y * gridDim.z;
  unsigned sum, cnt, mine, sp = 0u;
  for (;;) {
    sum = 0u; cnt = 0u; mine = 0u;
#pragma unroll
    for (unsigned j = 0; j < 16; ++j) { const unsigned c = xb_ld(&bar[XB_XCNT(j)]); sum += c; cnt += (c > 0u) ? 1u : 0u; mine = (j == x) ? c : mine; }
    if (sum == G) break;
    __builtin_amdgcn_s_sleep(1);
    if ((++sp & 255u) == 0u) { if (xb_ld(&bar[XB_TMO])) break; if (sp > XB_SPIN_CAP) { atomicAdd(&bar[XB_TMO], 1u); break; } }
  }
  nloc = mine > 0u ? mine : 1u; nx = cnt > 0u ? cnt : 1u;
}
DI void xcd_barrier(const XcdBarrier& b) {
  asm volatile("s_waitcnt vmcnt(0)" ::: "memory");
  __syncthreads();
  if (threadIdx.x == 0) {
    unsigned* bar = b.bar;
    __builtin_amdgcn_s_waitcnt(0);
    unsigned nloc = b.st[0], nx = b.st[1];
    if (nloc == 0u) { xcd_barrier_complete(bar, b.x, nloc, nx); b.st[0] = nloc; b.st[1] = nx; }
    const unsigned old = xb_add(&bar[XB_XSUB(b.x)], 1u);
    const unsigned gen = old / nloc;
    if (old + 1u == (gen + 1u) * nloc) {
      __builtin_amdgcn_fence(__ATOMIC_RELEASE, "agent");
      asm volatile("s_waitcnt vmcnt(0)" ::: "memory");
      const unsigned og = xb_add(&bar[XB_TOP], 1u);
      const unsigned tg = og / nx;
      if (og + 1u == (tg + 1u) * nx) xb_add(&bar[XB_TOPGEN], 1u);
      else XB_SPIN(xb_ld(&bar[XB_TOPGEN]) == tg, bar);
      __builtin_amdgcn_fence(__ATOMIC_ACQUIRE, "agent");
      xb_add(&bar[XB_XGEN(b.x)], 1u);
      asm volatile("s_waitcnt vmcnt(0)" ::: "memory");
    } else {
      XB_SPIN(xb_ld(&bar[XB_XGEN(b.x)]) == gen, bar);
      __builtin_amdgcn_fence(__ATOMIC_ACQUIRE, "agent");
      asm volatile("s_waitcnt vmcnt(0)" ::: "memory");
    }
  }
  __syncthreads();
}

#define GSYNC() do { xcd_barrier(xb); if (PROBE & 128) xcd_barrier(xb); } while (0)
template <int layer>
DI void run_layer(const Params& pp, const XcdBarrier& xb, char* smem_all, int wv0) {
  const int hb = wv0 >> 2;
  char* smem = smem_all + hb * HALF_LDS;
  const int vb = blockIdx.x * 2 + hb, nvb = gridDim.x * 2;
#define PH_BEGIN Params p = pp; p.wv = wv0; asm volatile("" : "+s"(p.ws), "+s"(p.out), "+s"(p.wv));
  {
    PH_BEGIN
    __syncthreads();
    EpiWin E{(u16*)(p.ws + OFF_RB), (u16*)(p.ws + OFF_PQT), (const float2*)(p.ws + OFF_TAB)};
    for (int rep_ = 0; rep_ < 1 + (((PROBE >> 8) & 1) && layer == 0 ? 1 : 0); ++rep_)
    g8::gemm_phase<1024, 1024, 1024, 320, 17>(p.wv, (G8_LAS unsigned char*)smem_all, (const u16*)(p.ws + OFF_RA), (const u16*)(p.ws + OFF_WT + layer * WT_LAYER + WT_IN), E);
  }
  GSYNC();
  {
    PH_BEGIN
    int* ctr = (int*)(p.ws + OFF_CTR) + layer * 2 + 0;
    volatile int* slot = (volatile int*)(smem_all + 2 * HALF_LDS);
    for (;;) {
      __syncthreads();
      if (p.wv == 0 && lane_now() == 0) *slot = atomicAdd(ctr, 2);
      __syncthreads();
      const int it = *slot + hb;
      if (it >= N_P2) break;
      int i = it;
      if (i < N_RST) { ph_retscan(p, i, layer, smem); continue; }
      i -= N_RST;
      if (i < N_DIL) { if ((PROBE & 2) && layer == 0) ph_dil(p, i, smem, true); ph_dil(p, i, smem); continue; }
      i -= N_DIL;
      if (i < N_QP) { ph_qproj(p, i, layer, smem); continue; }
      i -= N_QP;
      if (i < N_KVP) { ph_kvproj(p, i, layer, smem); continue; }
      i -= N_KVP;
      ph_pqfold(p, i);
    }
  }
  GSYNC();
  {
    PH_BEGIN
    int* ctr = (int*)(p.ws + OFF_CTR) + layer * 2 + 1;
    volatile int* slot = (volatile int*)(smem_all + 2 * HALF_LDS);
    for (;;) {
      __syncthreads();
      if (p.wv == 0 && lane_now() == 0) *slot = atomicAdd(ctr, 2);
      __syncthreads();
      const int it = *slot + hb;
      if (it >= N_P3) break;
      int i = it;
      if (i < N_FM) { ph_fmid(p, i); continue; }
      i -= N_FM;
      if (i < N_MLA) { if ((PROBE & 4) && layer == 0) ph_mla(p, i, smem); ph_mla(p, i, smem); continue; }
      i -= N_MLA;
      if (i < N_FG) { ph_fgemm(p, i, smem); continue; }
      i -= N_FG;
      if (i < N_RO) { ph_retout(p, i, layer, smem); continue; }
      i -= N_RO;
      ph_comb(p, i);
    }
  }
  GSYNC();
  {
    PH_BEGIN
    __syncthreads();
    g8::EpiStore E{(u16*)(p.ws + OFF_RA), 1024};
    for (int rep_ = 0; rep_ < 1 + (((PROBE >> 9) & 1) && layer == 0 ? 1 : 0); ++rep_)
    g8::gemm_phase<ZW, 1024, 1024, 320, 4>(p.wv, (G8_LAS unsigned char*)smem_all, (const u16*)(p.ws + OFF_RB) + Z_RG, (const u16*)(p.ws + OFF_WT + layer * WT_LAYER + WT_OUT), E);
  }
  GSYNC();
  {
    PH_BEGIN
    for (int it = vb; it < 5120; it += nvb) { if ((PROBE & 32) && layer == 0) ph_ew(p, it, 1, layer); ph_ew(p, it, 1, layer); }
  }
  GSYNC();
  {
    PH_BEGIN
    __syncthreads();
    EpiUp E{(u16*)(p.ws + OFF_RB + RB_GATED), p.conv_w + (size_t)layer * 3 * 5632, p.conv_b + (size_t)layer * 5632, smem_all + 131072, p.wv};
    for (int rep_ = 0; rep_ < 1 + (((PROBE >> 10) & 1) && layer == 0 ? 1 : 0); ++rep_)
    g8::gemm_phase<1024, 1024, 1024, 323, 22>(p.wv, (G8_LAS unsigned char*)smem_all, (const u16*)(p.ws + OFF_RB + RB_H2), (const u16*)(p.ws + OFF_WT + layer * WT_LAYER + WT_UP), E);
  }
  GSYNC();
  {
    PH_BEGIN
    __syncthreads();
    g8::EpiStore E{(u16*)(p.ws + OFF_RA), 1024};
    for (int rep_ = 0; rep_ < 1 + (((PROBE >> 11) & 1) && layer == 0 ? 1 : 0); ++rep_)
    g8::gemm_phase<DFF, DFF, DFF, 320, 4>(p.wv, (G8_LAS unsigned char*)smem_all, (const u16*)(p.ws + OFF_RB + RB_GATED), (const u16*)(p.ws + OFF_WT + layer * WT_LAYER + WT_DOWN), E);
  }
  GSYNC();
  {
    PH_BEGIN
    for (int it = vb; it < 5120; it += nvb) ph_ew(p, it, 2, layer);
  }
}

__global__ void __launch_bounds__(512, 2) mega(Params pp) {
  extern __shared__ __attribute__((aligned(16))) char smem_all[];
  cg::grid_group grid = cg::this_grid();
  const int wv0 = __builtin_amdgcn_readfirstlane(threadIdx.x >> 6);
  volatile XLAS unsigned* xst = (volatile XLAS unsigned*)(smem_all + 2 * HALF_LDS + 16);
  if (threadIdx.x < 2) xst[threadIdx.x] = 0u;
  __syncthreads();
  XcdBarrier xb = xcd_barrier_post((unsigned*)(pp.ws + OFF_BAR), xst);
  {
    const int hb = wv0 >> 2;
    char* smem = smem_all + hb * HALF_LDS;
    const int vb = blockIdx.x * 2 + hb, nvb = gridDim.x * 2;
    {
      PH_BEGIN
      int* ctr = (int*)(p.ws + OFF_CTR) + 8;
      volatile int* slot = (volatile int*)(smem_all + 2 * HALF_LDS);
      for (;;) {
        __syncthreads();
        if (p.wv == 0 && lane_now() == 0) *slot = atomicAdd(ctr, 2);
        __syncthreads();
        const int j = *slot + hb;
        if (j >= N_PREP) break;
        int it;
        if (j < 192) it = PI_TR + PI_FOLD + PI_PAD + j;
        else if (j < 320) it = PI_TR + (j - 192);
        else if (j < 576) it = PI_TR + PI_FOLD + PI_PAD + PI_MOD + (j - 320);
        else if (j < 832) it = PI_TR + PI_FOLD + PI_PAD + PI_MOD + PI_DFT + (j - 576);
        else if (j < 834) it = PI_TR + PI_FOLD + (j - 832);
        else it = j - 834;
        ph_prep(p, it, smem);
      }
    }
    grid.sync();
    {
      PH_BEGIN
      for (int it = vb; it < 5120; it += nvb) ph_ew(p, it, 0, 0);
    }
    GSYNC();
  }
  run_layer<0>(pp, xb, smem_all, wv0);
  GSYNC();
  run_layer<1>(pp, xb, smem_all, wv0);
}

extern "C" void kernel_launch(void* const* d_in, const int* in_sizes, int n_in, void* d_out, int out_size, void* d_ws,
                              size_t ws_size, hipStream_t stream) {
  static int grid_blocks = 0;
  if (!grid_blocks) {
    hipFuncSetAttribute((const void*)mega, hipFuncAttributeMaxDynamicSharedMemorySize, DYN_LDS);
    int dev = 0, cus = 0, per_cu = 0;
    hipGetDevice(&dev);
    hipDeviceGetAttribute(&cus, hipDeviceAttributeMultiprocessorCount, dev);
    hipOccupancyMaxActiveBlocksPerMultiprocessor(&per_cu, mega, 512, DYN_LDS);
    if (per_cu > 1) per_cu = 1;
    if (per_cu < 1) per_cu = 1;
    grid_blocks = cus * per_cu;
  }
  if (ws_size < WS_NEED) { fprintf(stderr, "workspace too small: %zu < %zu\n", ws_size, (size_t)WS_NEED); return; }
  Params p{};
  const float** f = (const float**)&p;
  for (int i = 0; i < 23; ++i) f[i] = (const float*)d_in[i];
  p.out = (float*)d_out;
  p.ws = (char*)d_ws;
#if 0
#else
  hipMemsetAsync((char*)d_ws + OFF_CTR, 0, 4096 + 16384, stream);
  p.ph_lo = 0;
  p.ph_hi = 20;
  void* args[] = {&p};
  hipError_t e = hipLaunchCooperativeKernel((void*)mega, dim3(grid_blocks), dim3(512), args, DYN_LDS, stream);
  if (e != hipSuccess) fprintf(stderr, "cooperative launch failed: %s (grid %d)\n", hipGetErrorString(e), grid_blocks);
#endif
}
```

```cpp
#include <hip/hip_runtime.h>
#include <hip/hip_cooperative_groups.h>
#include <cstdio>
namespace cg = cooperative_groups;

#ifndef PROBE
#define PROBE 0
#endif
#ifndef MULTI
#define MULTI 0
#endif

#define DI __device__ __forceinline__
typedef unsigned short u16;
typedef __attribute__((ext_vector_type(8))) short bf16x8;
typedef __attribute__((ext_vector_type(4))) float f32x4;

constexpr int NTOK = 81920;
constexpr int ZW = 3744;
constexpr int Z_RQ = 0, Z_RK = 256, Z_RV = 512, Z_RG = 768, Z_DK0 = 1024, Z_DQ0 = 1280, Z_CQ = 1536, Z_CKV = 3584, Z_KR = 3712;
__device__ __forceinline__ int zdq(int g) { return g == 0 ? 1280 : 1792 + (g - 1) * 256; }
__device__ __forceinline__ int zdk(int g) { return g == 0 ? 1024 : 2304 + (g - 1) * 256; }
__device__ __forceinline__ int zdv(int g) { return 2816 + g * 256; }
constexpr int DFF = 2816;
constexpr float EPS = 1e-6f;
constexpr float LOG2E = 1.4426950408889634f;
constexpr float LN2 = 0.6931471805599453f;

constexpr size_t OFF_RA = 0;
constexpr size_t OFF_RB = 167772160ull;
constexpr size_t OFF_PQT = OFF_RB + 613416960ull;
constexpr size_t OFF_RS = OFF_RB + 697303040ull;
constexpr size_t OFF_WT = OFF_RS + 83886080ull;
constexpr size_t WT_LAYER = 28639232ull;
constexpr size_t WT_IN = 0, WT_OUT = 8912896ull, WT_UP = 11010048ull, WT_DOWN = 22544384ull, WT_QB = 28311552ull, WT_KVB = 28508160ull;
constexpr size_t OFF_DFT = OFF_WT + 2 * WT_LAYER;
constexpr size_t OFF_TAB = OFF_DFT + 33554432ull;
constexpr size_t OFF_MOD = OFF_TAB + 1835008ull;
constexpr size_t OFF_LSE = OFF_MOD + 1769472ull;
constexpr size_t OFF_CTR = OFF_LSE + 3932160ull;
constexpr size_t OFF_BAR = OFF_CTR + 4096ull;
constexpr size_t WS_NEED = OFF_BAR + 16384ull;
constexpr size_t RA_QM = 0, RA_KB = 62914560ull, RA_VT = 125829120ull;
constexpr size_t RB_H2 = 0, RB_GATED = 169345024ull;

constexpr int HALF_LDS = 73728;
constexpr int DYN_LDS = 2 * HALF_LDS + 64;

struct Params {
  const float *x_p, *x_s, *c_p, *c_s, *w_ada, *b_ada, *n_pre_mix, *w_in, *dec_f, *dec_b, *w_fmix, *q_norm, *w_qb, *kv_norm,
      *w_kvb, *w_out, *n_post_mix, *n_pre_ffn, *w_up, *conv_w, *conv_b, *w_down, *n_post_ffn;
  float* out;
  char* ws;
  int ph_lo, ph_hi, wv, pad_;
};

DI int lane_now() { int l; asm volatile("v_mbcnt_lo_u32_b32 %0, -1, 0\n\tv_mbcnt_hi_u32_b32 %0, -1, %0" : "=v"(l)); return l; }
DI int ltid_w(int wv) { int t = ((wv & 3) << 6) | lane_now(); asm volatile("" : "+v"(t)); return t; }
#define ltid() ltid_w(p.wv)
DI u16 f2bf(float x) { __bf16 h = (__bf16)x; return __builtin_bit_cast(u16, h); }
DI float bf2f(unsigned b) { return __uint_as_float(b << 16); }
typedef __bf16 bf16x2_t __attribute__((ext_vector_type(2)));
typedef float f32x2_t __attribute__((ext_vector_type(2)));
DI unsigned pack2(float a, float b) { f32x2_t v = {a, b}; bf16x2_t r = __builtin_convertvector(v, bf16x2_t); return __builtin_bit_cast(unsigned, r); }
DI float fsilu(float a) { return a * __builtin_amdgcn_rcpf(1.f + __expf(-a)); }
DI uint2 pack4(const f32x4& v) { return make_uint2(pack2(v[0], v[1]), pack2(v[2], v[3])); }
DI float blo(unsigned w) { return __uint_as_float(w << 16); }
DI float bhi(unsigned w) { return __uint_as_float(w & 0xffff0000u); }
DI int tok0_of_batch(int bi) { return bi < 4 ? bi * 4096 : 16384 + (bi - 4) * 2048; }
DI void tile_info(int tile, int& bi, int& S, int& pos0) {
  if (tile < 128) { bi = tile >> 5; S = 4096; pos0 = (tile & 31) << 7; }
  else { int t = tile - 128; bi = 4 + (t >> 4); S = 2048; pos0 = (t & 15) << 7; }
}
DI int batch_of_tok(int tok) { return tok < 16384 ? (tok >> 12) : 4 + ((tok - 16384) >> 11); }

template <int TM, int TN>
DI void mma(const u16* sA, int lda, const u16* sB, int ldb, int ksteps, f32x4 (&acc)[TM][TN], int lane) {
  const int r = lane & 15, q = lane >> 4;
  for (int ks = 0; ks < ksteps; ++ks) {
    bf16x8 a[TM], b[TN];
#pragma unroll
    for (int i = 0; i < TM; ++i) a[i] = *(const bf16x8*)(sA + (i * 16 + r) * lda + ks * 32 + q * 8);
#pragma unroll
    for (int i = 0; i < TN; ++i) b[i] = *(const bf16x8*)(sB + (i * 16 + r) * ldb + ks * 32 + q * 8);
#pragma unroll
    for (int i = 0; i < TM; ++i)
#pragma unroll
      for (int j = 0; j < TN; ++j) acc[i][j] = __builtin_amdgcn_mfma_f32_16x16x32_bf16(b[j], a[i], acc[i][j], 0, 0, 0);
  }
}
template <int TM, int TN>
DI void zero_acc(f32x4 (&acc)[TM][TN]) {
  float zz = 0.f;
  asm volatile("" : "+v"(zz));
#pragma unroll
  for (int i = 0; i < TM; ++i)
#pragma unroll
    for (int j = 0; j < TN; ++j) acc[i][j] = f32x4{zz, zz, zz, zz};
}

template <class LA, class LB, class EP>
DI void gemm_tile_(int wv_, char* smem, int nk, LA loadA, LB loadB, EP epi) {
  u16* sA = (u16*)smem;
  u16* sB = sA + 128 * 72;
  const int tid = ltid_w(wv_), lane = tid & 63, w = tid >> 6, wm = w >> 1, wn = w & 1;
  const int lr = tid >> 3, lk = (tid & 7) * 8;
  uint4 ra[4], rb[4];
  f32x4 acc[4][4];
  zero_acc(acc);
#pragma unroll
  for (int i = 0; i < 4; ++i) { ra[i] = loadA(lr + 32 * i, lk); rb[i] = loadB(lr + 32 * i, lk); }
  for (int kt = 0; kt < nk; ++kt) {
    __syncthreads();
#pragma unroll
    for (int i = 0; i < 4; ++i) {
      *(uint4*)(sA + (lr + 32 * i) * 72 + lk) = ra[i];
      *(uint4*)(sB + (lr + 32 * i) * 72 + lk) = rb[i];
    }
    __syncthreads();
    if (kt + 1 < nk) {
#pragma unroll
      for (int i = 0; i < 4; ++i) { ra[i] = loadA(lr + 32 * i, (kt + 1) * 64 + lk); rb[i] = loadB(lr + 32 * i, (kt + 1) * 64 + lk); }
    }
    mma<4, 4>(sA + wm * 64 * 72, 72, sB + wn * 64 * 72, 72, 2, acc, lane);
  }
  epi(acc, wm, wn, lane);
}

template <class LA, class LB, class EP>
DI void gemm_tile2_(int wv_, char* smem, int nk, LA loadA, LB loadB, EP epi) {
  u16* sA = (u16*)smem;
  u16* sB = sA + 128 * 72;
  const int tid = ltid_w(wv_), lane = tid & 63, w = tid >> 6, wm = w >> 1, wn = w & 1;
  const int lr = tid >> 3, lk = (tid & 7) * 8;
  uint4 ra[4], rb[2];
  f32x4 acc[4][2], acc1[4][2];
  zero_acc(acc);
  zero_acc(acc1);
#pragma unroll
  for (int i = 0; i < 4; ++i) ra[i] = loadA(lr + 32 * i, lk);
#pragma unroll
  for (int i = 0; i < 2; ++i) rb[i] = loadB(lr + 32 * i, lk);
  const int nkh = nk >> 1;
  for (int kt = 0; kt < nk; ++kt) {
    __syncthreads();
#pragma unroll
    for (int i = 0; i < 4; ++i) *(uint4*)(sA + (lr + 32 * i) * 72 + lk) = ra[i];
#pragma unroll
    for (int i = 0; i < 2; ++i) *(uint4*)(sB + (lr + 32 * i) * 72 + lk) = rb[i];
    __syncthreads();
    if (kt + 1 < nk) {
#pragma unroll
      for (int i = 0; i < 4; ++i) ra[i] = loadA(lr + 32 * i, (kt + 1) * 64 + lk);
#pragma unroll
      for (int i = 0; i < 2; ++i) rb[i] = loadB(lr + 32 * i, (kt + 1) * 64 + lk);
    }
    if (kt == nkh) {
#pragma unroll
      for (int i = 0; i < 4; ++i)
#pragma unroll
        for (int j = 0; j < 2; ++j) { acc1[i][j] = acc[i][j]; acc[i][j] = f32x4{0.f, 0.f, 0.f, 0.f}; }
    }
    mma<4, 2>(sA + wm * 64 * 72, 72, sB + wn * 32 * 72, 72, 2, acc, lane);
  }
  epi(acc1, acc, wm, wn, lane);
}

DI void rope_pair(f32x4& a, f32x4& b, const float2* tabrow, int q, float sc) {
#pragma unroll
  for (int jj = 0; jj < 4; ++jj) {
    float2 cs = tabrow[q * 4 + jj];
    float x1 = a[jj], x2 = b[jj];
    a[jj] = (x1 * cs.x - x2 * cs.y) * sc;
    b[jj] = (x2 * cs.x + x1 * cs.y) * sc;
  }
}

constexpr int PI_TRL = 3416, PI_TR = 2 * PI_TRL, PI_FOLD = 128, PI_PAD = 2, PI_MOD = 192, PI_DFT = 256, PI_TAB = 256;
constexpr int N_PREP = PI_TR + PI_FOLD + PI_PAD + PI_MOD + PI_DFT + PI_TAB;

DI int swap45(int c) { return (c & 15) | ((c & 16) << 1) | ((c & 32) >> 1); }
DI void tr_tile_(int wv_, char* smem, const float* src, int lds, int k0, int s0, int nvalid, u16* dst, int ldd, int n0, const float* kscale, bool perm = false) {
  float* t = (float*)smem;
  const int tid = ltid_w(wv_);
  __syncthreads();
#pragma unroll 4
  for (int i = 0; i < 16; ++i) {
    int kr = (tid >> 6) + 4 * i, c = tid & 63;
    float v = (c < nvalid) ? src[(size_t)(k0 + kr) * lds + s0 + c] : 0.f;
    if (kscale) v *= kscale[k0 + kr];
    t[c * 65 + kr] = v;
  }
  __syncthreads();
#pragma unroll 4
  for (int i = 0; i < 16; ++i) {
    int c = (tid >> 6) + 4 * i, kr = tid & 63;
    if (c < nvalid) dst[(size_t)(n0 + (perm ? swap45(c) : c)) * ldd + k0 + kr] = f2bf(t[c * 65 + kr]);
  }
}

DI void ph_prep(const Params& p, int item, char* smem) {
  const int tid = ltid();
  if (item < PI_TR) {
    int layer = item / PI_TRL, it = item % PI_TRL;
    char* wt = p.ws + OFF_WT + layer * WT_LAYER;
    if (it < 1008) {
      int ct = it >> 4, kt = it & 15;
      if (ct >= 16 && ct < 20) return;
      int s0 = ct * 64, zc;
      if (s0 < 1536) zc = s0; else if (s0 < 2048) zc = s0 + 256; else if (s0 < 2304) zc = s0 - 1024; else if (s0 < 3584) zc = s0;
      else if (s0 < 3840) zc = s0 - 2048; else zc = s0 - 256;
      int n0 = 512 + zc;
      int nv = 4000 - s0 < 64 ? 4000 - s0 : 64;
      tr_tile_(p.wv, smem, p.w_in + (size_t)layer * 1024 * 4000, 4000, kt * 64, s0, nv, (u16*)(wt + WT_IN), 1024, n0, nullptr, s0 < 512);
      return;
    }
    it -= 1008;
    if (it < 256) { tr_tile_(p.wv, smem, p.w_out + (size_t)layer * 1024 * 1024, 1024, (it & 15) * 64, (it >> 4) * 64, 64, (u16*)(wt + WT_OUT), 1024, (it >> 4) * 64, nullptr); return; }
    it -= 256;
    if (it < 1408) {
      int s0 = (it >> 4) * 64, n0;
      if (s0 < DFF) n0 = (s0 >> 7) * 256 + (s0 & 127); else { int sb = s0 - DFF; n0 = (sb >> 7) * 256 + 128 + (sb & 127); }
      tr_tile_(p.wv, smem, p.w_up + (size_t)layer * 1024 * 5632, 5632, (it & 15) * 64, s0, 64, (u16*)(wt + WT_UP), 1024, n0, nullptr);
      return;
    }
    it -= 1408;
    if (it < 704) { int kt = it % 44, ct = it / 44; tr_tile_(p.wv, smem, p.w_down + (size_t)layer * 2816 * 1024, 1024, kt * 64, ct * 64, 64, (u16*)(wt + WT_DOWN), 2816, ct * 64, nullptr); return; }
    it -= 704;
    if (it < 24) { int kt = it & 3, ct = it >> 2; tr_tile_(p.wv, smem, p.w_qb + (size_t)layer * 256 * 384, 384, kt * 64, ct * 64, 64, (u16*)(wt + WT_QB), 256, ct * 64, p.q_norm + layer * 256); return; }
    it -= 24;
    { int kt = it & 1, ct = it >> 1; tr_tile_(p.wv, smem, p.w_kvb + (size_t)layer * 128 * 512, 512, kt * 64, ct * 64, 64, (u16*)(wt + WT_KVB), 128, ct * 64, p.kv_norm + layer * 128); return; }
  }
  item -= PI_TR;
  if (item < PI_FOLD) {
    int layer = item >> 6, g = (item >> 4) & 3, cs = (item >> 3) & 1, kc = item & 7;
    float* M = (float*)smem;
    float* ct = M + 4096;
    __syncthreads();
    if (tid < 64) ct[tid] = cospif((float)tid / 32.f);
    __syncthreads();
    const float* Wf = p.w_fmix + ((size_t)layer * 4 + g) * 4096;
    for (int i = 0; i < 16; ++i) {
      int idx = tid + 256 * i, c = idx >> 6, e = idx & 63;
      float a = 0.f;
      for (int c2 = 0; c2 < 64; ++c2) {
        int x = (c * c2) & 63;
        float tv = cs ? ct[(x - 16) & 63] : ct[x];
        a += tv * Wf[c2 * 64 + e];
      }
      M[c * 64 + e] = a;
    }
    __syncthreads();
    const float* W = p.w_in + (size_t)layer * 1024 * 4000 + 1024 + g * 64;
    u16* dst = (u16*)(p.ws + OFF_WT + layer * WT_LAYER + WT_IN);
    int e = tid & 63, kq = tid >> 6;
    for (int i = 0; i < 32; ++i) {
      int k = kc * 128 + kq * 32 + i;
      float a = 0.f;
#pragma unroll 8
      for (int c = 0; c < 64; ++c) a += W[(size_t)k * 4000 + c] * M[c * 64 + e];
      dst[(size_t)(cs * 256 + g * 64 + e) * 1024 + k] = f2bf(a);
    }
    return;
  }
  item -= PI_FOLD;
  if (item < PI_PAD) {
    uint4* dst = (uint4*)(p.ws + OFF_WT + item * WT_LAYER + WT_IN + (size_t)4256 * 1024 * 2);
    for (int i = tid; i < 96 * 1024 * 2 / 16; i += 256) dst[i] = make_uint4(0, 0, 0, 0);
    return;
  }
  item -= PI_PAD;
  if (item < PI_MOD) {
    int layer = item / 96, cb = item % 96;
    float* sC = (float*)smem;
    float* sR = sC + 4608;
    int col = cb * 64 + (tid & 63), kq = tid >> 6;
    float acc[36];
#pragma unroll
    for (int b = 0; b < 36; ++b) acc[b] = 0.f;
    const float* wa = p.w_ada + (size_t)layer * 1024 * 6144;
#pragma unroll 1
    for (int kc = 0; kc < 8; ++kc) {
      __syncthreads();
#pragma unroll 2
      for (int i = 0; i < 18; ++i) {
        int idx = tid + 256 * i, qq = idx / 1152, rem = idx % 1152, b = rem >> 5, kk = rem & 31;
        int k = qq * 256 + kc * 32 + kk;
        float c = b < 4 ? p.c_p[b * 1024 + k] : p.c_s[(b - 4) * 1024 + k];
        sC[idx] = fsilu(c);
      }
      __syncthreads();
#pragma unroll 2
      for (int kk = 0; kk < 32; ++kk) {
        float wv = wa[(size_t)(kq * 256 + kc * 32 + kk) * 6144 + col];
#pragma unroll
        for (int b = 0; b < 36; ++b) acc[b] += sC[(kq * 36 + b) * 32 + kk] * wv;
      }
    }
    __syncthreads();
#pragma unroll
    for (int b = 0; b < 36; ++b) sR[(kq * 36 + b) * 64 + (tid & 63)] = acc[b];
    __syncthreads();
    float* mod = (float*)(p.ws + OFF_MOD) + (size_t)layer * 36 * 6144;
    for (int i = 0; i < 9; ++i) {
      int idx = tid + 256 * i, b = idx >> 6, c = idx & 63;
      float s = sR[(0 * 36 + b) * 64 + c] + sR[(1 * 36 + b) * 64 + c] + sR[(2 * 36 + b) * 64 + c] + sR[(3 * 36 + b) * 64 + c];
      mod[b * 6144 + cb * 64 + c] = s + p.b_ada[layer * 6144 + cb * 64 + c];
    }
    return;
  }
  item -= PI_MOD;
  if (item < PI_DFT) {
    float* tab = (float*)smem;
    __syncthreads();
    for (int i = tid; i < 4096; i += 256) tab[i] = cospif((float)i / 2048.f);
    __syncthreads();
    u16* dft = (u16*)(p.ws + OFF_DFT);
    for (int rr = 0; rr < 16; ++rr) {
      int j = item * 16 + rr;
      for (int i = 0; i < 2; ++i) {
        int ch = tid + 256 * i;
        int kb = (ch & 255) * 8;
        bool sn = ch >= 256;
        unsigned wv[4];
#pragma unroll
        for (int e = 0; e < 8; e += 2) {
          int i0 = (j * (kb + e)) & 4095, i1 = (j * (kb + e + 1)) & 4095;
          float v0 = sn ? -tab[(i0 - 1024) & 4095] : tab[i0];
          float v1 = sn ? -tab[(i1 - 1024) & 4095] : tab[i1];
          wv[e >> 1] = pack2(v0, v1);
        }
        *(uint4*)(dft + (size_t)j * 4096 + ch * 8) = make_uint4(wv[0], wv[1], wv[2], wv[3]);
      }
    }
    return;
  }
  item -= PI_DFT;
  {
    float2* tab = (float2*)(p.ws + OFF_TAB);
    for (int idx = tid; idx < 896; idx += 256) {
      int pos = item * 16 + idx / 56, a = idx % 56;
      float inv;
      if (a < 16) inv = powf(500000.f, -(float)a * 2.f / 32.f);
      else if (a < 24) inv = powf(500000.f, -(float)(a - 16) * 2.f / 16.f);
      else inv = powf(10000.f, -(float)(a - 24) * 2.f / 64.f);
      float ang = (float)pos * inv;
      float s, c;
      sincosf(ang, &s, &c);
      tab[pos * 56 + a] = make_float2(c, s);
    }
  }
}

DI void ph_ew(const Params& p, int item, int mode, int layer) {
  const int tid = ltid(), lane = tid & 63, w = tid >> 6;
  const float* mod = (const float*)(p.ws + OFF_MOD);
  for (int i = 0; i < 4; ++i) {
    int tok = item * 16 + w * 4 + i;
    int bi = batch_of_tok(tok);
    const float* xin;
    if (mode == 0 || (mode == 1 && layer == 0)) xin = tok < 16384 ? p.x_p + (size_t)tok * 1024 : p.x_s + (size_t)(tok - 16384) * 1024;
    else xin = p.out + (size_t)tok * 1024;
    float x[16];
#pragma unroll
    for (int h2 = 0; h2 < 2; ++h2) {
      const float4* xp = (const float4*)(xin + lane * 8 + 512 * h2);
      float4 a = xp[0], b = xp[1];
      x[h2 * 8 + 0] = a.x; x[h2 * 8 + 1] = a.y; x[h2 * 8 + 2] = a.z; x[h2 * 8 + 3] = a.w;
      x[h2 * 8 + 4] = b.x; x[h2 * 8 + 5] = b.y; x[h2 * 8 + 6] = b.z; x[h2 * 8 + 7] = b.w;
    }
    if (mode != 0) {
      const u16* y = (const u16*)(p.ws + OFF_RA) + (size_t)tok * 1024;
      float yv[16];
      float ss = 0.f;
#pragma unroll
      for (int h2 = 0; h2 < 2; ++h2) {
        uint4 v = *(const uint4*)(y + lane * 8 + 512 * h2);
        unsigned wv[4] = {v.x, v.y, v.z, v.w};
#pragma unroll
        for (int e = 0; e < 4; ++e) { yv[h2 * 8 + 2 * e] = blo(wv[e]); yv[h2 * 8 + 2 * e + 1] = bhi(wv[e]); }
      }
#pragma unroll
      for (int e = 0; e < 16; ++e) ss += yv[e] * yv[e];
#pragma unroll
      for (int o = 1; o < 64; o <<= 1) ss += __shfl_xor(ss, o);
      float rs = rsqrtf(ss * (1.f / 1024.f) + EPS);
      const float* npost = (mode == 1 ? p.n_post_mix : p.n_post_ffn) + layer * 1024;
      const float* g = mod + ((size_t)layer * 36 + bi) * 6144 + (mode == 1 ? 2048 : 5120);
#pragma unroll
      for (int h2 = 0; h2 < 2; ++h2)
#pragma unroll
        for (int e = 0; e < 8; ++e) {
          int c = lane * 8 + 512 * h2 + e;
          x[h2 * 8 + e] += g[c] * (yv[h2 * 8 + e] * rs * npost[c]);
        }
      float* xo = p.out + (size_t)tok * 1024;
#pragma unroll
      for (int h2 = 0; h2 < 2; ++h2) {
        float4* op = (float4*)(xo + lane * 8 + 512 * h2);
        op[0] = make_float4(x[h2 * 8 + 0], x[h2 * 8 + 1], x[h2 * 8 + 2], x[h2 * 8 + 3]);
        op[1] = make_float4(x[h2 * 8 + 4], x[h2 * 8 + 5], x[h2 * 8 + 6], x[h2 * 8 + 7]);
      }
    }
    if (mode == 2 && layer == 1) continue;
    int nl = mode == 2 ? layer + 1 : layer;
    const float* npre = (mode == 1 ? p.n_pre_ffn : p.n_pre_mix) + nl * 1024;
    const float* mb = mod + ((size_t)nl * 36 + bi) * 6144 + (mode == 1 ? 3072 : 0);
    float ss = 0.f;
#pragma unroll
    for (int e = 0; e < 16; ++e) ss += x[e] * x[e];
#pragma unroll
    for (int o = 1; o < 64; o <<= 1) ss += __shfl_xor(ss, o);
    float rs = rsqrtf(ss * (1.f / 1024.f) + EPS);
    const int umt = tok / 254, urr = tok % 254;
    u16* hd = mode == 1 ? (u16*)(p.ws + OFF_RB + RB_H2) + ((size_t)umt * 256 + urr + 1) * 1024 : (u16*)(p.ws + OFF_RA) + (size_t)tok * 1024;
#pragma unroll
    for (int h2 = 0; h2 < 2; ++h2) {
      unsigned wv[4];
#pragma unroll
      for (int e = 0; e < 8; e += 2) {
        int c = lane * 8 + 512 * h2 + e;
        float v0 = x[h2 * 8 + e] * rs * npre[c] * (1.f + mb[1024 + c]) + mb[c];
        float v1 = x[h2 * 8 + e + 1] * rs * npre[c + 1] * (1.f + mb[1024 + c + 1]) + mb[c + 1];
        wv[e >> 1] = pack2(v0, v1);
      }
      uint4 ov = make_uint4(wv[0], wv[1], wv[2], wv[3]);
      *(uint4*)(hd + lane * 8 + 512 * h2) = ov;
      if (mode == 1) {
        u16* hb = (u16*)(p.ws + OFF_RB + RB_H2);
        if (urr == 0 && umt > 0) *(uint4*)(hb + ((size_t)(umt - 1) * 256 + 255) * 1024 + lane * 8 + 512 * h2) = ov;
        if (urr == 253 && umt + 1 < 323) *(uint4*)(hb + ((size_t)(umt + 1) * 256) * 1024 + lane * 8 + 512 * h2) = ov;
      }
    }
  }
}

DI void ph_win(const Params& p, int item, int layer, char* smem) {
  const int nt = item % 34, tile = item / 34;
  int bi, S, pos0;
  tile_info(tile, bi, S, pos0);
  const u16* h = (const u16*)(p.ws + OFF_RA) + (size_t)tile * 128 * 1024;
  const u16* wt = (const u16*)(p.ws + OFF_WT + layer * WT_LAYER + WT_IN) + (size_t)nt * 128 * 1024;
  u16* z = (u16*)(p.ws + OFF_RB);
  u16* pqt = (u16*)(p.ws + OFF_PQT) + (size_t)tok0_of_batch(bi) * 512;
  const float2* tab = (const float2*)(p.ws + OFF_TAB);
  auto la = [&](int row, int k) { return *(const uint4*)(h + (size_t)row * 1024 + k); };
  auto lb = [&](int n, int k) { return *(const uint4*)(wt + (size_t)n * 1024 + k); };
  auto epi = [&](f32x4 (&acc)[4][4], int wm, int wn, int lane) {
    const int r = lane & 15, q = lane >> 4;
    const int nw0 = nt * 128 + wn * 64;
    const int zc0 = nw0 - 512;
    if (nt >= 4 && zc0 >= ZW) return;
#pragma unroll
    for (int tm = 0; tm < 4; ++tm) {
      int m = wm * 64 + tm * 16 + r;
      int pos = pos0 + m;
      size_t tok = (size_t)tile * 128 + m;
      if (nt < 4) {
#pragma unroll
        for (int tn = 0; tn < 4; ++tn)
#pragma unroll
          for (int jj = 0; jj < 4; ++jj) {
            int n = nw0 + tn * 16 + q * 4 + jj;
            pqt[(size_t)n * S + pos] = f2bf(acc[tm][tn][jj]);
          }
        continue;
      }
      const float2* tr = tab + pos * 56;
      const bool prope = (zc0 >= 1024 && zc0 < 1536) || (zc0 >= 1792 && zc0 < 2816);
      if (zc0 < 512) {
        float sc = zc0 >= 256 ? 0.125f : 1.f;
        rope_pair(acc[tm][0], acc[tm][2], tr + 24, q, sc);
        rope_pair(acc[tm][1], acc[tm][3], tr + 24 + 16, q, sc);
      } else if (prope) {
        const bool isq = (zc0 >= 1280 && zc0 < 1536) || (zc0 >= 1792 && zc0 < 2304);
        float sc = isq ? 0.125f * LOG2E : 1.f;
#pragma unroll
        for (int jj = 0; jj < 4; ++jj) {
          float2 cs = tr[16 + (q & 1) * 4 + jj];
          float v = acc[tm][0][jj];
          float o = __shfl_xor(v, 32);
          acc[tm][0][jj] = q < 2 ? v * cs.x - o * cs.y : v * cs.x + o * cs.y;
        }
#pragma unroll
        for (int tn = 0; tn < 4; ++tn)
#pragma unroll
          for (int jj = 0; jj < 4; ++jj) acc[tm][tn][jj] *= sc;
      } else if (zc0 == Z_KR) {
        rope_pair(acc[tm][0], acc[tm][1], tr, q, 1.f);
      }
      u16* zr = z + tok * ZW + zc0 + q * 4;
      *(uint2*)(zr) = pack4(acc[tm][0]);
      *(uint2*)(zr + 16) = pack4(acc[tm][1]);
      if (zc0 != Z_KR) {
        *(uint2*)(zr + 32) = pack4(acc[tm][2]);
        *(uint2*)(zr + 48) = pack4(acc[tm][3]);
      }
    }
  };
  gemm_tile_(p.wv, smem, 16, la, lb, epi);
}

constexpr int N_DIL = 3840, N_QP = 1920, N_KVP = 2560, N_RST = 144, N_PQF = 2304;
constexpr int N_P2 = N_RST + N_DIL + N_QP + N_KVP + N_PQF;

DI bf16x8 pack8(const f32x4& a, const f32x4& b) {
  uint4 u = make_uint4(pack2(a[0], a[1]), pack2(a[2], a[3]), pack2(b[0], b[1]), pack2(b[2], b[3]));
  return __builtin_bit_cast(bf16x8, u);
}
DI bf16x8 ldvt2(const u16* row, int c0, int c1) {
  uint2 lo = *(const uint2*)(row + c0), hi = *(const uint2*)(row + c1);
  uint4 u = make_uint4(lo.x, lo.y, hi.x, hi.y);
  return __builtin_bit_cast(bf16x8, u);
}

DI void ph_dil(const Params& p, int item, char* smem, bool dry = false) {
  int bi, rem, nbt, S;
  if (item < 768) { bi = item / 192; rem = item % 192; nbt = 64; S = 4096; }
  else { int it = item - 768; bi = 4 + it / 96; rem = it % 96; nbt = 32; S = 2048; }
  const int g = rem / nbt, blk = rem % nbt, dil = 1 << (2 * g), L = S / dil, nblk = L >> 6;
  const int r = blk / nblk, nb = blk % nblk;
  const size_t tokb = tok0_of_batch(bi);
  u16* z = (u16*)(p.ws + OFF_RB);
  u16* sQ = (u16*)smem;
  u16* sK = sQ + 64 * 72;
  u16* sVT = sK + 192 * 72;
  u16* sP = sK;
  const int tid = ltid(), lane = tid & 63, w = tid >> 6;
  const int qq = w * 16 + (lane & 15), q4 = lane >> 4;
  uint4 rq0, rq1, rk0, rk1, rk2, rk3, rk4, rk5, rv0, rv1, rv2, rv3, rv4, rv5;
#define DIL_LOAD(hd_) { const int cq_ = zdq(g) + (hd_)*64, ck_ = zdk(g) + (hd_)*64, cv_ = zdv(g) + (hd_)*64; \
    { int c = tid + 0, row = c >> 3, kc = (c & 7) * 8; rq0 = *(const uint4*)(z + (tokb + r + dil * (nb * 64 + row)) * ZW + cq_ + kc); } \
    { int c = tid + 256, row = c >> 3, kc = (c & 7) * 8; rq1 = *(const uint4*)(z + (tokb + r + dil * (nb * 64 + row)) * ZW + cq_ + kc); } \
    { int c = tid + 0, row = c >> 3, kc = (c & 7) * 8; int t = nb * 64 - 64 + row; rk0 = make_uint4(0, 0, 0, 0); if (t >= 0 && t < L) rk0 = *(const uint4*)(z + (tokb + r + dil * t) * ZW + ck_ + kc); } \
    { int c = tid + 256, row = c >> 3, kc = (c & 7) * 8; int t = nb * 64 - 64 + row; rk1 = make_uint4(0, 0, 0, 0); if (t >= 0 && t < L) rk1 = *(const uint4*)(z + (tokb + r + dil * t) * ZW + ck_ + kc); } \
    { int c = tid + 512, row = c >> 3, kc = (c & 7) * 8; int t = nb * 64 - 64 + row; rk2 = make_uint4(0, 0, 0, 0); if (t >= 0 && t < L) rk2 = *(const uint4*)(z + (tokb + r + dil * t) * ZW + ck_ + kc); } \
    { int c = tid + 768, row = c >> 3, kc = (c & 7) * 8; int t = nb * 64 - 64 + row; rk3 = make_uint4(0, 0, 0, 0); if (t >= 0 && t < L) rk3 = *(const uint4*)(z + (tokb + r + dil * t) * ZW + ck_ + kc); } \
    { int c = tid + 1024, row = c >> 3, kc = (c & 7) * 8; int t = nb * 64 - 64 + row; rk4 = make_uint4(0, 0, 0, 0); if (t >= 0 && t < L) rk4 = *(const uint4*)(z + (tokb + r + dil * t) * ZW + ck_ + kc); } \
    { int c = tid + 1280, row = c >> 3, kc = (c & 7) * 8; int t = nb * 64 - 64 + row; rk5 = make_uint4(0, 0, 0, 0); if (t >= 0 && t < L) rk5 = *(const uint4*)(z + (tokb + r + dil * t) * ZW + ck_ + kc); } \
    { int c = tid + 0, kp = c % 96, kc = (c / 96) * 8; int t0 = nb * 64 - 64 + 2 * kp; rv0 = make_uint4(0, 0, 0, 0); rv1 = make_uint4(0, 0, 0, 0); if (t0 >= 0 && t0 < L) rv0 = *(const uint4*)(z + (tokb + r + dil * t0) * ZW + cv_ + kc); if (t0 + 1 >= 0 && t0 + 1 < L) rv1 = *(const uint4*)(z + (tokb + r + dil * (t0 + 1)) * ZW + cv_ + kc); } \
    { int c = tid + 256, kp = c % 96, kc = (c / 96) * 8; int t0 = nb * 64 - 64 + 2 * kp; rv2 = make_uint4(0, 0, 0, 0); rv3 = make_uint4(0, 0, 0, 0); if (t0 >= 0 && t0 < L) rv2 = *(const uint4*)(z + (tokb + r + dil * t0) * ZW + cv_ + kc); if (t0 + 1 >= 0 && t0 + 1 < L) rv3 = *(const uint4*)(z + (tokb + r + dil * (t0 + 1)) * ZW + cv_ + kc); } \
    { int c = tid + 512, kp = c % 96, kc = (c / 96) * 8; int t0 = nb * 64 - 64 + 2 * kp; rv4 = make_uint4(0, 0, 0, 0); rv5 = make_uint4(0, 0, 0, 0); if (t0 >= 0 && t0 < L) rv4 = *(const uint4*)(z + (tokb + r + dil * t0) * ZW + cv_ + kc); if (t0 + 1 >= 0 && t0 + 1 < L) rv5 = *(const uint4*)(z + (tokb + r + dil * (t0 + 1)) * ZW + cv_ + kc); } \
  }
  DIL_LOAD(0);
#pragma unroll 1
  for (int hd = 0; hd < 4; ++hd) {
    const int colq = zdq(g) + hd * 64;
    __syncthreads();
    { int c = tid + 0, row = c >> 3, kc = (c & 7) * 8; *(uint4*)(sQ + row * 72 + kc) = rq0; }
    { int c = tid + 256, row = c >> 3, kc = (c & 7) * 8; *(uint4*)(sQ + row * 72 + kc) = rq1; }
    { int c = tid + 0, row = c >> 3, kc = (c & 7) * 8; *(uint4*)(sK + row * 72 + kc) = rk0; }
    { int c = tid + 256, row = c >> 3, kc = (c & 7) * 8; *(uint4*)(sK + row * 72 + kc) = rk1; }
    { int c = tid + 512, row = c >> 3, kc = (c & 7) * 8; *(uint4*)(sK + row * 72 + kc) = rk2; }
    { int c = tid + 768, row = c >> 3, kc = (c & 7) * 8; *(uint4*)(sK + row * 72 + kc) = rk3; }
    { int c = tid + 1024, row = c >> 3, kc = (c & 7) * 8; *(uint4*)(sK + row * 72 + kc) = rk4; }
    { int c = tid + 1280, row = c >> 3, kc = (c & 7) * 8; *(uint4*)(sK + row * 72 + kc) = rk5; }
    { int c = tid + 0, kp = c % 96, kc = (c / 96) * 8;
      const int k5_ = (2 * kp) & 31, pc = ((2 * kp) & ~31) | (8 * ((k5_ >> 2) & 3) + 4 * (k5_ >> 4) + (k5_ & 3));
      unsigned w0[4] = {rv0.x, rv0.y, rv0.z, rv0.w}, w1[4] = {rv1.x, rv1.y, rv1.z, rv1.w};
#pragma unroll
      for (int e = 0; e < 4; ++e) {
        *(unsigned*)(sVT + (kc + 2 * e) * 200 + pc) = (w0[e] & 0xffffu) | (w1[e] << 16);
        *(unsigned*)(sVT + (kc + 2 * e + 1) * 200 + pc) = (w0[e] >> 16) | (w1[e] & 0xffff0000u);
      } }
    { int c = tid + 256, kp = c % 96, kc = (c / 96) * 8;
      const int k5_ = (2 * kp) & 31, pc = ((2 * kp) & ~31) | (8 * ((k5_ >> 2) & 3) + 4 * (k5_ >> 4) + (k5_ & 3));
      unsigned w0[4] = {rv2.x, rv2.y, rv2.z, rv2.w}, w1[4] = {rv3.x, rv3.y, rv3.z, rv3.w};
#pragma unroll
      for (int e = 0; e < 4; ++e) {
        *(unsigned*)(sVT + (kc + 2 * e) * 200 + pc) = (w0[e] & 0xffffu) | (w1[e] << 16);
        *(unsigned*)(sVT + (kc + 2 * e + 1) * 200 + pc) = (w0[e] >> 16) | (w1[e] & 0xffff0000u);
      } }
    { int c = tid + 512, kp = c % 96, kc = (c / 96) * 8;
      const int k5_ = (2 * kp) & 31, pc = ((2 * kp) & ~31) | (8 * ((k5_ >> 2) & 3) + 4 * (k5_ >> 4) + (k5_ & 3));
      unsigned w0[4] = {rv4.x, rv4.y, rv4.z, rv4.w}, w1[4] = {rv5.x, rv5.y, rv5.z, rv5.w};
#pragma unroll
      for (int e = 0; e < 4; ++e) {
        *(unsigned*)(sVT + (kc + 2 * e) * 200 + pc) = (w0[e] & 0xffffu) | (w1[e] << 16);
        *(unsigned*)(sVT + (kc + 2 * e + 1) * 200 + pc) = (w0[e] >> 16) | (w1[e] & 0xffff0000u);
      } }
    if (hd < 3) DIL_LOAD(hd + 1);
    __syncthreads();
    f32x4 s[10];
    {
      float zz = 0.f;
      asm volatile("" : "+v"(zz));
#pragma unroll
      for (int t = 0; t < 10; ++t) s[t] = f32x4{zz, zz, zz, zz};
    }
    const int lr = lane & 15;
#pragma unroll
    for (int ks = 0; ks < 2; ++ks) {
      bf16x8 qa = *(const bf16x8*)(sQ + (w * 16 + lr) * 72 + ks * 32 + q4 * 8);
#pragma unroll
      for (int t = 0; t < 9; ++t) {
        bf16x8 kb = *(const bf16x8*)(sK + ((w + t) * 16 + lr) * 72 + ks * 32 + q4 * 8);
        s[t] = __builtin_amdgcn_mfma_f32_16x16x32_bf16(kb, qa, s[t], 0, 0, 0);
      }
    }
    const int klo = max(qq, 64 - nb * 64), khi = min(qq + 128, L - 1 + 64 - nb * 64);
    const unsigned kspan = (unsigned)(khi - klo);
    const int kb0 = w * 16 + q4 * 4 - klo;
    float mx = -1e30f;
#pragma unroll
    for (int t = 0; t < 9; ++t)
#pragma unroll
      for (int jj = 0; jj < 4; ++jj) {
        bool ok = (unsigned)(kb0 + t * 16 + jj) <= kspan;
        float v = ok ? s[t][jj] : -1e30f;
        s[t][jj] = v;
        mx = fmaxf(mx, v);
      }
    mx = fmaxf(mx, __shfl_xor(mx, 16));
    mx = fmaxf(mx, __shfl_xor(mx, 32));
    float den = 0.f;
#pragma unroll
    for (int t = 0; t < 9; ++t)
#pragma unroll
      for (int jj = 0; jj < 4; ++jj) {
        float pv = __builtin_amdgcn_exp2f(s[t][jj] - mx);
        den += pv;
        s[t][jj] = pv;
      }
    den += __shfl_xor(den, 16);
    den += __shfl_xor(den, 32);
    f32x4 o[1][4];
    zero_acc(o);
    const u16* vrow = sVT + lr * 200 + ((w & ~1) >> 1) * 32 + q4 * 8;
    if (w & 1) {
#pragma unroll
      for (int pp = 0; pp < 5; ++pp) {
        bf16x8 pa = pp == 0 ? pack8(s[9], s[0]) : pack8(s[2 * pp - 1], s[2 * pp]);
#pragma unroll
        for (int td = 0; td < 4; ++td) {
          bf16x8 vb = *(const bf16x8*)(vrow + td * 16 * 200 + pp * 32);
          o[0][td] = __builtin_amdgcn_mfma_f32_16x16x32_bf16(vb, pa, o[0][td], 0, 0, 0);
        }
      }
    } else {
#pragma unroll
      for (int pp = 0; pp < 5; ++pp) {
        bf16x8 pa = pack8(s[2 * pp], s[2 * pp + 1]);
#pragma unroll
        for (int td = 0; td < 4; ++td) {
          bf16x8 vb = *(const bf16x8*)(vrow + td * 16 * 200 + pp * 32);
          o[0][td] = __builtin_amdgcn_mfma_f32_16x16x32_bf16(vb, pa, o[0][td], 0, 0, 0);
        }
      }
    }
    const float inv = 1.f / den;
    const size_t tok = tokb + r + dil * (nb * 64 + qq);
#pragma unroll
    for (int tn = 0; tn < 4; ++tn) {
      f32x4 v = o[0][tn];
      v[0] *= inv; v[1] *= inv; v[2] *= inv; v[3] *= inv;
      if (dry) *(uint2*)((u16*)p.out + tok * 1024 + (colq & 1023) + tn * 16 + q4 * 4) = pack4(v);
      else *(uint2*)(z + tok * ZW + colq + tn * 16 + q4 * 4) = pack4(v);
    }
    if (q4 == 0) ((float*)(p.ws + OFF_LSE))[((size_t)g * NTOK + tok) * 4 + hd] = (mx + log2f(den)) * LN2;
  }
#undef DIL_LOAD
}

DI void row_rstd_(int wv_, float* sR, const u16* base, int ncols) {
  const int tid = ltid_w(wv_), row = tid >> 1, half = tid & 1;
  const u16* b = base + (size_t)row * ZW + half * (ncols >> 1);
  float ss = 0.f;
  for (int c = 0; c < (ncols >> 4); ++c) {
    uint4 v = *(const uint4*)(b + c * 8);
    unsigned wv[4] = {v.x, v.y, v.z, v.w};
#pragma unroll
    for (int e = 0; e < 4; ++e) { float a = blo(wv[e]), d = bhi(wv[e]); ss += a * a + d * d; }
  }
  ss += __shfl_xor(ss, 1);
  if (half == 0) sR[row] = rsqrtf(ss / (float)ncols + EPS);
}

DI void ph_qproj(const Params& p, int item, int layer, char* smem) {
  const int nt = item % 3, tile = item / 3;
  int bi, S, pos0;
  tile_info(tile, bi, S, pos0);
  const u16* z = (const u16*)(p.ws + OFF_RB) + (size_t)tile * 128 * ZW;
  const u16* wt = (const u16*)(p.ws + OFF_WT + layer * WT_LAYER + WT_QB) + (size_t)nt * 128 * 256;
  u16* qm = (u16*)(p.ws + OFF_RA + RA_QM);
  const float2* tab = (const float2*)(p.ws + OFF_TAB);
  float* sR = (float*)(smem + 36864);
  __syncthreads();
  row_rstd_(p.wv, sR, z + Z_CQ, 256);
  auto la = [&](int row, int k) { return *(const uint4*)(z + (size_t)row * ZW + Z_CQ + k); };
  auto lb = [&](int n, int k) { return *(const uint4*)(wt + (size_t)n * 256 + k); };
  auto epi = [&](f32x4 (&acc)[4][4], int wm, int wn, int lane) {
    const int r = lane & 15, q = lane >> 4;
    const int nw0 = nt * 128 + wn * 64;
    const float QS = 0.10206207261596575f * LOG2E;
#pragma unroll
    for (int tm = 0; tm < 4; ++tm) {
      int m = wm * 64 + tm * 16 + r;
      int pos = pos0 + m;
      size_t tok = (size_t)tile * 128 + m;
      float rs = sR[m] * QS;
#pragma unroll
      for (int tn = 0; tn < 4; ++tn)
#pragma unroll
        for (int jj = 0; jj < 4; ++jj) acc[tm][tn][jj] *= rs;
      const float2* tr = tab + pos * 56;
      if (nw0 == 64 || nw0 == 256) rope_pair(acc[tm][0], acc[tm][1], tr, q, 1.f);
      else if (nw0 == 128 || nw0 == 320) rope_pair(acc[tm][2], acc[tm][3], tr, q, 1.f);
      u16* d = qm + tok * 384 + nw0 + q * 4;
#pragma unroll
      for (int tn = 0; tn < 4; ++tn) *(uint2*)(d + tn * 16) = pack4(acc[tm][tn]);
    }
  };
  gemm_tile_(p.wv, smem, 4, la, lb, epi);
}

DI void ph_kvproj(const Params& p, int item, int layer, char* smem) {
  const int nt = item & 3, tile = item >> 2;
  int bi, S, pos0;
  tile_info(tile, bi, S, pos0);
  const u16* z = (const u16*)(p.ws + OFF_RB) + (size_t)tile * 128 * ZW;
  const u16* wt = (const u16*)(p.ws + OFF_WT + layer * WT_LAYER + WT_KVB) + (size_t)nt * 128 * 128;
  u16* kb = (u16*)(p.ws + OFF_RA + RA_KB);
  u16* vt = (u16*)(p.ws + OFF_RA + RA_VT) + (size_t)tok0_of_batch(bi) * 256;
  float* sR = (float*)(smem + 36864);
  __syncthreads();
  row_rstd_(p.wv, sR, z + Z_CKV, 128);
  auto la = [&](int row, int k) { return *(const uint4*)(z + (size_t)row * ZW + Z_CKV + k); };
  auto lb = [&](int n, int k) { return *(const uint4*)(wt + (size_t)n * 128 + k); };
  auto epi = [&](f32x4 (&acc)[4][4], int wm, int wn, int lane) {
    const int r = lane & 15, q = lane >> 4;
#pragma unroll
    for (int tm = 0; tm < 4; ++tm) {
      int m = wm * 64 + tm * 16 + r;
      int pos = pos0 + m;
      const int k5 = pos & 31;
      const int ppos = (pos & ~31) | (8 * ((k5 >> 2) & 3) + 4 * (k5 >> 4) + (k5 & 3));
      size_t tok = (size_t)tile * 128 + m;
      float rs = sR[m];
#pragma unroll
      for (int tn = 0; tn < 4; ++tn)
#pragma unroll
        for (int jj = 0; jj < 4; ++jj) acc[tm][tn][jj] *= rs;
      if (wn == 0) {
        u16* d = kb + tok * 384 + nt * 96 + q * 4;
#pragma unroll
        for (int tn = 0; tn < 4; ++tn) *(uint2*)(d + tn * 16) = pack4(acc[tm][tn]);
      } else {
#pragma unroll
        for (int tn = 0; tn < 4; ++tn)
#pragma unroll
          for (int jj = 0; jj < 4; ++jj) vt[(size_t)(nt * 64 + tn * 16 + q * 4 + jj) * S + ppos] = f2bf(acc[tm][tn][jj]);
      }
    }
    if (wn == 0) {
      int m = wm * 64 + lane;
      size_t tok = (size_t)tile * 128 + m;
      const uint4* src = (const uint4*)(z + (size_t)m * ZW + Z_KR);
      uint4* dst = (uint4*)(kb + tok * 384 + nt * 96 + 64);
#pragma unroll
      for (int e = 0; e < 4; ++e) dst[e] = src[e];
    }
  };
  gemm_tile_(p.wv, smem, 2, la, lb, epi);
}

DI float logsig(float x) { return -log1pf(expf(-x)); }

DI void ph_retscan(const Params& p, int item, int layer, char* smem) {
  const int hd = item & 3, bi = item >> 2;
  const int N = bi < 4 ? 32 : 16;
  const int tb0 = bi < 4 ? bi * 32 : 128 + (bi - 4) * 16;
  const u16* zb = (const u16*)(p.ws + OFF_RB);
  u16* sKf = (u16*)smem;
  u16* sVf = sKf + 64 * 136;
  u16* sKb = sVf + 64 * 136;
  u16* sVb = sKb + 64 * 136;
  const int tid = ltid(), lane = tid & 63, w = tid >> 6;
  const float lf = logsig(p.dec_f[layer * 4 + hd]), lb = logsig(p.dec_b[layer * 4 + hd]);
  const int dir = w >> 1, eh = w & 1;
  const float cd = __expf(128.f * (dir ? lb : lf));
  f32x4 acc[2][4];
  zero_acc(acc);
  const int r = lane & 15, q = lane >> 4;
  for (int step = 0; step < N; ++step) {
    const int nf = step, nb = N - 1 - step;
    __syncthreads();
#pragma unroll
    for (int i = 0; i < 4; ++i) {
      int c = tid + 256 * i, j = c & 127, kc = (c >> 7) * 8;
      const u16* zf = zb + ((size_t)(tb0 + nf) * 128 + j) * ZW + hd * 64 + kc;
      const u16* zr = zb + ((size_t)(tb0 + nb) * 128 + j) * ZW + hd * 64 + kc;
      uint4 kf = *(const uint4*)(zf + Z_RK), vf = *(const uint4*)(zf + Z_RV), kbv = *(const uint4*)(zr + Z_RK), vbv = *(const uint4*)(zr + Z_RV);
      unsigned kfw[4] = {kf.x, kf.y, kf.z, kf.w}, vfw[4] = {vf.x, vf.y, vf.z, vf.w}, kbw[4] = {kbv.x, kbv.y, kbv.z, kbv.w}, vbw[4] = {vbv.x, vbv.y, vbv.z, vbv.w};
      float df = __expf((float)(127 - j) * lf), db = __expf((float)j * lb);
#pragma unroll
      for (int e = 0; e < 8; ++e) {
        float kx = (e & 1) ? bhi(kfw[e >> 1]) : blo(kfw[e >> 1]);
        float ky = (e & 1) ? bhi(kbw[e >> 1]) : blo(kbw[e >> 1]);
        sKf[(kc + e) * 136 + j] = f2bf(kx * df);
        sKb[(kc + e) * 136 + j] = f2bf(ky * db);
        sVf[(kc + e) * 136 + j] = (u16)((vfw[e >> 1] >> ((e & 1) * 16)) & 0xffffu);
        sVb[(kc + e) * 136 + j] = (u16)((vbw[e >> 1] >> ((e & 1) * 16)) & 0xffffu);
      }
    }
    __syncthreads();
    const int n = dir ? nb : nf;
    float* rs = (float*)(p.ws + OFF_RS) + ((size_t)((tb0 + n) * 4 + hd) * 2 + dir) * 4096;
#pragma unroll
    for (int tm = 0; tm < 2; ++tm)
#pragma unroll
      for (int tn = 0; tn < 4; ++tn) {
        int e = eh * 32 + tm * 16 + r, d = tn * 16 + q * 4;
        *(float4*)(rs + e * 64 + d) = make_float4(acc[tm][tn][0], acc[tm][tn][1], acc[tm][tn][2], acc[tm][tn][3]);
        acc[tm][tn][0] *= cd; acc[tm][tn][1] *= cd; acc[tm][tn][2] *= cd; acc[tm][tn][3] *= cd;
      }
    mma<2, 4>((dir ? sVb : sVf) + eh * 32 * 136, 136, dir ? sKb : sKf, 136, 4, acc, lane);
  }
}

DI void ph_pqfold(const Params& p, int item) {
  const int bi = item >> 6, cg8 = item & 63;
  const int S = bi < 4 ? 4096 : 2048, H = S >> 1;
  u16* pq = (u16*)(p.ws + OFF_PQT) + (size_t)tok0_of_batch(bi) * 512;
  const int tid = ltid();
  const int nch = H >> 3;
#pragma unroll 4
  for (int c = tid; c < 8 * nch; c += 256) {
    int row = cg8 * 8 + c / nch, k = (c % nch) * 8;
    u16* rp = pq + (size_t)row * S;
    const float sgn = row < 256 ? 1.f : -1.f;
    uint4 va = *(const uint4*)(rp + k), vb = *(const uint4*)(rp + H + k);
    unsigned wa[4] = {va.x, va.y, va.z, va.w}, wb[4] = {vb.x, vb.y, vb.z, vb.w}, o[4];
#pragma unroll
    for (int e = 0; e < 4; ++e) o[e] = pack2(blo(wa[e]) + sgn * blo(wb[e]), bhi(wa[e]) + sgn * bhi(wb[e]));
    if (k == 0) o[0] = (o[0] & 0xffff0000u) | (wa[0] & 0xffffu);
    *(uint4*)(rp + k) = make_uint4(o[0], o[1], o[2], o[3]);
  }
}

constexpr int N_MLA = 2560, N_FG = 1280, N_RO = 2560, N_COMB = 640, N_FM = 36;
constexpr int N_P3 = N_MLA + N_FG + N_RO + N_COMB + N_FM;

DI void mla_softmax(f32x4 (&s)[4], f32x4 (&o)[4], float& mrun, float& lrun) {
  float mx = -1e30f;
#pragma unroll
  for (int tn = 0; tn < 4; ++tn)
#pragma unroll
    for (int jj = 0; jj < 4; ++jj) mx = fmaxf(mx, s[tn][jj]);
  mx = fmaxf(mx, __shfl_xor(mx, 16));
  mx = fmaxf(mx, __shfl_xor(mx, 32));
  float mn = fmaxf(mrun, mx);
  float alpha = __builtin_amdgcn_exp2f(mrun - mn);
  mrun = mn;
  float ps = 0.f;
#pragma unroll
  for (int tn = 0; tn < 4; ++tn)
#pragma unroll
    for (int jj = 0; jj < 4; ++jj) { float pv = __builtin_amdgcn_exp2f(s[tn][jj] - mn); ps += pv; s[tn][jj] = pv; }
  lrun = lrun * alpha + ps;
#pragma unroll
  for (int tn = 0; tn < 4; ++tn)
#pragma unroll
    for (int jj = 0; jj < 4; ++jj) o[tn][jj] *= alpha;
}
DI void ph_mla(const Params& p, int item, char* smem) {
  int bi, hd, qb, S;
  if (item < 512) { bi = item >> 7; hd = (item >> 5) & 3; qb = item & 31; S = 4096; }
  else { int it = item - 512; bi = 4 + (it >> 6); hd = (it >> 4) & 3; qb = it & 15; S = 2048; }
  const size_t tokb = tok0_of_batch(bi);
  const u16* qm = (const u16*)(p.ws + OFF_RA + RA_QM) + (tokb + qb * 128) * 384 + hd * 96;
  const u16* kb = (const u16*)(p.ws + OFF_RA + RA_KB) + tokb * 384 + hd * 96;
  const u16* vt = (const u16*)(p.ws + OFF_RA + RA_VT) + tokb * 256 + (size_t)hd * 64 * S;
  u16* z = (u16*)(p.ws + OFF_RB);
  constexpr int BUF = 64 * 104 + 64 * 72;
  u16* sKV = (u16*)smem;
  u16* sP = sKV + 2 * BUF;
  const int tid = ltid(), lane = tid & 63, w = tid >> 6, r = lane & 15, q4 = lane >> 4;
  bf16x8 qf[2][3];
#pragma unroll
  for (int tm = 0; tm < 2; ++tm)
#pragma unroll
    for (int ks = 0; ks < 3; ++ks) qf[tm][ks] = *(const bf16x8*)(qm + (size_t)(w * 32 + tm * 16 + r) * 384 + ks * 32 + q4 * 8);
  const int kr0 = tid / 12, kc0 = (tid % 12) * 8, kr1 = (tid + 256) / 12, kc1 = ((tid + 256) % 12) * 8, kr2 = (tid + 512) / 12, kc2 = ((tid + 512) % 12) * 8;
  const int vr0 = tid >> 3, vc0 = (tid & 7) * 8, vr1 = vr0 + 32;
  uint4 rk0, rk1, rk2, rv0, rv1;
#define MLA_LOAD(kt_) { const u16* kb2 = kb + (size_t)(kt_) * 64 * 384; \
    rk0 = *(const uint4*)(kb2 + (size_t)kr0 * 384 + kc0); rk1 = *(const uint4*)(kb2 + (size_t)kr1 * 384 + kc1); rk2 = *(const uint4*)(kb2 + (size_t)kr2 * 384 + kc2); \
    rv0 = *(const uint4*)(vt + (size_t)vr0 * S + (kt_) * 64 + vc0); rv1 = *(const uint4*)(vt + (size_t)vr1 * S + (kt_) * 64 + vc0); }
#define MLA_WRITE(b_) { u16* sK_ = sKV + (b_) * BUF; u16* sV_ = sK_ + 64 * 104; \
    *(uint4*)(sK_ + kr0 * 104 + kc0) = rk0; *(uint4*)(sK_ + kr1 * 104 + kc1) = rk1; *(uint4*)(sK_ + kr2 * 104 + kc2) = rk2; \
    *(uint4*)(sV_ + vr0 * 72 + vc0) = rv0; *(uint4*)(sV_ + vr1 * 72 + vc0) = rv1; }
  const int nkt = S >> 6;
  MLA_LOAD(0);
  __syncthreads();
  MLA_WRITE(0);
  MLA_LOAD(1);
  __syncthreads();
  f32x4 o[2][4];
  zero_acc(o);
  float m0 = -1e30f, m1 = -1e30f, l0 = 0.f, l1 = 0.f;
  for (int kt = 0; kt < nkt; ++kt) {
    const int cur = kt & 1;
    const u16* sK = sKV + cur * BUF;
    const u16* sVT = sK + 64 * 104;
    f32x4 s[2][4];
    zero_acc(s);
#pragma unroll
    for (int ks = 0; ks < 3; ++ks) {
      bf16x8 bfr[4];
#pragma unroll
      for (int i = 0; i < 4; ++i) bfr[i] = *(const bf16x8*)(sK + (i * 16 + r) * 104 + ks * 32 + q4 * 8);
#pragma unroll
      for (int tm = 0; tm < 2; ++tm)
#pragma unroll
        for (int tn = 0; tn < 4; ++tn) s[tm][tn] = __builtin_amdgcn_mfma_f32_16x16x32_bf16(bfr[tn], qf[tm][ks], s[tm][tn], 0, 0, 0);
    }
    mla_softmax(s[0], o[0], m0, l0);
    mla_softmax(s[1], o[1], m1, l1);
#pragma unroll
    for (int kp = 0; kp < 2; ++kp) {
      bf16x8 pa0 = pack8(s[0][2 * kp], s[0][2 * kp + 1]), pa1 = pack8(s[1][2 * kp], s[1][2 * kp + 1]);
#pragma unroll
      for (int td = 0; td < 4; ++td) {
        bf16x8 vb = *(const bf16x8*)(sVT + (td * 16 + r) * 72 + kp * 32 + q4 * 8);
        o[0][td] = __builtin_amdgcn_mfma_f32_16x16x32_bf16(vb, pa0, o[0][td], 0, 0, 0);
        o[1][td] = __builtin_amdgcn_mfma_f32_16x16x32_bf16(vb, pa1, o[1][td], 0, 0, 0);
      }
    }
    if (kt + 1 < nkt) {
      MLA_WRITE(cur ^ 1);
      if (kt + 2 < nkt) MLA_LOAD(kt + 2);
    }
    __syncthreads();
  }
#undef MLA_LOAD
#undef MLA_WRITE
#pragma unroll
  for (int tm = 0; tm < 2; ++tm) {
    float l = tm ? l1 : l0;
    l += __shfl_xor(l, 16);
    l += __shfl_xor(l, 32);
    float inv = 1.f / l;
    size_t tok = tokb + qb * 128 + w * 32 + tm * 16 + r;
#pragma unroll
    for (int tn = 0; tn < 4; ++tn) {
      f32x4 v = o[tm][tn];
      v[0] *= inv; v[1] *= inv; v[2] *= inv; v[3] *= inv;
      *(uint2*)(z + tok * ZW + Z_CQ + hd * 64 + tn * 16 + q4 * 4) = pack4(v);
    }
  }
}

DI void ph_fgemm(const Params& p, int item, char* smem) {
  int bi, mt, nt, S;
  if (item < 256) { bi = item >> 6; mt = (item >> 2) & 15; nt = item & 3; S = 4096; }
  else { int it = item - 256; bi = 4 + (it >> 5); mt = (it >> 2) & 7; nt = it & 3; S = 2048; }
  const size_t tokb = tok0_of_batch(bi);
  const int H = S >> 1;
  const int rmul = S == 4096 ? 1 : 2;
  const u16* dft = (const u16*)(p.ws + OFF_DFT);
  const u16* pq = (const u16*)(p.ws + OFF_PQT) + tokb * 512;
  u16* z = (u16*)(p.ws + OFF_RB);
  auto la = [&](int row, int k) {
    int j = (mt * 128 + row) * rmul;
    int kk = k < H ? k : 2048 + (k - H);
    return *(const uint4*)(dft + (size_t)j * 4096 + kk);
  };
  auto lb = [&](int n, int k) {
    int c = nt * 64 + n;
    return k < H ? *(const uint4*)(pq + (size_t)c * S + k) : *(const uint4*)(pq + (size_t)(256 + c) * S + (k - H));
  };
  const float nrm = rsqrtf((float)S * 64.f);
  auto epi = [&](f32x4 (&a1)[4][2], f32x4 (&a2)[4][2], int wm, int wn, int lane) {
    const int r = lane & 15, q = lane >> 4;
#pragma unroll
    for (int tm = 0; tm < 4; ++tm) {
      int m = wm * 64 + tm * 16 + r;
      int j = mt * 128 + m;
      float sg = (j & 1) ? -1.f : 1.f;
#pragma unroll
      for (int tn = 0; tn < 2; ++tn) {
        int c = nt * 64 + wn * 32 + tn * 16 + q * 4;
        f32x4 v1, v2;
#pragma unroll
        for (int jj = 0; jj < 4; ++jj) {
          float pm = sg * bf2f(pq[(size_t)(c + jj) * S + H]);
          v1[jj] = (a1[tm][tn][jj] + a2[tm][tn][jj] + pm) * nrm;
          v2[jj] = (a1[tm][tn][jj] - a2[tm][tn][jj] + pm) * nrm;
        }
        *(uint2*)(z + (tokb + j) * ZW + Z_DK0 + c) = pack4(v1);
        if (j > 0) *(uint2*)(z + (tokb + S - j) * ZW + Z_DK0 + c) = pack4(v2);
      }
    }
  };
  gemm_tile2_(p.wv, smem, S >> 6, la, lb, epi);
}

DI void ph_fmid(const Params& p, int item) {
  const int bi = item;
  const int S = bi < 4 ? 4096 : 2048, H = S >> 1;
  const size_t tokb = tok0_of_batch(bi);
  const u16* pq = (const u16*)(p.ws + OFF_PQT) + tokb * 512;
  u16* z = (u16*)(p.ws + OFF_RB);
  const int c = ltid();
  const u16* rp = pq + (size_t)c * S;
  float se = 0.f, so = 0.f;
#pragma unroll 8
  for (int k = 0; k < H; k += 8) {
    uint4 v = *(const uint4*)(rp + k);
    unsigned w[4] = {v.x, v.y, v.z, v.w};
#pragma unroll
    for (int e = 0; e < 4; ++e) { se += blo(w[e]); so += bhi(w[e]); }
  }
  float f = (se - so + bf2f(rp[H])) * rsqrtf((float)S * 64.f);
  z[(tokb + H) * ZW + Z_DK0 + c] = f2bf(f);
}

DI void ph_comb(const Params& p, int item) {
  const int tid = ltid();
  const size_t tok = (size_t)item * 128 + (tid >> 1);
  u16* z = (u16*)(p.ws + OFF_RB) + tok * ZW;
  const float* lse = (const float*)(p.ws + OFF_LSE);
#pragma unroll
  for (int hh = 0; hh < 2; ++hh) {
    int hd = (tid & 1) * 2 + hh;
    float l0 = lse[((size_t)0 * NTOK + tok) * 4 + hd], l1 = lse[((size_t)1 * NTOK + tok) * 4 + hd], l2 = lse[((size_t)2 * NTOK + tok) * 4 + hd];
    float mx = fmaxf(l0, fmaxf(l1, l2));
    float w0 = __expf(l0 - mx), w1 = __expf(l1 - mx), w2 = __expf(l2 - mx);
    float inv = 1.f / (w0 + w1 + w2);
    w0 *= inv; w1 *= inv; w2 *= inv;
#pragma unroll
    for (int c8 = 0; c8 < 8; ++c8) {
      u16* a = z + hd * 64 + c8 * 8;
      uint4 v0 = *(const uint4*)(a + 1280), v1 = *(const uint4*)(a + 1792), v2 = *(const uint4*)(a + 2048);
      unsigned x0[4] = {v0.x, v0.y, v0.z, v0.w}, x1[4] = {v1.x, v1.y, v1.z, v1.w}, x2[4] = {v2.x, v2.y, v2.z, v2.w}, o[4];
#pragma unroll
      for (int e = 0; e < 4; ++e)
        o[e] = pack2(w0 * blo(x0[e]) + w1 * blo(x1[e]) + w2 * blo(x2[e]), w0 * bhi(x0[e]) + w1 * bhi(x1[e]) + w2 * bhi(x2[e]));
      *(uint4*)(a + 1280) = make_uint4(o[0], o[1], o[2], o[3]);
    }
  }
}

DI void ph_retout(const Params& p, int item, int layer, char* smem, bool dry = false) {
  const int hd = item & 3, tile = item >> 2;
  u16* z = (u16*)(p.ws + OFF_RB) + (size_t)tile * 128 * ZW;
  const float* rs = (const float*)(p.ws + OFF_RS) + (size_t)item * 2 * 4096;
  u16* sQ = (u16*)smem;
  u16* sK = sQ + 128 * 72;
  u16* sVT = sK + 128 * 72;
  u16* sSf = sVT + 64 * 136;
  u16* sSb = sSf + 64 * 72;
  u16* sS = sSf;
  const int tid = ltid(), lane = tid & 63, w = tid >> 6, r = lane & 15, q4 = lane >> 4;
  const float lf = logsig(p.dec_f[layer * 4 + hd]), lb = logsig(p.dec_b[layer * 4 + hd]);
  __syncthreads();
#pragma unroll
  for (int i = 0; i < 4; ++i) {
    int c = tid + 256 * i, row = c >> 3, kc = (c & 7) * 8;
    *(uint4*)(sQ + row * 72 + kc) = *(const uint4*)(z + (size_t)row * ZW + Z_RQ + hd * 64 + kc);
    *(uint4*)(sK + row * 72 + kc) = *(const uint4*)(z + (size_t)row * ZW + Z_RK + hd * 64 + kc);
  }
#pragma unroll
  for (int i = 0; i < 2; ++i) {
    int c = tid + 256 * i, jp = c & 63, kc = (c >> 6) * 8;
    uint4 v0 = *(const uint4*)(z + (size_t)(2 * jp) * ZW + Z_RV + hd * 64 + kc);
    uint4 v1 = *(const uint4*)(z + (size_t)(2 * jp + 1) * ZW + Z_RV + hd * 64 + kc);
    unsigned w0[4] = {v0.x, v0.y, v0.z, v0.w}, w1[4] = {v1.x, v1.y, v1.z, v1.w};
    const int k5_ = (2 * jp) & 31, pc = ((2 * jp) & ~31) | (8 * ((k5_ >> 2) & 3) + 4 * (k5_ >> 4) + (k5_ & 3));
#pragma unroll
    for (int e = 0; e < 4; ++e) {
      *(unsigned*)(sVT + (kc + 2 * e) * 136 + pc) = (w0[e] & 0xffffu) | (w1[e] << 16);
      *(unsigned*)(sVT + (kc + 2 * e + 1) * 136 + pc) = (w0[e] >> 16) | (w1[e] & 0xffff0000u);
    }
  }
#pragma unroll
  for (int i = 0; i < 4; ++i) {
    int c = tid + 256 * i, e = c >> 4, d = (c & 15) * 4;
    float4 a = *(const float4*)(rs + e * 64 + d), b = *(const float4*)(rs + 4096 + e * 64 + d);
    *(uint2*)(sSf + e * 72 + d) = make_uint2(pack2(a.x, a.y), pack2(a.z, a.w));
    *(uint2*)(sSb + e * 72 + d) = make_uint2(pack2(b.x, b.y), pack2(b.z, b.w));
  }
  __syncthreads();
  f32x4 oc[2][1][4];
#pragma unroll
  for (int h = 0; h < 2; ++h) {
    f32x4 cf[1][4], cb[1][4];
    zero_acc(cf);
    zero_acc(cb);
    mma<1, 4>(sQ + (h * 64 + w * 16) * 72, 72, sSf, 72, 2, cf, lane);
    mma<1, 4>(sQ + (h * 64 + w * 16) * 72, 72, sSb, 72, 2, cb, lane);
    int i = h * 64 + w * 16 + r;
    float rf = __expf((float)(i + 1) * lf), rb = __expf((float)(128 - i) * lb);
#pragma unroll
    for (int tn = 0; tn < 4; ++tn)
#pragma unroll
      for (int jj = 0; jj < 4; ++jj) oc[h][0][tn][jj] = rf * cf[0][tn][jj] + rb * cb[0][tn][jj];
  }
#pragma unroll
  for (int h = 0; h < 2; ++h) {
    const int i = h * 64 + w * 16 + r;
    {
      f32x4 s[1][8];
      zero_acc(s);
      mma<1, 8>(sQ + (h * 64 + w * 16) * 72, 72, sK, 72, 2, s, lane);
#pragma unroll
      for (int tn = 0; tn < 8; ++tn)
#pragma unroll
        for (int jj = 0; jj < 4; ++jj) {
          int j = tn * 16 + q4 * 4 + jj;
          float dcy = i >= j ? __expf((float)(i - j) * lf) : __expf((float)(j - i) * lb);
          s[0][tn][jj] *= dcy;
        }
#pragma unroll
      for (int kp = 0; kp < 4; ++kp) {
        bf16x8 pa = pack8(s[0][2 * kp], s[0][2 * kp + 1]);
#pragma unroll
        for (int td = 0; td < 4; ++td) {
          bf16x8 vb = *(const bf16x8*)(sVT + (td * 16 + r) * 136 + kp * 32 + q4 * 8);
          oc[h][0][td] = __builtin_amdgcn_mfma_f32_16x16x32_bf16(vb, pa, oc[h][0][td], 0, 0, 0);
        }
      }
    }
    float ss = 0.f;
#pragma unroll
    for (int tn = 0; tn < 4; ++tn)
#pragma unroll
      for (int jj = 0; jj < 4; ++jj) ss += oc[h][0][tn][jj] * oc[h][0][tn][jj];
    ss += __shfl_xor(ss, 16);
    ss += __shfl_xor(ss, 32);
    float rn = rsqrtf(ss * (1.f / 64.f) + EPS);
#pragma unroll
    for (int tn = 0; tn < 4; ++tn) {
      u16* gp = z + (size_t)i * ZW + Z_RG + hd * 64 + tn * 16 + q4 * 4;
      uint2 gv = *(const uint2*)gp;
      float g0 = blo(gv.x), g1 = bhi(gv.x), g2 = blo(gv.y), g3 = bhi(gv.y);
      f32x4 v = oc[h][0][tn];
      v[0] *= rn * fsilu(g0);
      v[1] *= rn * fsilu(g1);
      v[2] *= rn * fsilu(g2);
      v[3] *= rn * fsilu(g3);
      if (dry) *(uint2*)((u16*)p.out + ((size_t)tile * 128 + i) * 1024 + hd * 64 + tn * 16 + q4 * 4) = pack4(v);
      else *(uint2*)gp = pack4(v);
    }
  }
}

DI void ph_wout(const Params& p, int item, int layer, char* smem) {
  const int nt = item & 7, tile = item >> 3;
  const u16* z = (const u16*)(p.ws + OFF_RB) + (size_t)tile * 128 * ZW;
  const u16* wt = (const u16*)(p.ws + OFF_WT + layer * WT_LAYER + WT_OUT) + (size_t)nt * 128 * 1024;
  u16* y = (u16*)(p.ws + OFF_RA) + (size_t)tile * 128 * 1024 + nt * 128;
  auto la = [&](int row, int k) { return *(const uint4*)(z + (size_t)row * ZW + Z_RG + k); };
  auto lb = [&](int n, int k) { return *(const uint4*)(wt + (size_t)n * 1024 + k); };
  auto epi = [&](f32x4 (&acc)[4][4], int wm, int wn, int lane) {
    const int r = lane & 15, q = lane >> 4;
#pragma unroll
    for (int tm = 0; tm < 4; ++tm) {
      int m = wm * 64 + tm * 16 + r;
#pragma unroll
      for (int tn = 0; tn < 4; ++tn) *(uint2*)(y + (size_t)m * 1024 + wn * 64 + tn * 16 + q * 4) = pack4(acc[tm][tn]);
    }
  };
  gemm_tile_(p.wv, smem, 16, la, lb, epi);
}

constexpr int N_UPM = 676;
DI void ph_up(const Params& p, int item, int layer, char* smem) {
  const int nt = item % 44, mtile = item / 44;
  int bi, mt, S;
  if (mtile < 132) { bi = mtile / 33; mt = mtile % 33; S = 4096; }
  else { int t = mtile - 132; bi = 4 + t / 17; mt = t % 17; S = 2048; }
  const size_t tokb = tok0_of_batch(bi);
  const u16* h2 = (const u16*)(p.ws + OFF_RB + RB_H2) + tokb * 1024;
  const u16* wt = (const u16*)(p.ws + OFF_WT + layer * WT_LAYER + WT_UP);
  u16* gated = (u16*)(p.ws + OFF_RB + RB_GATED) + tokb * DFF;
  const int pbase = 126 * mt - 1;
  auto la = [&](int row, int k) {
    int pos = pbase + row;
    uint4 v = make_uint4(0, 0, 0, 0);
    if (pos >= 0 && pos < S) v = *(const uint4*)(h2 + (size_t)pos * 1024 + k);
    return v;
  };
  auto lb = [&](int n, int k) {
    int nn = n < 64 ? nt * 64 + n : DFF + nt * 64 + (n - 64);
    return *(const uint4*)(wt + (size_t)nn * 1024 + k);
  };
  auto epi = [&](f32x4 (&acc)[4][4], int wm, int wn, int lane) {
    const int r = lane & 15, q = lane >> 4, tid = ltid();
    u16* sU = (u16*)smem;
    __syncthreads();
#pragma unroll
    for (int tm = 0; tm < 4; ++tm) {
      int m = wm * 64 + tm * 16 + r;
#pragma unroll
      for (int tn = 0; tn < 4; ++tn) *(uint2*)(sU + m * 136 + wn * 64 + tn * 16 + q * 4) = pack4(acc[tm][tn]);
    }
    __syncthreads();
    const int c2 = (tid & 31) * 2, rb = tid >> 5;
    const int na = nt * 64 + c2, nb = DFF + na;
    const float* cw = p.conv_w + (size_t)layer * 3 * 5632;
    const float* cbias = p.conv_b + (size_t)layer * 5632;
    float wa[3][2], wb[3][2], ba[2], bb[2];
#pragma unroll
    for (int t = 0; t < 3; ++t) { wa[t][0] = cw[t * 5632 + na]; wa[t][1] = cw[t * 5632 + na + 1]; wb[t][0] = cw[t * 5632 + nb]; wb[t][1] = cw[t * 5632 + nb + 1]; }
    ba[0] = cbias[na]; ba[1] = cbias[na + 1]; bb[0] = cbias[nb]; bb[1] = cbias[nb + 1];
    for (int i = 0; i < 16; ++i) {
      int rr = rb + 8 * i;
      int pos = pbase + rr;
      if (rr >= 1 && rr <= 126 && pos < S) {
        float a0 = ba[0], a1 = ba[1], b0 = bb[0], b1 = bb[1];
#pragma unroll
        for (int t = 0; t < 3; ++t) {
          unsigned ua = *(const unsigned*)(sU + (rr - 1 + t) * 136 + c2);
          unsigned ub = *(const unsigned*)(sU + (rr - 1 + t) * 136 + 64 + c2);
          a0 += wa[t][0] * blo(ua); a1 += wa[t][1] * bhi(ua);
          b0 += wb[t][0] * blo(ub); b1 += wb[t][1] * bhi(ub);
        }
        float g0 = fsilu(a0) * b0, g1 = fsilu(a1) * b1;
        *(unsigned*)(gated + (size_t)pos * DFF + na) = pack2(g0, g1);
      }
    }
  };
  gemm_tile_(p.wv, smem, 16, la, lb, epi);
}

DI void ph_down(const Params& p, int item, int layer, char* smem) {
  const int nt = item & 7, tile = item >> 3;
  const u16* a = (const u16*)(p.ws + OFF_RB + RB_GATED) + (size_t)tile * 128 * DFF;
  const u16* wt = (const u16*)(p.ws + OFF_WT + layer * WT_LAYER + WT_DOWN) + (size_t)nt * 128 * DFF;
  u16* y = (u16*)(p.ws + OFF_RA) + (size_t)tile * 128 * 1024 + nt * 128;
  auto la = [&](int row, int k) { return *(const uint4*)(a + (size_t)row * DFF + k); };
  auto lb = [&](int n, int k) { return *(const uint4*)(wt + (size_t)n * DFF + k); };
  auto epi = [&](f32x4 (&acc)[4][4], int wm, int wn, int lane) {
    const int r = lane & 15, q = lane >> 4;
#pragma unroll
    for (int tm = 0; tm < 4; ++tm) {
      int m = wm * 64 + tm * 16 + r;
#pragma unroll
      for (int tn = 0; tn < 4; ++tn) *(uint2*)(y + (size_t)m * 1024 + wn * 64 + tn * 16 + q * 4) = pack4(acc[tm][tn]);
    }
  };
  gemm_tile_(p.wv, smem, 44, la, lb, epi);
}


namespace g8 {
#define G8_LAS __attribute__((address_space(3)))
constexpr int BM = 256, BK = 64, HALF = 128, HTB = HALF * BK * 2, STAGE_BYTES = 8 * HTB, NXCD = 8, WGM = 8;
DI int lds_byte(int r, int c) { const int st = (r >> 4) * 2 + (c >> 5), rr = r & 15, cc = c & 31, ob = rr * 64 + cc * 2; return st * 1024 + (ob ^ (((ob >> 9) & 1) << 5)); }
DI void stage_rc(int b, int& R, int& C) { const int st = b / 1024, sb = b % 1024, swz = sb ^ (((sb >> 9) & 1) << 5); R = (st >> 1) * 16 + swz / 64; C = (st & 1) * 32 + (swz % 64) / 2; }
struct Unit { int pm, pn; };
struct Order {
  int nM, nN, nwg, G, c;
  DI bool next(int i, Unit& u) const {
    const long L = (long)i * G + c;
    if (L >= nwg) return false;
    int wgid = (int)L;
    { const int q = nwg / NXCD, r = nwg % NXCD, xcd = wgid % NXCD, off = wgid / NXCD; wgid = (xcd < r ? xcd * (q + 1) : r * (q + 1) + (xcd - r) * q) + off; }
    const int nig = WGM * nN, gid = wgid / nig, fm = gid * WGM, gsz = (nM - fm) < WGM ? (nM - fm) : WGM;
    u.pm = fm + ((wgid % nig) % gsz);
    u.pn = (wgid % nig) / gsz;
    return true;
  }
};
template <int lda, int ldb, int K, int nM, int nN, class Epi>
DI void gemm_phase(int wv_, G8_LAS unsigned char* lds, const u16* A, const u16* Bt, const Epi& E) {
  int tid_ = (wv_ << 6) | lane_now();
  asm volatile("" : "+v"(tid_));
  const int tid = tid_, wid = __builtin_amdgcn_readfirstlane(tid >> 6), lane = tid & 63, wr = wid >> 2, wc = wid & 3, fr = lane & 15, fq = lane >> 4;
  const int nt = K / BK;
  Order S;
  S.nM = nM; S.nN = nN; S.nwg = nM * nN; S.G = gridDim.x; S.c = blockIdx.x;
  unsigned voffA[2], voffB[2];
#pragma unroll
  for (int i = 0; i < 2; ++i) { int R, C; stage_rc(tid * 16 + i * 8192, R, C); voffA[i] = (unsigned)(R * lda + C) * 2u; voffB[i] = (unsigned)(R * ldb + C) * 2u; }
  const size_t kstep = (size_t)(BK * 2);
  const size_t hstepA = (size_t)HALF * lda * 2, tstepA = 2 * hstepA, hstepB = (size_t)HALF * ldb * 2, tstepB = 2 * hstepB;
  const unsigned ldsw = (unsigned)wid * 1024u;
  const int aoff = lds_byte(wr * 64 + fr, fq * 8), boff = lds_byte(wc * 32 + fr, fq * 8);
#define G8_SA(b, h) (((b) * 2 + (h)) * HTB)
#define G8_SB(b, h) ((4 + (b) * 2 + (h)) * HTB)
#define G8_STAGE(bufoff, gbase, voff) do { _Pragma("unroll") for (int _i = 0; _i < 2; ++_i) \
    __builtin_amdgcn_global_load_lds((const unsigned*)((const char*)(gbase) + (voff)[_i]), (G8_LAS unsigned*)(lds + (bufoff) + ldsw + _i * 8192), 16, 0, 0); } while (0)
#define G8_LDA(dst, b, h) do { _Pragma("unroll") for (int m = 0; m < 4; ++m) _Pragma("unroll") for (int k = 0; k < 2; ++k) dst[m][k] = *(const G8_LAS bf16x8*)(lds + G8_SA(b, h) + aoff + m * 2048 + k * 1024); } while (0)
#define G8_LDB(dst, b, h) do { _Pragma("unroll") for (int n = 0; n < 2; ++n) _Pragma("unroll") for (int k = 0; k < 2; ++k) dst[n][k] = *(const G8_LAS bf16x8*)(lds + G8_SB(b, h) + boff + n * 2048 + k * 1024); } while (0)
#define G8_MMA(ai, bj, At, Bt) do { __builtin_amdgcn_s_setprio(1); _Pragma("unroll") for (int m = 0; m < 4; ++m) _Pragma("unroll") for (int n = 0; n < 2; ++n) _Pragma("unroll") for (int k = 0; k < 2; ++k) \
    acc[ai][bj][m][n] = __builtin_amdgcn_mfma_f32_16x16x32_bf16(Bt[n][k], At[m][k], acc[ai][bj][m][n], 0, 0, 0); __builtin_amdgcn_s_setprio(0); } while (0)
#define G8_WAIT_V(n) asm volatile("s_waitcnt vmcnt(" #n ")" ::: "memory")
#define G8_WAIT_L(n) asm volatile("s_waitcnt lgkmcnt(" #n ")" ::: "memory")
#define G8_BAR __builtin_amdgcn_s_barrier()
#define G8_SCHED __builtin_amdgcn_sched_barrier(0)
  Unit cur, nxt;
  int ui = 0;
  if (!S.next(0, cur)) return;
  f32x4 acc[2][2][4][2];
  float zz_ = 0.f;
  asm volatile("" : "+v"(zz_));
#pragma unroll
  for (int a = 0; a < 2; ++a)
#pragma unroll
    for (int b = 0; b < 2; ++b)
#pragma unroll
      for (int m = 0; m < 4; ++m)
#pragma unroll
        for (int n = 0; n < 2; ++n) acc[a][b][m][n] = (f32x4){zz_, zz_, zz_, zz_};
  bf16x8 At[4][2], B0[2][2], B1[2][2];
  const char* cA = (const char*)A + (size_t)cur.pm * tstepA;
  const char* cB = (const char*)Bt + (size_t)cur.pn * tstepB;
  G8_STAGE(G8_SB(0, 0), cB, voffB); G8_STAGE(G8_SA(0, 0), cA, voffA); G8_STAGE(G8_SB(0, 1), cB + hstepB, voffB); G8_STAGE(G8_SA(0, 1), cA + hstepA, voffA);
  if (wr == 1) G8_BAR;
  G8_WAIT_V(4); G8_BAR;
  G8_STAGE(G8_SB(1, 0), cB + kstep, voffB); G8_STAGE(G8_SA(1, 0), cA + kstep, voffA); G8_STAGE(G8_SB(1, 1), cB + hstepB + kstep, voffB);
  G8_WAIT_V(6); G8_BAR;
  for (;;) {
    const bool has_next = S.next(ui + 1, nxt);
    const char* nA = has_next ? (const char*)A + (size_t)nxt.pm * tstepA : cA;
    const char* nB = has_next ? (const char*)Bt + (size_t)nxt.pn * tstepB : cB;
    for (int t = 0; t < nt; t += 2) {
      const bool last = (t == nt - 2);
      const char* a1 = cA + (size_t)(t + 1) * kstep;
      const char* a2 = last ? nA : cA + (size_t)(t + 2) * kstep;
      const char* b2 = last ? nB : cB + (size_t)(t + 2) * kstep;
      const char* a3 = a2 + kstep;
      const char* b3 = b2 + kstep;
      G8_LDB(B0, 0, 0); G8_SCHED; G8_LDA(At, 0, 0); G8_STAGE(G8_SA(1, 1), a1 + hstepA, voffA);
      G8_WAIT_L(8); G8_BAR; G8_WAIT_L(0); G8_MMA(0, 0, At, B0); G8_BAR; G8_SCHED;
      G8_LDB(B1, 0, 1); G8_STAGE(G8_SB(0, 0), b2, voffB);
      G8_BAR; G8_WAIT_L(0); G8_MMA(0, 1, At, B1); G8_BAR;
      G8_LDA(At, 0, 1); G8_STAGE(G8_SA(0, 0), a2, voffA);
      G8_BAR; G8_WAIT_L(0); G8_MMA(1, 0, At, B0); G8_BAR; G8_SCHED;
      G8_STAGE(G8_SB(0, 1), b2 + hstepB, voffB);
      G8_WAIT_V(6); G8_BAR; G8_MMA(1, 1, At, B1); G8_BAR;
      G8_LDB(B0, 1, 0); G8_SCHED; G8_LDA(At, 1, 0); G8_STAGE(G8_SA(0, 1), a2 + hstepA, voffA);
      G8_WAIT_L(8); G8_BAR; G8_WAIT_L(0); G8_MMA(0, 0, At, B0); G8_BAR; G8_SCHED;
      G8_LDB(B1, 1, 1); G8_STAGE(G8_SB(1, 0), b3, voffB);
      G8_BAR; G8_WAIT_L(0); G8_MMA(0, 1, At, B1); G8_BAR;
      G8_LDA(At, 1, 1); G8_STAGE(G8_SA(1, 0), a3, voffA);
      G8_BAR; G8_WAIT_L(0); G8_MMA(1, 0, At, B0); G8_BAR; G8_SCHED;
      G8_STAGE(G8_SB(1, 1), b3 + hstepB, voffB);
      G8_WAIT_V(6); G8_BAR; G8_MMA(1, 1, At, B1); G8_BAR;
    }
    E(acc, cur, wr, wc, fr, fq);
    if (!has_next) break;
#pragma unroll
    for (int a = 0; a < 2; ++a)
#pragma unroll
      for (int b = 0; b < 2; ++b)
#pragma unroll
        for (int m = 0; m < 4; ++m)
#pragma unroll
          for (int n = 0; n < 2; ++n) acc[a][b][m][n] = (f32x4){zz_, zz_, zz_, zz_};
    cur = nxt; cA = nA; cB = nB; ++ui;
  }
  G8_WAIT_V(0);
  if (wr == 0) G8_BAR;
  G8_BAR;
}
struct EpiStore {
  u16* O; int ldc;
  DI void operator()(const f32x4 (&acc)[2][2][4][2], const Unit& u, int wr, int wc, int fr, int fq) const {
#pragma unroll
    for (int ai = 0; ai < 2; ++ai)
#pragma unroll
      for (int m = 0; m < 4; ++m) {
        u16* rowp = O + (size_t)(u.pm * BM + ai * HALF + wr * 64 + m * 16 + fr) * ldc + u.pn * BM + wc * 32 + fq * 4;
#pragma unroll
        for (int bj = 0; bj < 2; ++bj)
#pragma unroll
          for (int n = 0; n < 2; ++n) *(uint2*)(rowp + bj * HALF + n * 16) = pack4(acc[ai][bj][m][n]);
      }
  }
};
}


struct EpiWin {
  u16* z; u16* pqt; const float2* tab;
  DI void operator()(f32x4 (&acc)[2][2][4][2], const g8::Unit& u, int wr, int wc, int fr, int fq) const {
#pragma unroll
    for (int ai = 0; ai < 2; ++ai) {
      int bi, S, pos0;
      tile_info(u.pm * 2 + ai, bi, S, pos0);
      u16* pq = pqt + (size_t)tok0_of_batch(bi) * 512;
#pragma unroll
      for (int m = 0; m < 4; ++m) {
        const int rl = wr * 64 + m * 16 + fr;
        const int pos = pos0 + rl;
        const int fpos = pos <= (S >> 1) ? pos : 3 * (S >> 1) - pos;
        const size_t tok = (size_t)(u.pm * 2 + ai) * 128 + rl;
        const float2* tr = tab + pos * 56;
#pragma unroll
        for (int bj = 0; bj < 2; ++bj) {
          const int W0 = u.pn * 256 + bj * 128 + wc * 32;
          f32x4 a0 = acc[ai][bj][m][0], a1 = acc[ai][bj][m][1];
          if (W0 < 512) {
#pragma unroll
            for (int e = 0; e < 4; ++e) {
              pq[(size_t)(W0 + fq * 4 + e) * S + fpos] = f2bf(a0[e]);
              pq[(size_t)(W0 + 16 + fq * 4 + e) * S + fpos] = f2bf(a1[e]);
            }
            continue;
          }
          const int zw = W0 - 512;
          if (zw >= ZW) continue;
          const int zh = zw & ~63;
          if (zh < 512) {
            const float sc = zh >= 256 ? 0.125f : 1.f;
            const int i0 = 16 * (wc & 1) + 4 * fq;
            rope_pair(a0, a1, tr + 24 + 16 * (wc & 1), fq, sc);
            *(uint2*)(z + tok * ZW + zh + i0) = pack4(a0);
            *(uint2*)(z + tok * ZW + zh + 32 + i0) = pack4(a1);
            continue;
          }
          const bool prope = (zh >= 1024 && zh < 1536) || (zh >= 1792 && zh < 2816);
          if (prope) {
            const bool isq = (zh >= 1280 && zh < 1536) || (zh >= 1792 && zh < 2304);
            const float sc = isq ? 0.125f * LOG2E : 1.f;
            if ((wc & 1) == 0) {
#pragma unroll
              for (int e = 0; e < 4; ++e) {
                float2 cs = tr[16 + (fq & 1) * 4 + e];
                float v = a0[e];
                float o = __shfl_xor(v, 32);
                a0[e] = fq < 2 ? v * cs.x - o * cs.y : v * cs.x + o * cs.y;
              }
            }
#pragma unroll
            for (int e = 0; e < 4; ++e) { a0[e] *= sc; a1[e] *= sc; }
          } else if (zw == Z_KR) {
            rope_pair(a0, a1, tr, fq, 1.f);
          }
          *(uint2*)(z + tok * ZW + zw + fq * 4) = pack4(a0);
          *(uint2*)(z + tok * ZW + zw + 16 + fq * 4) = pack4(a1);
        }
      }
    }
  }
};


struct EpiUp {
  u16* gated; const float* cw; const float* cbias; char* xbuf; int wv;
  DI void operator()(f32x4 (&acc)[2][2][4][2], const g8::Unit& u, int wr, int wc, int fr, int fq) const {
    u16* sX = (u16*)xbuf;
    int tid_ = (wv << 6) | lane_now();
    asm volatile("" : "+v"(tid_));
    const int row = tid_ >> 1, hf = tid_ & 1;
    const int T = 254 * u.pm - 1 + row;
    const bool live = row >= 1 && row <= 254 && T < NTOK;
    int pos = 0, S = 4096;
    if (live) { if (T < 16384) { pos = T & 4095; } else { pos = (T - 16384) & 2047; S = 2048; } }
    const bool hasp = pos > 0, hasn = pos < S - 1;
    if (wr == 0) __builtin_amdgcn_s_barrier();
#pragma unroll 1
    for (int wcj = 0; wcj < 4; ++wcj)
#pragma unroll
    for (int nj = 0; nj < 2; ++nj) {
      if (wc == wcj) {
#pragma unroll
        for (int ai = 0; ai < 2; ++ai)
#pragma unroll
          for (int m = 0; m < 4; ++m) {
            int r = ai * 128 + wr * 64 + m * 16 + fr;
            *(uint2*)(sX + r * 32 + fq * 4) = pack4(acc[ai][0][m][nj]);
            *(uint2*)(sX + r * 32 + 16 + fq * 4) = pack4(acc[ai][1][m][nj]);
          }
      }
      __syncthreads();
      if (live) {
        const int ca = u.pn * 128 + wcj * 32 + nj * 16 + hf * 8;
        float oa[8], ob[8];
#pragma unroll
        for (int e = 0; e < 8; ++e) { oa[e] = cbias[ca + e]; ob[e] = cbias[DFF + ca + e]; }
#pragma unroll
        for (int t = 0; t < 3; ++t) {
          if ((t == 0 && !hasp) || (t == 2 && !hasn)) continue;
          uint4 va = *(const uint4*)(sX + (row - 1 + t) * 32 + hf * 8);
          uint4 vb = *(const uint4*)(sX + (row - 1 + t) * 32 + 16 + hf * 8);
          unsigned wa[4] = {va.x, va.y, va.z, va.w}, wb[4] = {vb.x, vb.y, vb.z, vb.w};
#pragma unroll
          for (int e = 0; e < 8; ++e) {
            float ua = (e & 1) ? bhi(wa[e >> 1]) : blo(wa[e >> 1]);
            float ub = (e & 1) ? bhi(wb[e >> 1]) : blo(wb[e >> 1]);
            oa[e] += cw[t * 5632 + ca + e] * ua;
            ob[e] += cw[t * 5632 + DFF + ca + e] * ub;
          }
        }
        unsigned o[4];
#pragma unroll
        for (int e = 0; e < 8; e += 2) {
          float g0 = fsilu(oa[e]) * ob[e], g1 = fsilu(oa[e + 1]) * ob[e + 1];
          o[e >> 1] = pack2(g0, g1);
        }
        *(uint4*)(gated + (size_t)T * DFF + ca) = make_uint4(o[0], o[1], o[2], o[3]);
      }
      __syncthreads();
    }
    if (wr == 1) __builtin_amdgcn_s_barrier();
  }
};


#define XB_TMO      128
#define XB_XCNT(j)  (256  + 64 * (j))
#define XB_XSUB(j)  (1280 + 64 * (j))
#define XB_XGEN(j)  (2304 + 64 * (j))
#define XB_TOP      3328
#define XB_TOPGEN   3392
#define XCD_BAR_WORDS 3456
#define XB_SPIN_CAP (1u << 18)
#define XLAS __attribute__((address_space(3)))
DI unsigned xb_ld(unsigned* p) { return __hip_atomic_load(p, __ATOMIC_RELAXED, __HIP_MEMORY_SCOPE_AGENT); }
DI unsigned xb_add(unsigned* p, unsigned v) { return __hip_atomic_fetch_add(p, v, __ATOMIC_RELAXED, __HIP_MEMORY_SCOPE_AGENT); }
DI unsigned xb_xcc_id() { return (unsigned)__builtin_amdgcn_s_getreg((3 << 11) | 20) & 0xFu; }
#define XB_SPIN(cond, bar) do { unsigned _sp = 0; while (cond) { __builtin_amdgcn_s_sleep(1); \
    if ((++_sp & 255u) == 0u) { if (xb_ld(&(bar)[XB_TMO])) break; if (_sp > XB_SPIN_CAP) { atomicAdd(&(bar)[XB_TMO], 1u); break; } } } } while (0)
struct XcdBarrier { unsigned* bar; unsigned x; volatile XLAS unsigned* st; };
DI XcdBarrier xcd_barrier_post(unsigned* bar, volatile XLAS unsigned* st) {
  XcdBarrier b; b.bar = bar; b.x = xb_xcc_id(); b.st = st;
  if (threadIdx.x == 0) (void)xb_add(&bar[XB_XCNT(b.x)], 1u);
  return b;
}
DI void xcd_barrier_complete(unsigned* bar, unsigned x, unsigned& nloc, unsigned& nx) {
  const unsigned G = gridDim.x * gridDim.y * gridDim.z;
  unsigned sum, cnt, mine, sp = 0u;
  for (;;) {
    sum = 0u; cnt = 0u; mine = 0u;
#pragma unroll
    for (unsigned j = 0; j < 16; ++j) { const unsigned c = xb_ld(&bar[XB_XCNT(j)]); sum += c; cnt += (c > 0u) ? 1u : 0u; mine = (j == x) ? c : mine; }
    if (sum == G) break;
    __builtin_amdgcn_s_sleep(1);
    if ((++sp & 255u) == 0u) { if (xb_ld(&bar[XB_TMO])) break; if (sp > XB_SPIN_CAP) { atomicAdd(&bar[XB_TMO], 1u); break; } }
  }
  nloc = mine > 0u ? mine : 1u; nx = cnt > 0u ? cnt : 1u;
}
DI void xcd_barrier(const XcdBarrier& b) {
  asm volatile("s_waitcnt vmcnt(0)" ::: "memory");
  __syncthreads();
  if (threadIdx.x == 0) {
    unsigned* bar = b.bar;
    __builtin_amdgcn_s_waitcnt(0);
    unsigned nloc = b.st[0], nx = b.st[1];
    if (nloc == 0u) { xcd_barrier_complete(bar, b.x, nloc, nx); b.st[0] = nloc; b.st[1] = nx; }
    const unsigned old = xb_add(&bar[XB_XSUB(b.x)], 1u);
    const unsigned gen = old / nloc;
    if (old + 1u == (gen + 1u) * nloc) {
      __builtin_amdgcn_fence(__ATOMIC_RELEASE, "agent");
      asm volatile("s_waitcnt vmcnt(0)" ::: "memory");
      const unsigned og = xb_add(&bar[XB_TOP], 1u);
      const unsigned tg = og / nx;
      if (og + 1u == (tg + 1u) * nx) xb_add(&bar[XB_TOPGEN], 1u);
      else XB_SPIN(xb_ld(&bar[XB_TOPGEN]) == tg, bar);
      __builtin_amdgcn_fence(__ATOMIC_ACQUIRE, "agent");
      xb_add(&bar[XB_XGEN(b.x)], 1u);
      asm volatile("s_waitcnt vmcnt(0)" ::: "memory");
    } else {
      XB_SPIN(xb_ld(&bar[XB_XGEN(b.x)]) == gen, bar);
      __builtin_amdgcn_fence(__ATOMIC_ACQUIRE, "agent");
      asm volatile("s_waitcnt vmcnt(0)" ::: "memory");
    }
  }
  __syncthreads();
}

#define GSYNC() do { xcd_barrier(xb); if (PROBE & 128) xcd_barrier(xb); } while (0)
template <int layer>
DI void run_layer(const Params& pp, const XcdBarrier& xb, char* smem_all, int wv0) {
  const int hb = wv0 >> 2;
  char* smem = smem_all + hb * HALF_LDS;
  const int vb = blockIdx.x * 2 + hb, nvb = gridDim.x * 2;
#define PH_BEGIN Params p = pp; p.wv = wv0; asm volatile("" : "+s"(p.ws), "+s"(p.out), "+s"(p.wv));
  {
    PH_BEGIN
    __syncthreads();
    EpiWin E{(u16*)(p.ws + OFF_RB), (u16*)(p.ws + OFF_PQT), (const float2*)(p.ws + OFF_TAB)};
    for (int rep_ = 0; rep_ < 1 + (((PROBE >> 8) & 1) && layer == 0 ? 1 : 0); ++rep_)
    g8::gemm_phase<1024, 1024, 1024, 320, 17>(p.wv, (G8_LAS unsigned char*)smem_all, (const u16*)(p.ws + OFF_RA), (const u16*)(p.ws + OFF_WT + layer * WT_LAYER + WT_IN), E);
  }
  GSYNC();
  {
    PH_BEGIN
    int* ctr = (int*)(p.ws + OFF_CTR) + layer * 2 + 0;
    volatile int* slot = (volatile int*)(smem_all + 2 * HALF_LDS);
    for (;;) {
      __syncthreads();
      if (p.wv == 0 && lane_now() == 0) *slot = atomicAdd(ctr, 2);
      __syncthreads();
      const int it = *slot + hb;
      if (it >= N_P2) break;
      int i = it;
      if (i < N_RST) { ph_retscan(p, i, layer, smem); continue; }
      i -= N_RST;
      if (i < N_DIL) { if ((PROBE & 2) && layer == 0) ph_dil(p, i, smem, true); ph_dil(p, i, smem); continue; }
      i -= N_DIL;
      if (i < N_QP) { ph_qproj(p, i, layer, smem); continue; }
      i -= N_QP;
      if (i < N_KVP) { ph_kvproj(p, i, layer, smem); continue; }
      i -= N_KVP;
      ph_pqfold(p, i);
    }
  }
  GSYNC();
  {
    PH_BEGIN
    int* ctr = (int*)(p.ws + OFF_CTR) + layer * 2 + 1;
    volatile int* slot = (volatile int*)(smem_all + 2 * HALF_LDS);
    for (;;) {
      __syncthreads();
      if (p.wv == 0 && lane_now() == 0) *slot = atomicAdd(ctr, 2);
      __syncthreads();
      const int it = *slot + hb;
      if (it >= N_P3) break;
      int i = it;
      if (i < N_FM) { ph_fmid(p, i); continue; }
      i -= N_FM;
      if (i < N_MLA) { if ((PROBE & 4) && layer == 0) ph_mla(p, i, smem); ph_mla(p, i, smem); continue; }
      i -= N_MLA;
      if (i < N_FG) { ph_fgemm(p, i, smem); continue; }
      i -= N_FG;
      if (i < N_RO) { ph_retout(p, i, layer, smem); continue; }
      i -= N_RO;
      ph_comb(p, i);
    }
  }
  GSYNC();
  {
    PH_BEGIN
    __syncthreads();
    g8::EpiStore E{(u16*)(p.ws + OFF_RA), 1024};
    for (int rep_ = 0; rep_ < 1 + (((PROBE >> 9) & 1) && layer == 0 ? 1 : 0); ++rep_)
    g8::gemm_phase<ZW, 1024, 1024, 320, 4>(p.wv, (G8_LAS unsigned char*)smem_all, (const u16*)(p.ws + OFF_RB) + Z_RG, (const u16*)(p.ws + OFF_WT + layer * WT_LAYER + WT_OUT), E);
  }
  GSYNC();
  {
    PH_BEGIN
    for (int it = vb; it < 5120; it += nvb) { if ((PROBE & 32) && layer == 0) ph_ew(p, it, 1, layer); ph_ew(p, it, 1, layer); }
  }
  GSYNC();
  {
    PH_BEGIN
    __syncthreads();
    EpiUp E{(u16*)(p.ws + OFF_RB + RB_GATED), p.conv_w + (size_t)layer * 3 * 5632, p.conv_b + (size_t)layer * 5632, smem_all + 131072, p.wv};
    for (int rep_ = 0; rep_ < 1 + (((PROBE >> 10) & 1) && layer == 0 ? 1 : 0); ++rep_)
    g8::gemm_phase<1024, 1024, 1024, 323, 22>(p.wv, (G8_LAS unsigned char*)smem_all, (const u16*)(p.ws + OFF_RB + RB_H2), (const u16*)(p.ws + OFF_WT + layer * WT_LAYER + WT_UP), E);
  }
  GSYNC();
  {
    PH_BEGIN
    __syncthreads();
    g8::EpiStore E{(u16*)(p.ws + OFF_RA), 1024};
    for (int rep_ = 0; rep_ < 1 + (((PROBE >> 11) & 1) && layer == 0 ? 1 : 0); ++rep_)
    g8::gemm_phase<DFF, DFF, DFF, 320, 4>(p.wv, (G8_LAS unsigned char*)smem_all, (const u16*)(p.ws + OFF_RB + RB_GATED), (const u16*)(p.ws + OFF_WT + layer * WT_LAYER + WT_DOWN), E);
  }
  GSYNC();
  {
    PH_BEGIN
    for (int it = vb; it < 5120; it += nvb) ph_ew(p, it, 2, layer);
  }
}

__global__ void __launch_bounds__(512, 2) mega(Params pp) {
  extern __shared__ __attribute__((aligned(16))) char smem_all[];
  cg::grid_group grid = cg::this_grid();
  const int wv0 = __builtin_amdgcn_readfirstlane(threadIdx.x >> 6);
  volatile XLAS unsigned* xst = (volatile XLAS unsigned*)(smem_all + 2 * HALF_LDS + 16);
  if (threadIdx.x < 2) xst[threadIdx.x] = 0u;
  __syncthreads();
  XcdBarrier xb = xcd_barrier_post((unsigned*)(pp.ws + OFF_BAR), xst);
  {
    const int hb = wv0 >> 2;
    char* smem = smem_all + hb * HALF_LDS;
    const int vb = blockIdx.x * 2 + hb, nvb = gridDim.x * 2;
    {
      PH_BEGIN
      int* ctr = (int*)(p.ws + OFF_CTR) + 8;
      volatile int* slot = (volatile int*)(smem_all + 2 * HALF_LDS);
      for (;;) {
        __syncthreads();
        if (p.wv == 0 && lane_now() == 0) *slot = atomicAdd(ctr, 2);
        __syncthreads();
        const int j = *slot + hb;
        if (j >= N_PREP) break;
        int it;
        if (j < 192) it = PI_TR + PI_FOLD + PI_PAD + j;
        else if (j < 320) it = PI_TR + (j - 192);
        else if (j < 576) it = PI_TR + PI_FOLD + PI_PAD + PI_MOD + (j - 320);
        else if (j < 832) it = PI_TR + PI_FOLD + PI_PAD + PI_MOD + PI_DFT + (j - 576);
        else if (j < 834) it = PI_TR + PI_FOLD + (j - 832);
        else it = j - 834;
        ph_prep(p, it, smem);
      }
    }
    grid.sync();
    {
      PH_BEGIN
      for (int it = vb; it < 5120; it += nvb) ph_ew(p, it, 0, 0);
    }
    GSYNC();
  }
  run_layer<0>(pp, xb, smem_all, wv0);
  GSYNC();
  run_layer<1>(pp, xb, smem_all, wv0);
}

extern "C" void kernel_launch(void* const* d_in, const int* in_sizes, int n_in, void* d_out, int out_size, void* d_ws,
                              size_t ws_size, hipStream_t stream) {
  static int grid_blocks = 0;
  if (!grid_blocks) {
    hipFuncSetAttribute((const void*)mega, hipFuncAttributeMaxDynamicSharedMemorySize, DYN_LDS);
    int dev = 0, cus = 0, per_cu = 0;
    hipGetDevice(&dev);
    hipDeviceGetAttribute(&cus, hipDeviceAttributeMultiprocessorCount, dev);
    hipOccupancyMaxActiveBlocksPerMultiprocessor(&per_cu, mega, 512, DYN_LDS);
    if (per_cu > 1) per_cu = 1;
    if (per_cu < 1) per_cu = 1;
    grid_blocks = cus * per_cu;
  }
  if (ws_size < WS_NEED) { fprintf(stderr, "workspace too small: %zu < %zu\n", ws_size, (size_t)WS_NEED); return; }
  Params p{};
  const float** f = (const float**)&p;
  for (int i = 0; i < 23; ++i) f[i] = (const float*)d_in[i];
  p.out = (float*)d_out;
  p.ws = (char*)d_ws;
#if 0
#else
  hipMemsetAsync((char*)d_ws + OFF_CTR, 0, 4096 + 16384, stream);
  p.ph_lo = 0;
  p.ph_hi = 20;
  void* args[] = {&p};
  hipError_t e = hipLaunchCooperativeKernel((void*)mega, dim3(grid_blocks), dim3(512), args, DYN_LDS, stream);
  if (e != hipSuccess) fprintf(stderr, "cooperative launch failed: %s (grid %d)\n", hipGetErrorString(e), grid_blocks);
#endif
}
```

```cpp
#include <hip/hip_runtime.h>
#include <hip/hip_cooperative_groups.h>
#include <cstdio>
namespace cg = cooperative_groups;

#ifndef PROBE
#define PROBE 0
#endif
#ifndef MULTI
#define MULTI 0
#endif

#define DI __device__ __forceinline__
typedef unsigned short u16;
typedef __attribute__((ext_vector_type(8))) short bf16x8;
typedef __attribute__((ext_vector_type(4))) float f32x4;

constexpr int NTOK = 81920;
constexpr int ZW = 3744;
constexpr int Z_RQ = 0, Z_RK = 256, Z_RV = 512, Z_RG = 768, Z_DK0 = 1024, Z_DQ0 = 1280, Z_CQ = 1536, Z_CKV = 3584, Z_KR = 3712;
__device__ __forceinline__ int zdq(int g) { return g == 0 ? 1280 : 1792 + (g - 1) * 256; }
__device__ __forceinline__ int zdk(int g) { return g == 0 ? 1024 : 2304 + (g - 1) * 256; }
__device__ __forceinline__ int zdv(int g) { return 2816 + g * 256; }
constexpr int DFF = 2816;
constexpr float EPS = 1e-6f;
constexpr float LOG2E = 1.4426950408889634f;
constexpr float LN2 = 0.6931471805599453f;

constexpr size_t OFF_RA = 0;
constexpr size_t OFF_RB = 167772160ull;
constexpr size_t OFF_PQT = OFF_RB + 613416960ull;
constexpr size_t OFF_RS = OFF_RB + 697303040ull;
constexpr size_t OFF_WT = OFF_RS + 83886080ull;
constexpr size_t WT_LAYER = 28639232ull;
constexpr size_t WT_IN = 0, WT_OUT = 8912896ull, WT_UP = 11010048ull, WT_DOWN = 22544384ull, WT_QB = 28311552ull, WT_KVB = 28508160ull;
constexpr size_t OFF_DFT = OFF_WT + 2 * WT_LAYER;
constexpr size_t OFF_TAB = OFF_DFT + 33554432ull;
constexpr size_t OFF_MOD = OFF_TAB + 1835008ull;
constexpr size_t OFF_LSE = OFF_MOD + 1769472ull;
constexpr size_t OFF_CTR = OFF_LSE + 3932160ull;
constexpr size_t OFF_BAR = OFF_CTR + 4096ull;
constexpr size_t WS_NEED = OFF_BAR + 16384ull;
constexpr size_t RA_QM = 0, RA_KB = 62914560ull, RA_VT = 125829120ull;
constexpr size_t RB_H2 = 0, RB_GATED = 169345024ull;

constexpr int HALF_LDS = 73728;
constexpr int DYN_LDS = 2 * HALF_LDS + 64;

struct Params {
  const float *x_p, *x_s, *c_p, *c_s, *w_ada, *b_ada, *n_pre_mix, *w_in, *dec_f, *dec_b, *w_fmix, *q_norm, *w_qb, *kv_norm,
      *w_kvb, *w_out, *n_post_mix, *n_pre_ffn, *w_up, *conv_w, *conv_b, *w_down, *n_post_ffn;
  float* out;
  char* ws;
  int ph_lo, ph_hi, wv, pad_;
};

DI int lane_now() { int l; asm volatile("v_mbcnt_lo_u32_b32 %0, -1, 0\n\tv_mbcnt_hi_u32_b32 %0, -1, %0" : "=v"(l)); return l; }
DI int ltid_w(int wv) { int t = ((wv & 3) << 6) | lane_now(); asm volatile("" : "+v"(t)); return t; }
#define ltid() ltid_w(p.wv)
DI u16 f2bf(float x) { __bf16 h = (__bf16)x; return __builtin_bit_cast(u16, h); }
DI float bf2f(unsigned b) { return __uint_as_float(b << 16); }
typedef __bf16 bf16x2_t __attribute__((ext_vector_type(2)));
typedef float f32x2_t __attribute__((ext_vector_type(2)));
DI unsigned pack2(float a, float b) { f32x2_t v = {a, b}; bf16x2_t r = __builtin_convertvector(v, bf16x2_t); return __builtin_bit_cast(unsigned, r); }
DI float fsilu(float a) { return a * __builtin_amdgcn_rcpf(1.f + __expf(-a)); }
DI uint2 pack4(const f32x4& v) { return make_uint2(pack2(v[0], v[1]), pack2(v[2], v[3])); }
DI float blo(unsigned w) { return __uint_as_float(w << 16); }
DI float bhi(unsigned w) { return __uint_as_float(w & 0xffff0000u); }
DI int tok0_of_batch(int bi) { return bi < 4 ? bi * 4096 : 16384 + (bi - 4) * 2048; }
DI void tile_info(int tile, int& bi, int& S, int& pos0) {
  if (tile < 128) { bi = tile >> 5; S = 4096; pos0 = (tile & 31) << 7; }
  else { int t = tile - 128; bi = 4 + (t >> 4); S = 2048; pos0 = (t & 15) << 7; }
}
DI int batch_of_tok(int tok) { return tok < 16384 ? (tok >> 12) : 4 + ((tok - 16384) >> 11); }

template <int TM, int TN>
DI void mma(const u16* sA, int lda, const u16* sB, int ldb, int ksteps, f32x4 (&acc)[TM][TN], int lane) {
  const int r = lane & 15, q = lane >> 4;
  for (int ks = 0; ks < ksteps; ++ks) {
    bf16x8 a[TM], b[TN];
#pragma unroll
    for (int i = 0; i < TM; ++i) a[i] = *(const bf16x8*)(sA + (i * 16 + r) * lda + ks * 32 + q * 8);
#pragma unroll
    for (int i = 0; i < TN; ++i) b[i] = *(const bf16x8*)(sB + (i * 16 + r) * ldb + ks * 32 + q * 8);
#pragma unroll
    for (int i = 0; i < TM; ++i)
#pragma unroll
      for (int j = 0; j < TN; ++j) acc[i][j] = __builtin_amdgcn_mfma_f32_16x16x32_bf16(b[j], a[i], acc[i][j], 0, 0, 0);
  }
}
template <int TM, int TN>
DI void zero_acc(f32x4 (&acc)[TM][TN]) {
  float zz = 0.f;
  asm volatile("" : "+v"(zz));
#pragma unroll
  for (int i = 0; i < TM; ++i)
#pragma unroll
    for (int j = 0; j < TN; ++j) acc[i][j] = f32x4{zz, zz, zz, zz};
}

template <class LA, class LB, class EP>
DI void gemm_tile_(int wv_, char* smem, int nk, LA loadA, LB loadB, EP epi) {
  u16* sA = (u16*)smem;
  u16* sB = sA + 128 * 72;
  const int tid = ltid_w(wv_), lane = tid & 63, w = tid >> 6, wm = w >> 1, wn = w & 1;
  const int lr = tid >> 3, lk = (tid & 7) * 8;
  uint4 ra[4], rb[4];
  f32x4 acc[4][4];
  zero_acc(acc);
#pragma unroll
  for (int i = 0; i < 4; ++i) { ra[i] = loadA(lr + 32 * i, lk); rb[i] = loadB(lr + 32 * i, lk); }
  for (int kt = 0; kt < nk; ++kt) {
    __syncthreads();
#pragma unroll
    for (int i = 0; i < 4; ++i) {
      *(uint4*)(sA + (lr + 32 * i) * 72 + lk) = ra[i];
      *(uint4*)(sB + (lr + 32 * i) * 72 + lk) = rb[i];
    }
    __syncthreads();
    if (kt + 1 < nk) {
#pragma unroll
      for (int i = 0; i < 4; ++i) { ra[i] = loadA(lr + 32 * i, (kt + 1) * 64 + lk); rb[i] = loadB(lr + 32 * i, (kt + 1) * 64 + lk); }
    }
    mma<4, 4>(sA + wm * 64 * 72, 72, sB + wn * 64 * 72, 72, 2, acc, lane);
  }
  epi(acc, wm, wn, lane);
}

template <class LA, class LB, class EP>
DI void gemm_tile2_(int wv_, char* smem, int nk, LA loadA, LB loadB, EP epi) {
  constexpr int BUFE = 128 * 72 + 64 * 72;
  u16* sbase = (u16*)smem;
  const int tid = ltid_w(wv_), lane = tid & 63, w = tid >> 6, wm = w >> 1, wn = w & 1;
  const int lr = tid >> 3, lk = (tid & 7) * 8;
  uint4 ra[4], rb[2];
  f32x4 acc[4][2], acc1[4][2];
  zero_acc(acc);
  zero_acc(acc1);
#pragma unroll
  for (int i = 0; i < 4; ++i) ra[i] = loadA(lr + 32 * i, lk);
#pragma unroll
  for (int i = 0; i < 2; ++i) rb[i] = loadB(lr + 32 * i, lk);
  __syncthreads();
#pragma unroll
  for (int i = 0; i < 4; ++i) *(uint4*)(sbase + (lr + 32 * i) * 72 + lk) = ra[i];
#pragma unroll
  for (int i = 0; i < 2; ++i) *(uint4*)(sbase + 128 * 72 + (lr + 32 * i) * 72 + lk) = rb[i];
#pragma unroll
  for (int i = 0; i < 4; ++i) ra[i] = loadA(lr + 32 * i, 64 + lk);
#pragma unroll
  for (int i = 0; i < 2; ++i) rb[i] = loadB(lr + 32 * i, 64 + lk);
  __syncthreads();
  const int nkh = nk >> 1;
  for (int kt = 0; kt < nk; ++kt) {
    u16* sA = sbase + (kt & 1) * BUFE;
    u16* sB = sA + 128 * 72;
    if (kt == nkh) {
#pragma unroll
      for (int i = 0; i < 4; ++i)
#pragma unroll
        for (int j = 0; j < 2; ++j) { acc1[i][j] = acc[i][j]; acc[i][j] = f32x4{0.f, 0.f, 0.f, 0.f}; }
    }
    mma<4, 2>(sA + wm * 64 * 72, 72, sB + wn * 32 * 72, 72, 2, acc, lane);
    if (kt + 1 < nk) {
      u16* nA = sbase + ((kt + 1) & 1) * BUFE;
      u16* nB = nA + 128 * 72;
#pragma unroll
      for (int i = 0; i < 4; ++i) *(uint4*)(nA + (lr + 32 * i) * 72 + lk) = ra[i];
#pragma unroll
      for (int i = 0; i < 2; ++i) *(uint4*)(nB + (lr + 32 * i) * 72 + lk) = rb[i];
      if (kt + 2 < nk) {
#pragma unroll
        for (int i = 0; i < 4; ++i) ra[i] = loadA(lr + 32 * i, (kt + 2) * 64 + lk);
#pragma unroll
        for (int i = 0; i < 2; ++i) rb[i] = loadB(lr + 32 * i, (kt + 2) * 64 + lk);
      }
    }
    __syncthreads();
  }
  epi(acc1, acc, wm, wn, lane);
}

DI void rope_pair(f32x4& a, f32x4& b, const float2* tabrow, int q, float sc) {
#pragma unroll
  for (int jj = 0; jj < 4; ++jj) {
    float2 cs = tabrow[q * 4 + jj];
    float x1 = a[jj], x2 = b[jj];
    a[jj] = (x1 * cs.x - x2 * cs.y) * sc;
    b[jj] = (x2 * cs.x + x1 * cs.y) * sc;
  }
}

constexpr int PI_TRL = 3416, PI_TR = 2 * PI_TRL, PI_FOLD = 128, PI_PAD = 2, PI_MOD = 192, PI_DFT = 256, PI_TAB = 256;
constexpr int N_PREP = PI_TR + PI_FOLD + PI_PAD + PI_MOD + PI_DFT + PI_TAB;

DI int swap45(int c) { return (c & 15) | ((c & 16) << 1) | ((c & 32) >> 1); }
DI void tr_tile_(int wv_, char* smem, const float* src, int lds, int k0, int s0, int nvalid, u16* dst, int ldd, int n0, const float* kscale, bool perm = false) {
  float* t = (float*)smem;
  const int tid = ltid_w(wv_);
  __syncthreads();
#pragma unroll 4
  for (int i = 0; i < 16; ++i) {
    int kr = (tid >> 6) + 4 * i, c = tid & 63;
    float v = (c < nvalid) ? src[(size_t)(k0 + kr) * lds + s0 + c] : 0.f;
    if (kscale) v *= kscale[k0 + kr];
    t[c * 65 + kr] = v;
  }
  __syncthreads();
#pragma unroll 4
  for (int i = 0; i < 16; ++i) {
    int c = (tid >> 6) + 4 * i, kr = tid & 63;
    if (c < nvalid) dst[(size_t)(n0 + (perm ? swap45(c) : c)) * ldd + k0 + kr] = f2bf(t[c * 65 + kr]);
  }
}

DI void ph_prep(const Params& p, int item, char* smem) {
  const int tid = ltid();
  if (item < PI_TR) {
    int layer = item / PI_TRL, it = item % PI_TRL;
    char* wt = p.ws + OFF_WT + layer * WT_LAYER;
    if (it < 1008) {
      int ct = it >> 4, kt = it & 15;
      if (ct >= 16 && ct < 20) return;
      int s0 = ct * 64, zc;
      if (s0 < 1536) zc = s0; else if (s0 < 2048) zc = s0 + 256; else if (s0 < 2304) zc = s0 - 1024; else if (s0 < 3584) zc = s0;
      else if (s0 < 3840) zc = s0 - 2048; else zc = s0 - 256;
      int n0 = 512 + zc;
      int nv = 4000 - s0 < 64 ? 4000 - s0 : 64;
      tr_tile_(p.wv, smem, p.w_in + (size_t)layer * 1024 * 4000, 4000, kt * 64, s0, nv, (u16*)(wt + WT_IN), 1024, n0, nullptr, s0 < 512);
      return;
    }
    it -= 1008;
    if (it < 256) { tr_tile_(p.wv, smem, p.w_out + (size_t)layer * 1024 * 1024, 1024, (it & 15) * 64, (it >> 4) * 64, 64, (u16*)(wt + WT_OUT), 1024, (it >> 4) * 64, nullptr); return; }
    it -= 256;
    if (it < 1408) {
      int s0 = (it >> 4) * 64, n0;
      if (s0 < DFF) n0 = (s0 >> 7) * 256 + (s0 & 127); else { int sb = s0 - DFF; n0 = (sb >> 7) * 256 + 128 + (sb & 127); }
      tr_tile_(p.wv, smem, p.w_up + (size_t)layer * 1024 * 5632, 5632, (it & 15) * 64, s0, 64, (u16*)(wt + WT_UP), 1024, n0, nullptr);
      return;
    }
    it -= 1408;
    if (it < 704) { int kt = it % 44, ct = it / 44; tr_tile_(p.wv, smem, p.w_down + (size_t)layer * 2816 * 1024, 1024, kt * 64, ct * 64, 64, (u16*)(wt + WT_DOWN), 2816, ct * 64, nullptr); return; }
    it -= 704;
    if (it < 24) { int kt = it & 3, ct = it >> 2; tr_tile_(p.wv, smem, p.w_qb + (size_t)layer * 256 * 384, 384, kt * 64, ct * 64, 64, (u16*)(wt + WT_QB), 256, ct * 64, p.q_norm + layer * 256); return; }
    it -= 24;
    { int kt = it & 1, ct = it >> 1; tr_tile_(p.wv, smem, p.w_kvb + (size_t)layer * 128 * 512, 512, kt * 64, ct * 64, 64, (u16*)(wt + WT_KVB), 128, ct * 64, p.kv_norm + layer * 128); return; }
  }
  item -= PI_TR;
  if (item < PI_FOLD) {
    int layer = item >> 6, g = (item >> 4) & 3, cs = (item >> 3) & 1, kc = item & 7;
    float* M = (float*)smem;
    float* ct = M + 4096;
    __syncthreads();
    if (tid < 64) ct[tid] = cospif((float)tid / 32.f);
    __syncthreads();
    const float* Wf = p.w_fmix + ((size_t)layer * 4 + g) * 4096;
    for (int i = 0; i < 16; ++i) {
      int idx = tid + 256 * i, c = idx >> 6, e = idx & 63;
      float a = 0.f;
      for (int c2 = 0; c2 < 64; ++c2) {
        int x = (c * c2) & 63;
        float tv = cs ? ct[(x - 16) & 63] : ct[x];
        a += tv * Wf[c2 * 64 + e];
      }
      M[c * 64 + e] = a;
    }
    __syncthreads();
    const float* W = p.w_in + (size_t)layer * 1024 * 4000 + 1024 + g * 64;
    u16* dst = (u16*)(p.ws + OFF_WT + layer * WT_LAYER + WT_IN);
    int e = tid & 63, kq = tid >> 6;
    for (int i = 0; i < 32; ++i) {
      int k = kc * 128 + kq * 32 + i;
      float a = 0.f;
#pragma unroll 8
      for (int c = 0; c < 64; ++c) a += W[(size_t)k * 4000 + c] * M[c * 64 + e];
      dst[(size_t)(cs * 256 + g * 64 + e) * 1024 + k] = f2bf(a);
    }
    return;
  }
  item -= PI_FOLD;
  if (item < PI_PAD) {
    uint4* dst = (uint4*)(p.ws + OFF_WT + item * WT_LAYER + WT_IN + (size_t)4256 * 1024 * 2);
    for (int i = tid; i < 96 * 1024 * 2 / 16; i += 256) dst[i] = make_uint4(0, 0, 0, 0);
    return;
  }
  item -= PI_PAD;
  if (item < PI_MOD) {
    int layer = item / 96, cb = item % 96;
    float* sC = (float*)smem;
    float* sR = sC + 4608;
    int col = cb * 64 + (tid & 63), kq = tid >> 6;
    float acc[36];
#pragma unroll
    for (int b = 0; b < 36; ++b) acc[b] = 0.f;
    const float* wa = p.w_ada + (size_t)layer * 1024 * 6144;
#pragma unroll 1
    for (int kc = 0; kc < 8; ++kc) {
      __syncthreads();
#pragma unroll 2
      for (int i = 0; i < 18; ++i) {
        int idx = tid + 256 * i, qq = idx / 1152, rem = idx % 1152, b = rem >> 5, kk = rem & 31;
        int k = qq * 256 + kc * 32 + kk;
        float c = b < 4 ? p.c_p[b * 1024 + k] : p.c_s[(b - 4) * 1024 + k];
        sC[idx] = fsilu(c);
      }
      __syncthreads();
#pragma unroll 2
      for (int kk = 0; kk < 32; ++kk) {
        float wv = wa[(size_t)(kq * 256 + kc * 32 + kk) * 6144 + col];
#pragma unroll
        for (int b = 0; b < 36; ++b) acc[b] += sC[(kq * 36 + b) * 32 + kk] * wv;
      }
    }
    __syncthreads();
#pragma unroll
    for (int b = 0; b < 36; ++b) sR[(kq * 36 + b) * 64 + (tid & 63)] = acc[b];
    __syncthreads();
    float* mod = (float*)(p.ws + OFF_MOD) + (size_t)layer * 36 * 6144;
    for (int i = 0; i < 9; ++i) {
      int idx = tid + 256 * i, b = idx >> 6, c = idx & 63;
      float s = sR[(0 * 36 + b) * 64 + c] + sR[(1 * 36 + b) * 64 + c] + sR[(2 * 36 + b) * 64 + c] + sR[(3 * 36 + b) * 64 + c];
      mod[b * 6144 + cb * 64 + c] = s + p.b_ada[layer * 6144 + cb * 64 + c];
    }
    return;
  }
  item -= PI_MOD;
  if (item < PI_DFT) {
    float* tab = (float*)smem;
    __syncthreads();
    for (int i = tid; i < 4096; i += 256) tab[i] = cospif((float)i / 2048.f);
    __syncthreads();
    u16* dft = (u16*)(p.ws + OFF_DFT);
    for (int rr = 0; rr < 16; ++rr) {
      int j = item * 16 + rr;
      for (int i = 0; i < 2; ++i) {
        int ch = tid + 256 * i;
        int kb = (ch & 255) * 8;
        bool sn = ch >= 256;
        unsigned wv[4];
#pragma unroll
        for (int e = 0; e < 8; e += 2) {
          int i0 = (j * (kb + e)) & 4095, i1 = (j * (kb + e + 1)) & 4095;
          float v0 = sn ? -tab[(i0 - 1024) & 4095] : tab[i0];
          float v1 = sn ? -tab[(i1 - 1024) & 4095] : tab[i1];
          wv[e >> 1] = pack2(v0, v1);
        }
        *(uint4*)(dft + (size_t)j * 4096 + ch * 8) = make_uint4(wv[0], wv[1], wv[2], wv[3]);
      }
    }
    return;
  }
  item -= PI_DFT;
  {
    float2* tab = (float2*)(p.ws + OFF_TAB);
    for (int idx = tid; idx < 896; idx += 256) {
      int pos = item * 16 + idx / 56, a = idx % 56;
      float inv;
      if (a < 16) inv = powf(500000.f, -(float)a * 2.f / 32.f);
      else if (a < 24) inv = powf(500000.f, -(float)(a - 16) * 2.f / 16.f);
      else inv = powf(10000.f, -(float)(a - 24) * 2.f / 64.f);
      float ang = (float)pos * inv;
      float s, c;
      sincosf(ang, &s, &c);
      tab[pos * 56 + a] = make_float2(c, s);
    }
  }
}

DI void ph_ew(const Params& p, int item, int mode, int layer) {
  const int tid = ltid(), lane = tid & 63, w = tid >> 6;
  const float* mod = (const float*)(p.ws + OFF_MOD);
  for (int i = 0; i < 4; ++i) {
    int tok = item * 16 + w * 4 + i;
    int bi = batch_of_tok(tok);
    const float* xin;
    if (mode == 0 || (mode == 1 && layer == 0)) xin = tok < 16384 ? p.x_p + (size_t)tok * 1024 : p.x_s + (size_t)(tok - 16384) * 1024;
    else xin = p.out + (size_t)tok * 1024;
    float x[16];
#pragma unroll
    for (int h2 = 0; h2 < 2; ++h2) {
      const float4* xp = (const float4*)(xin + lane * 8 + 512 * h2);
      float4 a = xp[0], b = xp[1];
      x[h2 * 8 + 0] = a.x; x[h2 * 8 + 1] = a.y; x[h2 * 8 + 2] = a.z; x[h2 * 8 + 3] = a.w;
      x[h2 * 8 + 4] = b.x; x[h2 * 8 + 5] = b.y; x[h2 * 8 + 6] = b.z; x[h2 * 8 + 7] = b.w;
    }
    if (mode != 0) {
      const u16* y = (const u16*)(p.ws + OFF_RA) + (size_t)tok * 1024;
      float yv[16];
      float ss = 0.f;
#pragma unroll
      for (int h2 = 0; h2 < 2; ++h2) {
        uint4 v = *(const uint4*)(y + lane * 8 + 512 * h2);
        unsigned wv[4] = {v.x, v.y, v.z, v.w};
#pragma unroll
        for (int e = 0; e < 4; ++e) { yv[h2 * 8 + 2 * e] = blo(wv[e]); yv[h2 * 8 + 2 * e + 1] = bhi(wv[e]); }
      }
#pragma unroll
      for (int e = 0; e < 16; ++e) ss += yv[e] * yv[e];
#pragma unroll
      for (int o = 1; o < 64; o <<= 1) ss += __shfl_xor(ss, o);
      float rs = rsqrtf(ss * (1.f / 1024.f) + EPS);
      const float* npost = (mode == 1 ? p.n_post_mix : p.n_post_ffn) + layer * 1024;
      const float* g = mod + ((size_t)layer * 36 + bi) * 6144 + (mode == 1 ? 2048 : 5120);
#pragma unroll
      for (int h2 = 0; h2 < 2; ++h2)
#pragma unroll
        for (int e = 0; e < 8; ++e) {
          int c = lane * 8 + 512 * h2 + e;
          x[h2 * 8 + e] += g[c] * (yv[h2 * 8 + e] * rs * npost[c]);
        }
      float* xo = p.out + (size_t)tok * 1024;
#pragma unroll
      for (int h2 = 0; h2 < 2; ++h2) {
        float4* op = (float4*)(xo + lane * 8 + 512 * h2);
        op[0] = make_float4(x[h2 * 8 + 0], x[h2 * 8 + 1], x[h2 * 8 + 2], x[h2 * 8 + 3]);
        op[1] = make_float4(x[h2 * 8 + 4], x[h2 * 8 + 5], x[h2 * 8 + 6], x[h2 * 8 + 7]);
      }
    }
    if (mode == 2 && layer == 1) continue;
    int nl = mode == 2 ? layer + 1 : layer;
    const float* npre = (mode == 1 ? p.n_pre_ffn : p.n_pre_mix) + nl * 1024;
    const float* mb = mod + ((size_t)nl * 36 + bi) * 6144 + (mode == 1 ? 3072 : 0);
    float ss = 0.f;
#pragma unroll
    for (int e = 0; e < 16; ++e) ss += x[e] * x[e];
#pragma unroll
    for (int o = 1; o < 64; o <<= 1) ss += __shfl_xor(ss, o);
    float rs = rsqrtf(ss * (1.f / 1024.f) + EPS);
    const int umt = tok / 254, urr = tok % 254;
    u16* hd = mode == 1 ? (u16*)(p.ws + OFF_RB + RB_H2) + ((size_t)umt * 256 + urr + 1) * 1024 : (u16*)(p.ws + OFF_RA) + (size_t)tok * 1024;
#pragma unroll
    for (int h2 = 0; h2 < 2; ++h2) {
      unsigned wv[4];
#pragma unroll
      for (int e = 0; e < 8; e += 2) {
        int c = lane * 8 + 512 * h2 + e;
        float v0 = x[h2 * 8 + e] * rs * npre[c] * (1.f + mb[1024 + c]) + mb[c];
        float v1 = x[h2 * 8 + e + 1] * rs * npre[c + 1] * (1.f + mb[1024 + c + 1]) + mb[c + 1];
        wv[e >> 1] = pack2(v0, v1);
      }
      uint4 ov = make_uint4(wv[0], wv[1], wv[2], wv[3]);
      *(uint4*)(hd + lane * 8 + 512 * h2) = ov;
      if (mode == 1) {
        u16* hb = (u16*)(p.ws + OFF_RB + RB_H2);
        if (urr == 0 && umt > 0) *(uint4*)(hb + ((size_t)(umt - 1) * 256 + 255) * 1024 + lane * 8 + 512 * h2) = ov;
        if (urr == 253 && umt + 1 < 323) *(uint4*)(hb + ((size_t)(umt + 1) * 256) * 1024 + lane * 8 + 512 * h2) = ov;
      }
    }
  }
}

DI void ph_win(const Params& p, int item, int layer, char* smem) {
  const int nt = item % 34, tile = item / 34;
  int bi, S, pos0;
  tile_info(tile, bi, S, pos0);
  const u16* h = (const u16*)(p.ws + OFF_RA) + (size_t)tile * 128 * 1024;
  const u16* wt = (const u16*)(p.ws + OFF_WT + layer * WT_LAYER + WT_IN) + (size_t)nt * 128 * 1024;
  u16* z = (u16*)(p.ws + OFF_RB);
  u16* pqt = (u16*)(p.ws + OFF_PQT) + (size_t)tok0_of_batch(bi) * 512;
  const float2* tab = (const float2*)(p.ws + OFF_TAB);
  auto la = [&](int row, int k) { return *(const uint4*)(h + (size_t)row * 1024 + k); };
  auto lb = [&](int n, int k) { return *(const uint4*)(wt + (size_t)n * 1024 + k); };
  auto epi = [&](f32x4 (&acc)[4][4], int wm, int wn, int lane) {
    const int r = lane & 15, q = lane >> 4;
    const int nw0 = nt * 128 + wn * 64;
    const int zc0 = nw0 - 512;
    if (nt >= 4 && zc0 >= ZW) return;
#pragma unroll
    for (int tm = 0; tm < 4; ++tm) {
      int m = wm * 64 + tm * 16 + r;
      int pos = pos0 + m;
      size_t tok = (size_t)tile * 128 + m;
      if (nt < 4) {
#pragma unroll
        for (int tn = 0; tn < 4; ++tn)
#pragma unroll
          for (int jj = 0; jj < 4; ++jj) {
            int n = nw0 + tn * 16 + q * 4 + jj;
            pqt[(size_t)n * S + pos] = f2bf(acc[tm][tn][jj]);
          }
        continue;
      }
      const float2* tr = tab + pos * 56;
      const bool prope = (zc0 >= 1024 && zc0 < 1536) || (zc0 >= 1792 && zc0 < 2816);
      if (zc0 < 512) {
        float sc = zc0 >= 256 ? 0.125f : 1.f;
        rope_pair(acc[tm][0], acc[tm][2], tr + 24, q, sc);
        rope_pair(acc[tm][1], acc[tm][3], tr + 24 + 16, q, sc);
      } else if (prope) {
        const bool isq = (zc0 >= 1280 && zc0 < 1536) || (zc0 >= 1792 && zc0 < 2304);
        float sc = isq ? 0.125f * LOG2E : 1.f;
#pragma unroll
        for (int jj = 0; jj < 4; ++jj) {
          float2 cs = tr[16 + (q & 1) * 4 + jj];
          float v = acc[tm][0][jj];
          float o = __shfl_xor(v, 32);
          acc[tm][0][jj] = q < 2 ? v * cs.x - o * cs.y : v * cs.x + o * cs.y;
        }
#pragma unroll
        for (int tn = 0; tn < 4; ++tn)
#pragma unroll
          for (int jj = 0; jj < 4; ++jj) acc[tm][tn][jj] *= sc;
      } else if (zc0 == Z_KR) {
        rope_pair(acc[tm][0], acc[tm][1], tr, q, 1.f);
      }
      u16* zr = z + tok * ZW + zc0 + q * 4;
      *(uint2*)(zr) = pack4(acc[tm][0]);
      *(uint2*)(zr + 16) = pack4(acc[tm][1]);
      if (zc0 != Z_KR) {
        *(uint2*)(zr + 32) = pack4(acc[tm][2]);
        *(uint2*)(zr + 48) = pack4(acc[tm][3]);
      }
    }
  };
  gemm_tile_(p.wv, smem, 16, la, lb, epi);
}

constexpr int N_DIL = 3840, N_QP = 1920, N_KVP = 2560, N_RST = 144, N_PQF = 2304;
constexpr int N_P2 = N_RST + N_DIL + N_QP + N_KVP + N_PQF;

DI bf16x8 pack8(const f32x4& a, const f32x4& b) {
  uint4 u = make_uint4(pack2(a[0], a[1]), pack2(a[2], a[3]), pack2(b[0], b[1]), pack2(b[2], b[3]));
  return __builtin_bit_cast(bf16x8, u);
}
DI bf16x8 ldvt2(const u16* row, int c0, int c1) {
  uint2 lo = *(const uint2*)(row + c0), hi = *(const uint2*)(row + c1);
  uint4 u = make_uint4(lo.x, lo.y, hi.x, hi.y);
  return __builtin_bit_cast(bf16x8, u);
}

DI void ph_dil(const Params& p, int item, char* smem, bool dry = false) {
  int bi, rem, nbt, S;
  if (item < 768) { bi = item / 192; rem = item % 192; nbt = 64; S = 4096; }
  else { int it = item - 768; bi = 4 + it / 96; rem = it % 96; nbt = 32; S = 2048; }
  const int g = rem / nbt, blk = rem % nbt, dil = 1 << (2 * g), L = S / dil, nblk = L >> 6;
  const int r = blk / nblk, nb = blk % nblk;
  const size_t tokb = tok0_of_batch(bi);
  u16* z = (u16*)(p.ws + OFF_RB);
  u16* sQ = (u16*)smem;
  u16* sK = sQ + 64 * 72;
  u16* sVT = sK + 192 * 72;
  u16* sP = sK;
  const int tid = ltid(), lane = tid & 63, w = tid >> 6;
  const int qq = w * 16 + (lane & 15), q4 = lane >> 4;
  uint4 rq0, rq1, rk0, rk1, rk2, rk3, rk4, rk5, rv0, rv1, rv2, rv3, rv4, rv5;
#define DIL_LOAD(hd_) { const int cq_ = zdq(g) + (hd_)*64, ck_ = zdk(g) + (hd_)*64, cv_ = zdv(g) + (hd_)*64; \
    { int c = tid + 0, row = c >> 3, kc = (c & 7) * 8; rq0 = *(const uint4*)(z + (tokb + r + dil * (nb * 64 + row)) * ZW + cq_ + kc); } \
    { int c = tid + 256, row = c >> 3, kc = (c & 7) * 8; rq1 = *(const uint4*)(z + (tokb + r + dil * (nb * 64 + row)) * ZW + cq_ + kc); } \
    { int c = tid + 0, row = c >> 3, kc = (c & 7) * 8; int t = nb * 64 - 64 + row; rk0 = make_uint4(0, 0, 0, 0); if (t >= 0 && t < L) rk0 = *(const uint4*)(z + (tokb + r + dil * t) * ZW + ck_ + kc); } \
    { int c = tid + 256, row = c >> 3, kc = (c & 7) * 8; int t = nb * 64 - 64 + row; rk1 = make_uint4(0, 0, 0, 0); if (t >= 0 && t < L) rk1 = *(const uint4*)(z + (tokb + r + dil * t) * ZW + ck_ + kc); } \
    { int c = tid + 512, row = c >> 3, kc = (c & 7) * 8; int t = nb * 64 - 64 + row; rk2 = make_uint4(0, 0, 0, 0); if (t >= 0 && t < L) rk2 = *(const uint4*)(z + (tokb + r + dil * t) * ZW + ck_ + kc); } \
    { int c = tid + 768, row = c >> 3, kc = (c & 7) * 8; int t = nb * 64 - 64 + row; rk3 = make_uint4(0, 0, 0, 0); if (t >= 0 && t < L) rk3 = *(const uint4*)(z + (tokb + r + dil * t) * ZW + ck_ + kc); } \
    { int c = tid + 1024, row = c >> 3, kc = (c & 7) * 8; int t = nb * 64 - 64 + row; rk4 = make_uint4(0, 0, 0, 0); if (t >= 0 && t < L) rk4 = *(const uint4*)(z + (tokb + r + dil * t) * ZW + ck_ + kc); } \
    { int c = tid + 1280, row = c >> 3, kc = (c & 7) * 8; int t = nb * 64 - 64 + row; rk5 = make_uint4(0, 0, 0, 0); if (t >= 0 && t < L) rk5 = *(const uint4*)(z + (tokb + r + dil * t) * ZW + ck_ + kc); } \
    { int c = tid + 0, kp = c % 96, kc = (c / 96) * 8; int t0 = nb * 64 - 64 + 2 * kp; rv0 = make_uint4(0, 0, 0, 0); rv1 = make_uint4(0, 0, 0, 0); if (t0 >= 0 && t0 < L) rv0 = *(const uint4*)(z + (tokb + r + dil * t0) * ZW + cv_ + kc); if (t0 + 1 >= 0 && t0 + 1 < L) rv1 = *(const uint4*)(z + (tokb + r + dil * (t0 + 1)) * ZW + cv_ + kc); } \
    { int c = tid + 256, kp = c % 96, kc = (c / 96) * 8; int t0 = nb * 64 - 64 + 2 * kp; rv2 = make_uint4(0, 0, 0, 0); rv3 = make_uint4(0, 0, 0, 0); if (t0 >= 0 && t0 < L) rv2 = *(const uint4*)(z + (tokb + r + dil * t0) * ZW + cv_ + kc); if (t0 + 1 >= 0 && t0 + 1 < L) rv3 = *(const uint4*)(z + (tokb + r + dil * (t0 + 1)) * ZW + cv_ + kc); } \
    { int c = tid + 512, kp = c % 96, kc = (c / 96) * 8; int t0 = nb * 64 - 64 + 2 * kp; rv4 = make_uint4(0, 0, 0, 0); rv5 = make_uint4(0, 0, 0, 0); if (t0 >= 0 && t0 < L) rv4 = *(const uint4*)(z + (tokb + r + dil * t0) * ZW + cv_ + kc); if (t0 + 1 >= 0 && t0 + 1 < L) rv5 = *(const uint4*)(z + (tokb + r + dil * (t0 + 1)) * ZW + cv_ + kc); } \
  }
  DIL_LOAD(0);
#pragma unroll 1
  for (int hd = 0; hd < 4; ++hd) {
    const int colq = zdq(g) + hd * 64;
    __syncthreads();
    { int c = tid + 0, row = c >> 3, kc = (c & 7) * 8; *(uint4*)(sQ + row * 72 + kc) = rq0; }
    { int c = tid + 256, row = c >> 3, kc = (c & 7) * 8; *(uint4*)(sQ + row * 72 + kc) = rq1; }
    { int c = tid + 0, row = c >> 3, kc = (c & 7) * 8; *(uint4*)(sK + row * 72 + kc) = rk0; }
    { int c = tid + 256, row = c >> 3, kc = (c & 7) * 8; *(uint4*)(sK + row * 72 + kc) = rk1; }
    { int c = tid + 512, row = c >> 3, kc = (c & 7) * 8; *(uint4*)(sK + row * 72 + kc) = rk2; }
    { int c = tid + 768, row = c >> 3, kc = (c & 7) * 8; *(uint4*)(sK + row * 72 + kc) = rk3; }
    { int c = tid + 1024, row = c >> 3, kc = (c & 7) * 8; *(uint4*)(sK + row * 72 + kc) = rk4; }
    { int c = tid + 1280, row = c >> 3, kc = (c & 7) * 8; *(uint4*)(sK + row * 72 + kc) = rk5; }
    { int c = tid + 0, kp = c % 96, kc = (c / 96) * 8;
      const int k5_ = (2 * kp) & 31, pc = ((2 * kp) & ~31) | (8 * ((k5_ >> 2) & 3) + 4 * (k5_ >> 4) + (k5_ & 3));
      unsigned w0[4] = {rv0.x, rv0.y, rv0.z, rv0.w}, w1[4] = {rv1.x, rv1.y, rv1.z, rv1.w};
#pragma unroll
      for (int e = 0; e < 4; ++e) {
        *(unsigned*)(sVT + (kc + 2 * e) * 200 + pc) = (w0[e] & 0xffffu) | (w1[e] << 16);
        *(unsigned*)(sVT + (kc + 2 * e + 1) * 200 + pc) = (w0[e] >> 16) | (w1[e] & 0xffff0000u);
      } }
    { int c = tid + 256, kp = c % 96, kc = (c / 96) * 8;
      const int k5_ = (2 * kp) & 31, pc = ((2 * kp) & ~31) | (8 * ((k5_ >> 2) & 3) + 4 * (k5_ >> 4) + (k5_ & 3));
      unsigned w0[4] = {rv2.x, rv2.y, rv2.z, rv2.w}, w1[4] = {rv3.x, rv3.y, rv3.z, rv3.w};
#pragma unroll
      for (int e = 0; e < 4; ++e) {
        *(unsigned*)(sVT + (kc + 2 * e) * 200 + pc) = (w0[e] & 0xffffu) | (w1[e] << 16);
        *(unsigned*)(sVT + (kc + 2 * e + 1) * 200 + pc) = (w0[e] >> 16) | (w1[e] & 0xffff0000u);
      } }
    { int c = tid + 512, kp = c % 96, kc = (c / 96) * 8;
      const int k5_ = (2 * kp) & 31, pc = ((2 * kp) & ~31) | (8 * ((k5_ >> 2) & 3) + 4 * (k5_ >> 4) + (k5_ & 3));
      unsigned w0[4] = {rv4.x, rv4.y, rv4.z, rv4.w}, w1[4] = {rv5.x, rv5.y, rv5.z, rv5.w};
#pragma unroll
      for (int e = 0; e < 4; ++e) {
        *(unsigned*)(sVT + (kc + 2 * e) * 200 + pc) = (w0[e] & 0xffffu) | (w1[e] << 16);
        *(unsigned*)(sVT + (kc + 2 * e + 1) * 200 + pc) = (w0[e] >> 16) | (w1[e] & 0xffff0000u);
      } }
    if (hd < 3) DIL_LOAD(hd + 1);
    __syncthreads();
    f32x4 s[10];
    {
      float zz = 0.f;
      asm volatile("" : "+v"(zz));
#pragma unroll
      for (int t = 0; t < 10; ++t) s[t] = f32x4{zz, zz, zz, zz};
    }
    const int lr = lane & 15;
#pragma unroll
    for (int ks = 0; ks < 2; ++ks) {
      bf16x8 qa = *(const bf16x8*)(sQ + (w * 16 + lr) * 72 + ks * 32 + q4 * 8);
#pragma unroll
      for (int t = 0; t < 9; ++t) {
        bf16x8 kb = *(const bf16x8*)(sK + ((w + t) * 16 + lr) * 72 + ks * 32 + q4 * 8);
        s[t] = __builtin_amdgcn_mfma_f32_16x16x32_bf16(kb, qa, s[t], 0, 0, 0);
      }
    }
    const int klo = max(qq, 64 - nb * 64), khi = min(qq + 128, L - 1 + 64 - nb * 64);
    const unsigned kspan = (unsigned)(khi - klo);
    const int kb0 = w * 16 + q4 * 4 - klo;
    float mx = -1e30f;
#pragma unroll
    for (int t = 0; t < 9; ++t)
#pragma unroll
      for (int jj = 0; jj < 4; ++jj) {
        bool ok = (unsigned)(kb0 + t * 16 + jj) <= kspan;
        float v = ok ? s[t][jj] : -1e30f;
        s[t][jj] = v;
        mx = fmaxf(mx, v);
      }
    mx = fmaxf(mx, __shfl_xor(mx, 16));
    mx = fmaxf(mx, __shfl_xor(mx, 32));
    float den = 0.f;
#pragma unroll
    for (int t = 0; t < 9; ++t)
#pragma unroll
      for (int jj = 0; jj < 4; ++jj) {
        float pv = __builtin_amdgcn_exp2f(s[t][jj] - mx);
        den += pv;
        s[t][jj] = pv;
      }
    den += __shfl_xor(den, 16);
    den += __shfl_xor(den, 32);
    f32x4 o[1][4];
    zero_acc(o);
    const u16* vrow = sVT + lr * 200 + ((w & ~1) >> 1) * 32 + q4 * 8;
    if (w & 1) {
#pragma unroll
      for (int pp = 0; pp < 5; ++pp) {
        bf16x8 pa = pp == 0 ? pack8(s[9], s[0]) : pack8(s[2 * pp - 1], s[2 * pp]);
#pragma unroll
        for (int td = 0; td < 4; ++td) {
          bf16x8 vb = *(const bf16x8*)(vrow + td * 16 * 200 + pp * 32);
          o[0][td] = __builtin_amdgcn_mfma_f32_16x16x32_bf16(vb, pa, o[0][td], 0, 0, 0);
        }
      }
    } else {
#pragma unroll
      for (int pp = 0; pp < 5; ++pp) {
        bf16x8 pa = pack8(s[2 * pp], s[2 * pp + 1]);
#pragma unroll
        for (int td = 0; td < 4; ++td) {
          bf16x8 vb = *(const bf16x8*)(vrow + td * 16 * 200 + pp * 32);
          o[0][td] = __builtin_amdgcn_mfma_f32_16x16x32_bf16(vb, pa, o[0][td], 0, 0, 0);
        }
      }
    }
    const float inv = 1.f / den;
    const size_t tok = tokb + r + dil * (nb * 64 + qq);
#pragma unroll
    for (int tn = 0; tn < 4; ++tn) {
      f32x4 v = o[0][tn];
      v[0] *= inv; v[1] *= inv; v[2] *= inv; v[3] *= inv;
      if (dry) *(uint2*)((u16*)p.out + tok * 1024 + (colq & 1023) + tn * 16 + q4 * 4) = pack4(v);
      else *(uint2*)(z + tok * ZW + colq + tn * 16 + q4 * 4) = pack4(v);
    }
    if (q4 == 0) ((float*)(p.ws + OFF_LSE))[((size_t)g * NTOK + tok) * 4 + hd] = (mx + log2f(den)) * LN2;
  }
#undef DIL_LOAD
}

DI void row_rstd_(int wv_, float* sR, const u16* base, int ncols) {
  const int tid = ltid_w(wv_), row = tid >> 1, half = tid & 1;
  const u16* b = base + (size_t)row * ZW + half * (ncols >> 1);
  float ss = 0.f;
  for (int c = 0; c < (ncols >> 4); ++c) {
    uint4 v = *(const uint4*)(b + c * 8);
    unsigned wv[4] = {v.x, v.y, v.z, v.w};
#pragma unroll
    for (int e = 0; e < 4; ++e) { float a = blo(wv[e]), d = bhi(wv[e]); ss += a * a + d * d; }
  }
  ss += __shfl_xor(ss, 1);
  if (half == 0) sR[row] = rsqrtf(ss / (float)ncols + EPS);
}

DI void ph_qproj(const Params& p, int item, int layer, char* smem) {
  const int nt = item % 3, tile = item / 3;
  int bi, S, pos0;
  tile_info(tile, bi, S, pos0);
  const u16* z = (const u16*)(p.ws + OFF_RB) + (size_t)tile * 128 * ZW;
  const u16* wt = (const u16*)(p.ws + OFF_WT + layer * WT_LAYER + WT_QB) + (size_t)nt * 128 * 256;
  u16* qm = (u16*)(p.ws + OFF_RA + RA_QM);
  const float2* tab = (const float2*)(p.ws + OFF_TAB);
  float* sR = (float*)(smem + 36864);
  __syncthreads();
  row_rstd_(p.wv, sR, z + Z_CQ, 256);
  auto la = [&](int row, int k) { return *(const uint4*)(z + (size_t)row * ZW + Z_CQ + k); };
  auto lb = [&](int n, int k) { return *(const uint4*)(wt + (size_t)n * 256 + k); };
  auto epi = [&](f32x4 (&acc)[4][4], int wm, int wn, int lane) {
    const int r = lane & 15, q = lane >> 4;
    const int nw0 = nt * 128 + wn * 64;
    const float QS = 0.10206207261596575f * LOG2E;
#pragma unroll
    for (int tm = 0; tm < 4; ++tm) {
      int m = wm * 64 + tm * 16 + r;
      int pos = pos0 + m;
      size_t tok = (size_t)tile * 128 + m;
      float rs = sR[m] * QS;
#pragma unroll
      for (int tn = 0; tn < 4; ++tn)
#pragma unroll
        for (int jj = 0; jj < 4; ++jj) acc[tm][tn][jj] *= rs;
      const float2* tr = tab + pos * 56;
      if (nw0 == 64 || nw0 == 256) rope_pair(acc[tm][0], acc[tm][1], tr, q, 1.f);
      else if (nw0 == 128 || nw0 == 320) rope_pair(acc[tm][2], acc[tm][3], tr, q, 1.f);
      u16* d = qm + tok * 384 + nw0 + q * 4;
#pragma unroll
      for (int tn = 0; tn < 4; ++tn) *(uint2*)(d + tn * 16) = pack4(acc[tm][tn]);
    }
  };
  gemm_tile_(p.wv, smem, 4, la, lb, epi);
}

DI void ph_kvproj(const Params& p, int item, int layer, char* smem) {
  const int nt = item & 3, tile = item >> 2;
  int bi, S, pos0;
  tile_info(tile, bi, S, pos0);
  const u16* z = (const u16*)(p.ws + OFF_RB) + (size_t)tile * 128 * ZW;
  const u16* wt = (const u16*)(p.ws + OFF_WT + layer * WT_LAYER + WT_KVB) + (size_t)nt * 128 * 128;
  u16* kb = (u16*)(p.ws + OFF_RA + RA_KB);
  u16* vt = (u16*)(p.ws + OFF_RA + RA_VT) + (size_t)tok0_of_batch(bi) * 256;
  float* sR = (float*)(smem + 36864);
  __syncthreads();
  row_rstd_(p.wv, sR, z + Z_CKV, 128);
  auto la = [&](int row, int k) { return *(const uint4*)(z + (size_t)row * ZW + Z_CKV + k); };
  auto lb = [&](int n, int k) { return *(const uint4*)(wt + (size_t)n * 128 + k); };
  auto epi = [&](f32x4 (&acc)[4][4], int wm, int wn, int lane) {
    const int r = lane & 15, q = lane >> 4;
#pragma unroll
    for (int tm = 0; tm < 4; ++tm) {
      int m = wm * 64 + tm * 16 + r;
      int pos = pos0 + m;
      const int k5 = pos & 31;
      const int ppos = (pos & ~31) | (8 * ((k5 >> 2) & 3) + 4 * (k5 >> 4) + (k5 & 3));
      size_t tok = (size_t)tile * 128 + m;
      float rs = sR[m];
#pragma unroll
      for (int tn = 0; tn < 4; ++tn)
#pragma unroll
        for (int jj = 0; jj < 4; ++jj) acc[tm][tn][jj] *= rs;
      if (wn == 0) {
        u16* d = kb + tok * 384 + nt * 96 + q * 4;
#pragma unroll
        for (int tn = 0; tn < 4; ++tn) *(uint2*)(d + tn * 16) = pack4(acc[tm][tn]);
      } else {
#pragma unroll
        for (int tn = 0; tn < 4; ++tn)
#pragma unroll
          for (int jj = 0; jj < 4; ++jj) vt[(size_t)(nt * 64 + tn * 16 + q * 4 + jj) * S + ppos] = f2bf(acc[tm][tn][jj]);
      }
    }
    if (wn == 0) {
      int m = wm * 64 + lane;
      size_t tok = (size_t)tile * 128 + m;
      const uint4* src = (const uint4*)(z + (size_t)m * ZW + Z_KR);
      uint4* dst = (uint4*)(kb + tok * 384 + nt * 96 + 64);
#pragma unroll
      for (int e = 0; e < 4; ++e) dst[e] = src[e];
    }
  };
  gemm_tile_(p.wv, smem, 2, la, lb, epi);
}

DI float logsig(float x) { return -log1pf(expf(-x)); }

DI void ph_retscan(const Params& p, int item, int layer, char* smem) {
  const int hd = item & 3, bi = item >> 2;
  const int N = bi < 4 ? 32 : 16;
  const int tb0 = bi < 4 ? bi * 32 : 128 + (bi - 4) * 16;
  const u16* zb = (const u16*)(p.ws + OFF_RB);
  u16* sKf = (u16*)smem;
  u16* sVf = sKf + 64 * 136;
  u16* sKb = sVf + 64 * 136;
  u16* sVb = sKb + 64 * 136;
  const int tid = ltid(), lane = tid & 63, w = tid >> 6;
  const float lf = logsig(p.dec_f[layer * 4 + hd]), lb = logsig(p.dec_b[layer * 4 + hd]);
  const int dir = w >> 1, eh = w & 1;
  const float cd = __expf(128.f * (dir ? lb : lf));
  f32x4 acc[2][4];
  zero_acc(acc);
  const int r = lane & 15, q = lane >> 4;
  for (int step = 0; step < N; ++step) {
    const int nf = step, nb = N - 1 - step;
    __syncthreads();
#pragma unroll
    for (int i = 0; i < 4; ++i) {
      int c = tid + 256 * i, j = c & 127, kc = (c >> 7) * 8;
      const u16* zf = zb + ((size_t)(tb0 + nf) * 128 + j) * ZW + hd * 64 + kc;
      const u16* zr = zb + ((size_t)(tb0 + nb) * 128 + j) * ZW + hd * 64 + kc;
      uint4 kf = *(const uint4*)(zf + Z_RK), vf = *(const uint4*)(zf + Z_RV), kbv = *(const uint4*)(zr + Z_RK), vbv = *(const uint4*)(zr + Z_RV);
      unsigned kfw[4] = {kf.x, kf.y, kf.z, kf.w}, vfw[4] = {vf.x, vf.y, vf.z, vf.w}, kbw[4] = {kbv.x, kbv.y, kbv.z, kbv.w}, vbw[4] = {vbv.x, vbv.y, vbv.z, vbv.w};
      float df = __expf((float)(127 - j) * lf), db = __expf((float)j * lb);
#pragma unroll
      for (int e = 0; e < 8; ++e) {
        float kx = (e & 1) ? bhi(kfw[e >> 1]) : blo(kfw[e >> 1]);
        float ky = (e & 1) ? bhi(kbw[e >> 1]) : blo(kbw[e >> 1]);
        sKf[(kc + e) * 136 + j] = f2bf(kx * df);
        sKb[(kc + e) * 136 + j] = f2bf(ky * db);
        sVf[(kc + e) * 136 + j] = (u16)((vfw[e >> 1] >> ((e & 1) * 16)) & 0xffffu);
        sVb[(kc + e) * 136 + j] = (u16)((vbw[e >> 1] >> ((e & 1) * 16)) & 0xffffu);
      }
    }
    __syncthreads();
    const int n = dir ? nb : nf;
    float* rs = (float*)(p.ws + OFF_RS) + ((size_t)((tb0 + n) * 4 + hd) * 2 + dir) * 4096;
#pragma unroll
    for (int tm = 0; tm < 2; ++tm)
#pragma unroll
      for (int tn = 0; tn < 4; ++tn) {
        int e = eh * 32 + tm * 16 + r, d = tn * 16 + q * 4;
        *(float4*)(rs + e * 64 + d) = make_float4(acc[tm][tn][0], acc[tm][tn][1], acc[tm][tn][2], acc[tm][tn][3]);
        acc[tm][tn][0] *= cd; acc[tm][tn][1] *= cd; acc[tm][tn][2] *= cd; acc[tm][tn][3] *= cd;
      }
    mma<2, 4>((dir ? sVb : sVf) + eh * 32 * 136, 136, dir ? sKb : sKf, 136, 4, acc, lane);
  }
}

DI void ph_pqfold(const Params& p, int item) {
  const int bi = item >> 6, cg8 = item & 63;
  const int S = bi < 4 ? 4096 : 2048, H = S >> 1;
  u16* pq = (u16*)(p.ws + OFF_PQT) + (size_t)tok0_of_batch(bi) * 512;
  const int tid = ltid();
  const int nch = H >> 3;
#pragma unroll 4
  for (int c = tid; c < 8 * nch; c += 256) {
    int row = cg8 * 8 + c / nch, k = (c % nch) * 8;
    u16* rp = pq + (size_t)row * S;
    const float sgn = row < 256 ? 1.f : -1.f;
    uint4 va = *(const uint4*)(rp + k), vb = *(const uint4*)(rp + H + k);
    unsigned wa[4] = {va.x, va.y, va.z, va.w}, wb[4] = {vb.x, vb.y, vb.z, vb.w}, o[4];
#pragma unroll
    for (int e = 0; e < 4; ++e) o[e] = pack2(blo(wa[e]) + sgn * blo(wb[e]), bhi(wa[e]) + sgn * bhi(wb[e]));
    if (k == 0) o[0] = (o[0] & 0xffff0000u) | (wa[0] & 0xffffu);
    *(uint4*)(rp + k) = make_uint4(o[0], o[1], o[2], o[3]);
  }
}

constexpr int N_MLA = 2560, N_FG = 1280, N_RO = 2560, N_COMB = 640, N_FM = 36;
constexpr int N_P3 = N_MLA + N_FG + N_RO + N_COMB + N_FM;

DI void mla_softmax(f32x4 (&s)[4], f32x4 (&o)[4], float& mrun, float& lrun) {
  float mx = -1e30f;
#pragma unroll
  for (int tn = 0; tn < 4; ++tn)
#pragma unroll
    for (int jj = 0; jj < 4; ++jj) mx = fmaxf(mx, s[tn][jj]);
  mx = fmaxf(mx, __shfl_xor(mx, 16));
  mx = fmaxf(mx, __shfl_xor(mx, 32));
  float mn = fmaxf(mrun, mx);
  float alpha = __builtin_amdgcn_exp2f(mrun - mn);
  mrun = mn;
  float ps = 0.f;
#pragma unroll
  for (int tn = 0; tn < 4; ++tn)
#pragma unroll
    for (int jj = 0; jj < 4; ++jj) { float pv = __builtin_amdgcn_exp2f(s[tn][jj] - mn); ps += pv; s[tn][jj] = pv; }
  lrun = lrun * alpha + ps;
#pragma unroll
  for (int tn = 0; tn < 4; ++tn)
#pragma unroll
    for (int jj = 0; jj < 4; ++jj) o[tn][jj] *= alpha;
}
DI void ph_mla(const Params& p, int item, char* smem) {
  int bi, hd, qb, S;
  if (item < 512) { bi = item >> 7; hd = (item >> 5) & 3; qb = item & 31; S = 4096; }
  else { int it = item - 512; bi = 4 + (it >> 6); hd = (it >> 4) & 3; qb = it & 15; S = 2048; }
  const size_t tokb = tok0_of_batch(bi);
  const u16* qm = (const u16*)(p.ws + OFF_RA + RA_QM) + (tokb + qb * 128) * 384 + hd * 96;
  const u16* kb = (const u16*)(p.ws + OFF_RA + RA_KB) + tokb * 384 + hd * 96;
  const u16* vt = (const u16*)(p.ws + OFF_RA + RA_VT) + tokb * 256 + (size_t)hd * 64 * S;
  u16* z = (u16*)(p.ws + OFF_RB);
  constexpr int BUF = 64 * 104 + 64 * 72;
  u16* sKV = (u16*)smem;
  u16* sP = sKV + 2 * BUF;
  const int tid = ltid(), lane = tid & 63, w = tid >> 6, r = lane & 15, q4 = lane >> 4;
  bf16x8 qf[2][3];
#pragma unroll
  for (int tm = 0; tm < 2; ++tm)
#pragma unroll
    for (int ks = 0; ks < 3; ++ks) qf[tm][ks] = *(const bf16x8*)(qm + (size_t)(w * 32 + tm * 16 + r) * 384 + ks * 32 + q4 * 8);
  const int kr0 = tid / 12, kc0 = (tid % 12) * 8, kr1 = (tid + 256) / 12, kc1 = ((tid + 256) % 12) * 8, kr2 = (tid + 512) / 12, kc2 = ((tid + 512) % 12) * 8;
  const int vr0 = tid >> 3, vc0 = (tid & 7) * 8, vr1 = vr0 + 32;
  uint4 rk0, rk1, rk2, rv0, rv1;
#define MLA_LOAD(kt_) { const u16* kb2 = kb + (size_t)(kt_) * 64 * 384; \
    rk0 = *(const uint4*)(kb2 + (size_t)kr0 * 384 + kc0); rk1 = *(const uint4*)(kb2 + (size_t)kr1 * 384 + kc1); rk2 = *(const uint4*)(kb2 + (size_t)kr2 * 384 + kc2); \
    rv0 = *(const uint4*)(vt + (size_t)vr0 * S + (kt_) * 64 + vc0); rv1 = *(const uint4*)(vt + (size_t)vr1 * S + (kt_) * 64 + vc0); }
#define MLA_WRITE(b_) { u16* sK_ = sKV + (b_) * BUF; u16* sV_ = sK_ + 64 * 104; \
    *(uint4*)(sK_ + kr0 * 104 + kc0) = rk0; *(uint4*)(sK_ + kr1 * 104 + kc1) = rk1; *(uint4*)(sK_ + kr2 * 104 + kc2) = rk2; \
    *(uint4*)(sV_ + vr0 * 72 + vc0) = rv0; *(uint4*)(sV_ + vr1 * 72 + vc0) = rv1; }
  const int nkt = S >> 6;
  MLA_LOAD(0);
  __syncthreads();
  MLA_WRITE(0);
  MLA_LOAD(1);
  __syncthreads();
  f32x4 o[2][4];
  zero_acc(o);
  float m0 = -1e30f, m1 = -1e30f, l0 = 0.f, l1 = 0.f;
  for (int kt = 0; kt < nkt; ++kt) {
    const int cur = kt & 1;
    const u16* sK = sKV + cur * BUF;
    const u16* sVT = sK + 64 * 104;
    f32x4 s[2][4];
    zero_acc(s);
#pragma unroll
    for (int ks = 0; ks < 3; ++ks) {
      bf16x8 bfr[4];
#pragma unroll
      for (int i = 0; i < 4; ++i) bfr[i] = *(const bf16x8*)(sK + (i * 16 + r) * 104 + ks * 32 + q4 * 8);
#pragma unroll
      for (int tm = 0; tm < 2; ++tm)
#pragma unroll
        for (int tn = 0; tn < 4; ++tn) s[tm][tn] = __builtin_amdgcn_mfma_f32_16x16x32_bf16(bfr[tn], qf[tm][ks], s[tm][tn], 0, 0, 0);
    }
    mla_softmax(s[0], o[0], m0, l0);
    mla_softmax(s[1], o[1], m1, l1);
#pragma unroll
    for (int kp = 0; kp < 2; ++kp) {
      bf16x8 pa0 = pack8(s[0][2 * kp], s[0][2 * kp + 1]), pa1 = pack8(s[1][2 * kp], s[1][2 * kp + 1]);
#pragma unroll
      for (int td = 0; td < 4; ++td) {
        bf16x8 vb = *(const bf16x8*)(sVT + (td * 16 + r) * 72 + kp * 32 + q4 * 8);
        o[0][td] = __builtin_amdgcn_mfma_f32_16x16x32_bf16(vb, pa0, o[0][td], 0, 0, 0);
        o[1][td] = __builtin_amdgcn_mfma_f32_16x16x32_bf16(vb, pa1, o[1][td], 0, 0, 0);
      }
    }
    if (kt + 1 < nkt) {
      MLA_WRITE(cur ^ 1);
      if (kt + 2 < nkt) MLA_LOAD(kt + 2);
    }
    __syncthreads();
  }
#undef MLA_LOAD
#undef MLA_WRITE
#pragma unroll
  for (int tm = 0; tm < 2; ++tm) {
    float l = tm ? l1 : l0;
    l += __shfl_xor(l, 16);
    l += __shfl_xor(l, 32);
    float inv = 1.f / l;
    size_t tok = tokb + qb * 128 + w * 32 + tm * 16 + r;
#pragma unroll
    for (int tn = 0; tn < 4; ++tn) {
      f32x4 v = o[tm][tn];
      v[0] *= inv; v[1] *= inv; v[2] *= inv; v[3] *= inv;
      *(uint2*)(z + tok * ZW + Z_CQ + hd * 64 + tn * 16 + q4 * 4) = pack4(v);
    }
  }
}

DI void ph_fgemm(const Params& p, int item, char* smem) {
  int bi, mt, nt, S;
  if (item < 256) { bi = item >> 6; mt = (item >> 2) & 15; nt = item & 3; S = 4096; }
  else { int it = item - 256; bi = 4 + (it >> 5); mt = (it >> 2) & 7; nt = it & 3; S = 2048; }
  const size_t tokb = tok0_of_batch(bi);
  const int H = S >> 1;
  const int rmul = S == 4096 ? 1 : 2;
  const u16* dft = (const u16*)(p.ws + OFF_DFT);
  const u16* pq = (const u16*)(p.ws + OFF_PQT) + tokb * 512;
  u16* z = (u16*)(p.ws + OFF_RB);
  auto la = [&](int row, int k) {
    int j = (mt * 128 + row) * rmul;
    int kk = k < H ? k : 2048 + (k - H);
    return *(const uint4*)(dft + (size_t)j * 4096 + kk);
  };
  auto lb = [&](int n, int k) {
    int c = nt * 64 + n;
    return k < H ? *(const uint4*)(pq + (size_t)c * S + k) : *(const uint4*)(pq + (size_t)(256 + c) * S + (k - H));
  };
  const float nrm = rsqrtf((float)S * 64.f);
  auto epi = [&](f32x4 (&a1)[4][2], f32x4 (&a2)[4][2], int wm, int wn, int lane) {
    const int r = lane & 15, q = lane >> 4;
#pragma unroll
    for (int tm = 0; tm < 4; ++tm) {
      int m = wm * 64 + tm * 16 + r;
      int j = mt * 128 + m;
      float sg = (j & 1) ? -1.f : 1.f;
#pragma unroll
      for (int tn = 0; tn < 2; ++tn) {
        int c = nt * 64 + wn * 32 + tn * 16 + q * 4;
        f32x4 v1, v2;
#pragma unroll
        for (int jj = 0; jj < 4; ++jj) {
          float pm = sg * bf2f(pq[(size_t)(c + jj) * S + H]);
          v1[jj] = (a1[tm][tn][jj] + a2[tm][tn][jj] + pm) * nrm;
          v2[jj] = (a1[tm][tn][jj] - a2[tm][tn][jj] + pm) * nrm;
        }
        *(uint2*)(z + (tokb + j) * ZW + Z_DK0 + c) = pack4(v1);
        if (j > 0) *(uint2*)(z + (tokb + S - j) * ZW + Z_DK0 + c) = pack4(v2);
      }
    }
  };
  gemm_tile2_(p.wv, smem, S >> 6, la, lb, epi);
}

DI void ph_fmid(const Params& p, int item) {
  const int bi = item;
  const int S = bi < 4 ? 4096 : 2048, H = S >> 1;
  const size_t tokb = tok0_of_batch(bi);
  const u16* pq = (const u16*)(p.ws + OFF_PQT) + tokb * 512;
  u16* z = (u16*)(p.ws + OFF_RB);
  const int c = ltid();
  const u16* rp = pq + (size_t)c * S;
  float se = 0.f, so = 0.f;
#pragma unroll 8
  for (int k = 0; k < H; k += 8) {
    uint4 v = *(const uint4*)(rp + k);
    unsigned w[4] = {v.x, v.y, v.z, v.w};
#pragma unroll
    for (int e = 0; e < 4; ++e) { se += blo(w[e]); so += bhi(w[e]); }
  }
  float f = (se - so + bf2f(rp[H])) * rsqrtf((float)S * 64.f);
  z[(tokb + H) * ZW + Z_DK0 + c] = f2bf(f);
}

DI void ph_comb(const Params& p, int item) {
  const int tid = ltid();
  const size_t tok = (size_t)item * 128 + (tid >> 1);
  u16* z = (u16*)(p.ws + OFF_RB) + tok * ZW;
  const float* lse = (const float*)(p.ws + OFF_LSE);
#pragma unroll
  for (int hh = 0; hh < 2; ++hh) {
    int hd = (tid & 1) * 2 + hh;
    float l0 = lse[((size_t)0 * NTOK + tok) * 4 + hd], l1 = lse[((size_t)1 * NTOK + tok) * 4 + hd], l2 = lse[((size_t)2 * NTOK + tok) * 4 + hd];
    float mx = fmaxf(l0, fmaxf(l1, l2));
    float w0 = __expf(l0 - mx), w1 = __expf(l1 - mx), w2 = __expf(l2 - mx);
    float inv = 1.f / (w0 + w1 + w2);
    w0 *= inv; w1 *= inv; w2 *= inv;
#pragma unroll
    for (int c8 = 0; c8 < 8; ++c8) {
      u16* a = z + hd * 64 + c8 * 8;
      uint4 v0 = *(const uint4*)(a + 1280), v1 = *(const uint4*)(a + 1792), v2 = *(const uint4*)(a + 2048);
      unsigned x0[4] = {v0.x, v0.y, v0.z, v0.w}, x1[4] = {v1.x, v1.y, v1.z, v1.w}, x2[4] = {v2.x, v2.y, v2.z, v2.w}, o[4];
#pragma unroll
      for (int e = 0; e < 4; ++e)
        o[e] = pack2(w0 * blo(x0[e]) + w1 * blo(x1[e]) + w2 * blo(x2[e]), w0 * bhi(x0[e]) + w1 * bhi(x1[e]) + w2 * bhi(x2[e]));
      *(uint4*)(a + 1280) = make_uint4(o[0], o[1], o[2], o[3]);
    }
  }
}

DI void ph_retout(const Params& p, int item, int layer, char* smem, bool dry = false) {
  const int hd = item & 3, tile = item >> 2;
  u16* z = (u16*)(p.ws + OFF_RB) + (size_t)tile * 128 * ZW;
  const float* rs = (const float*)(p.ws + OFF_RS) + (size_t)item * 2 * 4096;
  u16* sQ = (u16*)smem;
  u16* sK = sQ + 128 * 72;
  u16* sVT = sK + 128 * 72;
  u16* sSf = sVT + 64 * 136;
  u16* sSb = sSf + 64 * 72;
  u16* sS = sSf;
  const int tid = ltid(), lane = tid & 63, w = tid >> 6, r = lane & 15, q4 = lane >> 4;
  const float lf = logsig(p.dec_f[layer * 4 + hd]), lb = logsig(p.dec_b[layer * 4 + hd]);
  __syncthreads();
#pragma unroll
  for (int i = 0; i < 4; ++i) {
    int c = tid + 256 * i, row = c >> 3, kc = (c & 7) * 8;
    *(uint4*)(sQ + row * 72 + kc) = *(const uint4*)(z + (size_t)row * ZW + Z_RQ + hd * 64 + kc);
    *(uint4*)(sK + row * 72 + kc) = *(const uint4*)(z + (size_t)row * ZW + Z_RK + hd * 64 + kc);
  }
#pragma unroll
  for (int i = 0; i < 2; ++i) {
    int c = tid + 256 * i, jp = c & 63, kc = (c >> 6) * 8;
    uint4 v0 = *(const uint4*)(z + (size_t)(2 * jp) * ZW + Z_RV + hd * 64 + kc);
    uint4 v1 = *(const uint4*)(z + (size_t)(2 * jp + 1) * ZW + Z_RV + hd * 64 + kc);
    unsigned w0[4] = {v0.x, v0.y, v0.z, v0.w}, w1[4] = {v1.x, v1.y, v1.z, v1.w};
    const int k5_ = (2 * jp) & 31, pc = ((2 * jp) & ~31) | (8 * ((k5_ >> 2) & 3) + 4 * (k5_ >> 4) + (k5_ & 3));
#pragma unroll
    for (int e = 0; e < 4; ++e) {
      *(unsigned*)(sVT + (kc + 2 * e) * 136 + pc) = (w0[e] & 0xffffu) | (w1[e] << 16);
      *(unsigned*)(sVT + (kc + 2 * e + 1) * 136 + pc) = (w0[e] >> 16) | (w1[e] & 0xffff0000u);
    }
  }
#pragma unroll
  for (int i = 0; i < 4; ++i) {
    int c = tid + 256 * i, e = c >> 4, d = (c & 15) * 4;
    float4 a = *(const float4*)(rs + e * 64 + d), b = *(const float4*)(rs + 4096 + e * 64 + d);
    *(uint2*)(sSf + e * 72 + d) = make_uint2(pack2(a.x, a.y), pack2(a.z, a.w));
    *(uint2*)(sSb + e * 72 + d) = make_uint2(pack2(b.x, b.y), pack2(b.z, b.w));
  }
  __syncthreads();
  f32x4 oc[2][1][4];
#pragma unroll
  for (int h = 0; h < 2; ++h) {
    f32x4 cf[1][4], cb[1][4];
    zero_acc(cf);
    zero_acc(cb);
    mma<1, 4>(sQ + (h * 64 + w * 16) * 72, 72, sSf, 72, 2, cf, lane);
    mma<1, 4>(sQ + (h * 64 + w * 16) * 72, 72, sSb, 72, 2, cb, lane);
    int i = h * 64 + w * 16 + r;
    float rf = __expf((float)(i + 1) * lf), rb = __expf((float)(128 - i) * lb);
#pragma unroll
    for (int tn = 0; tn < 4; ++tn)
#pragma unroll
      for (int jj = 0; jj < 4; ++jj) oc[h][0][tn][jj] = rf * cf[0][tn][jj] + rb * cb[0][tn][jj];
  }
#pragma unroll
  for (int h = 0; h < 2; ++h) {
    const int i = h * 64 + w * 16 + r;
    {
      f32x4 s[1][8];
      zero_acc(s);
      mma<1, 8>(sQ + (h * 64 + w * 16) * 72, 72, sK, 72, 2, s, lane);
#pragma unroll
      for (int tn = 0; tn < 8; ++tn)
#pragma unroll
        for (int jj = 0; jj < 4; ++jj) {
          int j = tn * 16 + q4 * 4 + jj;
          float dcy = i >= j ? __expf((float)(i - j) * lf) : __expf((float)(j - i) * lb);
          s[0][tn][jj] *= dcy;
        }
#pragma unroll
      for (int kp = 0; kp < 4; ++kp) {
        bf16x8 pa = pack8(s[0][2 * kp], s[0][2 * kp + 1]);
#pragma unroll
        for (int td = 0; td < 4; ++td) {
          bf16x8 vb = *(const bf16x8*)(sVT + (td * 16 + r) * 136 + kp * 32 + q4 * 8);
          oc[h][0][td] = __builtin_amdgcn_mfma_f32_16x16x32_bf16(vb, pa, oc[h][0][td], 0, 0, 0);
        }
      }
    }
    float ss = 0.f;
#pragma unroll
    for (int tn = 0; tn < 4; ++tn)
#pragma unroll
      for (int jj = 0; jj < 4; ++jj) ss += oc[h][0][tn][jj] * oc[h][0][tn][jj];
    ss += __shfl_xor(ss, 16);
    ss += __shfl_xor(ss, 32);
    float rn = rsqrtf(ss * (1.f / 64.f) + EPS);
#pragma unroll
    for (int tn = 0; tn < 4; ++tn) {
      u16* gp = z + (size_t)i * ZW + Z_RG + hd * 64 + tn * 16 + q4 * 4;
      uint2 gv = *(const uint2*)gp;
      float g0 = blo(gv.x), g1 = bhi(gv.x), g2 = blo(gv.y), g3 = bhi(gv.y);
      f32x4 v = oc[h][0][tn];
      v[0] *= rn * fsilu(g0);
      v[1] *= rn * fsilu(g1);
      v[2] *= rn * fsilu(g2);
      v[3] *= rn * fsilu(g3);
      if (dry) *(uint2*)((u16*)p.out + ((size_t)tile * 128 + i) * 1024 + hd * 64 + tn * 16 + q4 * 4) = pack4(v);
      else *(uint2*)gp = pack4(v);
    }
  }
}

DI void ph_wout(const Params& p, int item, int layer, char* smem) {
  const int nt = item & 7, tile = item >> 3;
  const u16* z = (const u16*)(p.ws + OFF_RB) + (size_t)tile * 128 * ZW;
  const u16* wt = (const u16*)(p.ws + OFF_WT + layer * WT_LAYER + WT_OUT) + (size_t)nt * 128 * 1024;
  u16* y = (u16*)(p.ws + OFF_RA) + (size_t)tile * 128 * 1024 + nt * 128;
  auto la = [&](int row, int k) { return *(const uint4*)(z + (size_t)row * ZW + Z_RG + k); };
  auto lb = [&](int n, int k) { return *(const uint4*)(wt + (size_t)n * 1024 + k); };
  auto epi = [&](f32x4 (&acc)[4][4], int wm, int wn, int lane) {
    const int r = lane & 15, q = lane >> 4;
#pragma unroll
    for (int tm = 0; tm < 4; ++tm) {
      int m = wm * 64 + tm * 16 + r;
#pragma unroll
      for (int tn = 0; tn < 4; ++tn) *(uint2*)(y + (size_t)m * 1024 + wn * 64 + tn * 16 + q * 4) = pack4(acc[tm][tn]);
    }
  };
  gemm_tile_(p.wv, smem, 16, la, lb, epi);
}

constexpr int N_UPM = 676;
DI void ph_up(const Params& p, int item, int layer, char* smem) {
  const int nt = item % 44, mtile = item / 44;
  int bi, mt, S;
  if (mtile < 132) { bi = mtile / 33; mt = mtile % 33; S = 4096; }
  else { int t = mtile - 132; bi = 4 + t / 17; mt = t % 17; S = 2048; }
  const size_t tokb = tok0_of_batch(bi);
  const u16* h2 = (const u16*)(p.ws + OFF_RB + RB_H2) + tokb * 1024;
  const u16* wt = (const u16*)(p.ws + OFF_WT + layer * WT_LAYER + WT_UP);
  u16* gated = (u16*)(p.ws + OFF_RB + RB_GATED) + tokb * DFF;
  const int pbase = 126 * mt - 1;
  auto la = [&](int row, int k) {
    int pos = pbase + row;
    uint4 v = make_uint4(0, 0, 0, 0);
    if (pos >= 0 && pos < S) v = *(const uint4*)(h2 + (size_t)pos * 1024 + k);
    return v;
  };
  auto lb = [&](int n, int k) {
    int nn = n < 64 ? nt * 64 + n : DFF + nt * 64 + (n - 64);
    return *(const uint4*)(wt + (size_t)nn * 1024 + k);
  };
  auto epi = [&](f32x4 (&acc)[4][4], int wm, int wn, int lane) {
    const int r = lane & 15, q = lane >> 4, tid = ltid();
    u16* sU = (u16*)smem;
    __syncthreads();
#pragma unroll
    for (int tm = 0; tm < 4; ++tm) {
      int m = wm * 64 + tm * 16 + r;
#pragma unroll
      for (int tn = 0; tn < 4; ++tn) *(uint2*)(sU + m * 136 + wn * 64 + tn * 16 + q * 4) = pack4(acc[tm][tn]);
    }
    __syncthreads();
    const int c2 = (tid & 31) * 2, rb = tid >> 5;
    const int na = nt * 64 + c2, nb = DFF + na;
    const float* cw = p.conv_w + (size_t)layer * 3 * 5632;
    const float* cbias = p.conv_b + (size_t)layer * 5632;
    float wa[3][2], wb[3][2], ba[2], bb[2];
#pragma unroll
    for (int t = 0; t < 3; ++t) { wa[t][0] = cw[t * 5632 + na]; wa[t][1] = cw[t * 5632 + na + 1]; wb[t][0] = cw[t * 5632 + nb]; wb[t][1] = cw[t * 5632 + nb + 1]; }
    ba[0] = cbias[na]; ba[1] = cbias[na + 1]; bb[0] = cbias[nb]; bb[1] = cbias[nb + 1];
    for (int i = 0; i < 16; ++i) {
      int rr = rb + 8 * i;
      int pos = pbase + rr;
      if (rr >= 1 && rr <= 126 && pos < S) {
        float a0 = ba[0], a1 = ba[1], b0 = bb[0], b1 = bb[1];
#pragma unroll
        for (int t = 0; t < 3; ++t) {
          unsigned ua = *(const unsigned*)(sU + (rr - 1 + t) * 136 + c2);
          unsigned ub = *(const unsigned*)(sU + (rr - 1 + t) * 136 + 64 + c2);
          a0 += wa[t][0] * blo(ua); a1 += wa[t][1] * bhi(ua);
          b0 += wb[t][0] * blo(ub); b1 += wb[t][1] * bhi(ub);
        }
        float g0 = fsilu(a0) * b0, g1 = fsilu(a1) * b1;
        *(unsigned*)(gated + (size_t)pos * DFF + na) = pack2(g0, g1);
      }
    }
  };
  gemm_tile_(p.wv, smem, 16, la, lb, epi);
}

DI void ph_down(const Params& p, int item, int layer, char* smem) {
  const int nt = item & 7, tile = item >> 3;
  const u16* a = (const u16*)(p.ws + OFF_RB + RB_GATED) + (size_t)tile * 128 * DFF;
  const u16* wt = (const u16*)(p.ws + OFF_WT + layer * WT_LAYER + WT_DOWN) + (size_t)nt * 128 * DFF;
  u16* y = (u16*)(p.ws + OFF_RA) + (size_t)tile * 128 * 1024 + nt * 128;
  auto la = [&](int row, int k) { return *(const uint4*)(a + (size_t)row * DFF + k); };
  auto lb = [&](int n, int k) { return *(const uint4*)(wt + (size_t)n * DFF + k); };
  auto epi = [&](f32x4 (&acc)[4][4], int wm, int wn, int lane) {
    const int r = lane & 15, q = lane >> 4;
#pragma unroll
    for (int tm = 0; tm < 4; ++tm) {
      int m = wm * 64 + tm * 16 + r;
#pragma unroll
      for (int tn = 0; tn < 4; ++tn) *(uint2*)(y + (size_t)m * 1024 + wn * 64 + tn * 16 + q * 4) = pack4(acc[tm][tn]);
    }
  };
  gemm_tile_(p.wv, smem, 44, la, lb, epi);
}


namespace g8 {
#define G8_LAS __attribute__((address_space(3)))
constexpr int BM = 256, BK = 64, HALF = 128, HTB = HALF * BK * 2, STAGE_BYTES = 8 * HTB, NXCD = 8, WGM = 8;
DI int lds_byte(int r, int c) { const int st = (r >> 4) * 2 + (c >> 5), rr = r & 15, cc = c & 31, ob = rr * 64 + cc * 2; return st * 1024 + (ob ^ (((ob >> 9) & 1) << 5)); }
DI void stage_rc(int b, int& R, int& C) { const int st = b / 1024, sb = b % 1024, swz = sb ^ (((sb >> 9) & 1) << 5); R = (st >> 1) * 16 + swz / 64; C = (st & 1) * 32 + (swz % 64) / 2; }
struct Unit { int pm, pn; };
struct Order {
  int nM, nN, nwg, G, c;
  DI bool next(int i, Unit& u) const {
    const long L = (long)i * G + c;
    if (L >= nwg) return false;
    int wgid = (int)L;
    { const int q = nwg / NXCD, r = nwg % NXCD, xcd = wgid % NXCD, off = wgid / NXCD; wgid = (xcd < r ? xcd * (q + 1) : r * (q + 1) + (xcd - r) * q) + off; }
    const int nig = WGM * nN, gid = wgid / nig, fm = gid * WGM, gsz = (nM - fm) < WGM ? (nM - fm) : WGM;
    u.pm = fm + ((wgid % nig) % gsz);
    u.pn = (wgid % nig) / gsz;
    return true;
  }
};
template <int lda, int ldb, int K, int nM, int nN, class Epi>
DI void gemm_phase(int wv_, G8_LAS unsigned char* lds, const u16* A, const u16* Bt, const Epi& E) {
  int tid_ = (wv_ << 6) | lane_now();
  asm volatile("" : "+v"(tid_));
  const int tid = tid_, wid = __builtin_amdgcn_readfirstlane(tid >> 6), lane = tid & 63, wr = wid >> 2, wc = wid & 3, fr = lane & 15, fq = lane >> 4;
  const int nt = K / BK;
  Order S;
  S.nM = nM; S.nN = nN; S.nwg = nM * nN; S.G = gridDim.x; S.c = blockIdx.x;
  unsigned voffA[2], voffB[2];
#pragma unroll
  for (int i = 0; i < 2; ++i) { int R, C; stage_rc(tid * 16 + i * 8192, R, C); voffA[i] = (unsigned)(R * lda + C) * 2u; voffB[i] = (unsigned)(R * ldb + C) * 2u; }
  const size_t kstep = (size_t)(BK * 2);
  const size_t hstepA = (size_t)HALF * lda * 2, tstepA = 2 * hstepA, hstepB = (size_t)HALF * ldb * 2, tstepB = 2 * hstepB;
  const unsigned ldsw = (unsigned)wid * 1024u;
  const int aoff = lds_byte(wr * 64 + fr, fq * 8), boff = lds_byte(wc * 32 + fr, fq * 8);
#define G8_SA(b, h) (((b) * 2 + (h)) * HTB)
#define G8_SB(b, h) ((4 + (b) * 2 + (h)) * HTB)
#define G8_STAGE(bufoff, gbase, voff) do { _Pragma("unroll") for (int _i = 0; _i < 2; ++_i) \
    __builtin_amdgcn_global_load_lds((const unsigned*)((const char*)(gbase) + (voff)[_i]), (G8_LAS unsigned*)(lds + (bufoff) + ldsw + _i * 8192), 16, 0, 0); } while (0)
#define G8_LDA(dst, b, h) do { _Pragma("unroll") for (int m = 0; m < 4; ++m) _Pragma("unroll") for (int k = 0; k < 2; ++k) dst[m][k] = *(const G8_LAS bf16x8*)(lds + G8_SA(b, h) + aoff + m * 2048 + k * 1024); } while (0)
#define G8_LDB(dst, b, h) do { _Pragma("unroll") for (int n = 0; n < 2; ++n) _Pragma("unroll") for (int k = 0; k < 2; ++k) dst[n][k] = *(const G8_LAS bf16x8*)(lds + G8_SB(b, h) + boff + n * 2048 + k * 1024); } while (0)
#define G8_MMA(ai, bj, At, Bt) do { __builtin_amdgcn_s_setprio(1); _Pragma("unroll") for (int m = 0; m < 4; ++m) _Pragma("unroll") for (int n = 0; n < 2; ++n) _Pragma("unroll") for (int k = 0; k < 2; ++k) \
    acc[ai][bj][m][n] = __builtin_amdgcn_mfma_f32_16x16x32_bf16(Bt[n][k], At[m][k], acc[ai][bj][m][n], 0, 0, 0); __builtin_amdgcn_s_setprio(0); } while (0)
#define G8_WAIT_V(n) asm volatile("s_waitcnt vmcnt(" #n ")" ::: "memory")
#define G8_WAIT_L(n) asm volatile("s_waitcnt lgkmcnt(" #n ")" ::: "memory")
#define G8_BAR __builtin_amdgcn_s_barrier()
#define G8_SCHED __builtin_amdgcn_sched_barrier(0)
  Unit cur, nxt;
  int ui = 0;
  if (!S.next(0, cur)) return;
  f32x4 acc[2][2][4][2];
  float zz_ = 0.f;
  asm volatile("" : "+v"(zz_));
#pragma unroll
  for (int a = 0; a < 2; ++a)
#pragma unroll
    for (int b = 0; b < 2; ++b)
#pragma unroll
      for (int m = 0; m < 4; ++m)
#pragma unroll
        for (int n = 0; n < 2; ++n) acc[a][b][m][n] = (f32x4){zz_, zz_, zz_, zz_};
  bf16x8 At[4][2], B0[2][2], B1[2][2];
  const char* cA = (const char*)A + (size_t)cur.pm * tstepA;
  const char* cB = (const char*)Bt + (size_t)cur.pn * tstepB;
  G8_STAGE(G8_SB(0, 0), cB, voffB); G8_STAGE(G8_SA(0, 0), cA, voffA); G8_STAGE(G8_SB(0, 1), cB + hstepB, voffB); G8_STAGE(G8_SA(0, 1), cA + hstepA, voffA);
  if (wr == 1) G8_BAR;
  G8_WAIT_V(4); G8_BAR;
  G8_STAGE(G8_SB(1, 0), cB + kstep, voffB); G8_STAGE(G8_SA(1, 0), cA + kstep, voffA); G8_STAGE(G8_SB(1, 1), cB + hstepB + kstep, voffB);
  G8_WAIT_V(6); G8_BAR;
  for (;;) {
    const bool has_next = S.next(ui + 1, nxt);
    const char* nA = has_next ? (const char*)A + (size_t)nxt.pm * tstepA : cA;
    const char* nB = has_next ? (const char*)Bt + (size_t)nxt.pn * tstepB : cB;
    for (int t = 0; t < nt; t += 2) {
      const bool last = (t == nt - 2);
      const char* a1 = cA + (size_t)(t + 1) * kstep;
      const char* a2 = last ? nA : cA + (size_t)(t + 2) * kstep;
      const char* b2 = last ? nB : cB + (size_t)(t + 2) * kstep;
      const char* a3 = a2 + kstep;
      const char* b3 = b2 + kstep;
      G8_LDB(B0, 0, 0); G8_SCHED; G8_LDA(At, 0, 0); G8_STAGE(G8_SA(1, 1), a1 + hstepA, voffA);
      G8_WAIT_L(8); G8_BAR; G8_WAIT_L(0); G8_MMA(0, 0, At, B0); G8_BAR; G8_SCHED;
      G8_LDB(B1, 0, 1); G8_STAGE(G8_SB(0, 0), b2, voffB);
      G8_BAR; G8_WAIT_L(0); G8_MMA(0, 1, At, B1); G8_BAR;
      G8_LDA(At, 0, 1); G8_STAGE(G8_SA(0, 0), a2, voffA);
      G8_BAR; G8_WAIT_L(0); G8_MMA(1, 0, At, B0); G8_BAR; G8_SCHED;
      G8_STAGE(G8_SB(0, 1), b2 + hstepB, voffB);
      G8_WAIT_V(6); G8_BAR; G8_MMA(1, 1, At, B1); G8_BAR;
      G8_LDB(B0, 1, 0); G8_SCHED; G8_LDA(At, 1, 0); G8_STAGE(G8_SA(0, 1), a2 + hstepA, voffA);
      G8_WAIT_L(8); G8_BAR; G8_WAIT_L(0); G8_MMA(0, 0, At, B0); G8_BAR; G8_SCHED;
      G8_LDB(B1, 1, 1); G8_STAGE(G8_SB(1, 0), b3, voffB);
      G8_BAR; G8_WAIT_L(0); G8_MMA(0, 1, At, B1); G8_BAR;
      G8_LDA(At, 1, 1); G8_STAGE(G8_SA(1, 0), a3, voffA);
      G8_BAR; G8_WAIT_L(0); G8_MMA(1, 0, At, B0); G8_BAR; G8_SCHED;
      G8_STAGE(G8_SB(1, 1), b3 + hstepB, voffB);
      G8_WAIT_V(6); G8_BAR; G8_MMA(1, 1, At, B1); G8_BAR;
    }
    E(acc, cur, wr, wc, fr, fq);
    if (!has_next) break;
#pragma unroll
    for (int a = 0; a < 2; ++a)
#pragma unroll
      for (int b = 0; b < 2; ++b)
#pragma unroll
        for (int m = 0; m < 4; ++m)
#pragma unroll
          for (int n = 0; n < 2; ++n) acc[a][b][m][n] = (f32x4){zz_, zz_, zz_, zz_};
    cur = nxt; cA = nA; cB = nB; ++ui;
  }
  G8_WAIT_V(0);
  if (wr == 0) G8_BAR;
  G8_BAR;
}
struct EpiStore {
  u16* O; int ldc;
  DI void operator()(const f32x4 (&acc)[2][2][4][2], const Unit& u, int wr, int wc, int fr, int fq) const {
#pragma unroll
    for (int ai = 0; ai < 2; ++ai)
#pragma unroll
      for (int m = 0; m < 4; ++m) {
        u16* rowp = O + (size_t)(u.pm * BM + ai * HALF + wr * 64 + m * 16 + fr) * ldc + u.pn * BM + wc * 32 + fq * 4;
#pragma unroll
        for (int bj = 0; bj < 2; ++bj)
#pragma unroll
          for (int n = 0; n < 2; ++n) *(uint2*)(rowp + bj * HALF + n * 16) = pack4(acc[ai][bj][m][n]);
      }
  }
};
}


struct EpiWin {
  u16* z; u16* pqt; const float2* tab;
  DI void operator()(f32x4 (&acc)[2][2][4][2], const g8::Unit& u, int wr, int wc, int fr, int fq) const {
#pragma unroll
    for (int ai = 0; ai < 2; ++ai) {
      int bi, S, pos0;
      tile_info(u.pm * 2 + ai, bi, S, pos0);
      u16* pq = pqt + (size_t)tok0_of_batch(bi) * 512;
#pragma unroll
      for (int m = 0; m < 4; ++m) {
        const int rl = wr * 64 + m * 16 + fr;
        const int pos = pos0 + rl;
        const int fpos = pos <= (S >> 1) ? pos : 3 * (S >> 1) - pos;
        const size_t tok = (size_t)(u.pm * 2 + ai) * 128 + rl;
        const float2* tr = tab + pos * 56;
#pragma unroll
        for (int bj = 0; bj < 2; ++bj) {
          const int W0 = u.pn * 256 + bj * 128 + wc * 32;
          f32x4 a0 = acc[ai][bj][m][0], a1 = acc[ai][bj][m][1];
          if (W0 < 512) {
#pragma unroll
            for (int e = 0; e < 4; ++e) {
              pq[(size_t)(W0 + fq * 4 + e) * S + fpos] = f2bf(a0[e]);
              pq[(size_t)(W0 + 16 + fq * 4 + e) * S + fpos] = f2bf(a1[e]);
            }
            continue;
          }
          const int zw = W0 - 512;
          if (zw >= ZW) continue;
          const int zh = zw & ~63;
          if (zh < 512) {
            const float sc = zh >= 256 ? 0.125f : 1.f;
            const int i0 = 16 * (wc & 1) + 4 * fq;
            rope_pair(a0, a1, tr + 24 + 16 * (wc & 1), fq, sc);
            *(uint2*)(z + tok * ZW + zh + i0) = pack4(a0);
            *(uint2*)(z + tok * ZW + zh + 32 + i0) = pack4(a1);
            continue;
          }
          const bool prope = (zh >= 1024 && zh < 1536) || (zh >= 1792 && zh < 2816);
          if (prope) {
            const bool isq = (zh >= 1280 && zh < 1536) || (zh >= 1792 && zh < 2304);
            const float sc = isq ? 0.125f * LOG2E : 1.f;
            if ((wc & 1) == 0) {
#pragma unroll
              for (int e = 0; e < 4; ++e) {
                float2 cs = tr[16 + (fq & 1) * 4 + e];
                float v = a0[e];
                float o = __shfl_xor(v, 32);
                a0[e] = fq < 2 ? v * cs.x - o * cs.y : v * cs.x + o * cs.y;
              }
            }
#pragma unroll
            for (int e = 0; e < 4; ++e) { a0[e] *= sc; a1[e] *= sc; }
          } else if (zw == Z_KR) {
            rope_pair(a0, a1, tr, fq, 1.f);
          }
          *(uint2*)(z + tok * ZW + zw + fq * 4) = pack4(a0);
          *(uint2*)(z + tok * ZW + zw + 16 + fq * 4) = pack4(a1);
        }
      }
    }
  }
};


struct EpiUp {
  u16* gated; const float* cw; const float* cbias; char* xbuf; int wv;
  DI void operator()(f32x4 (&acc)[2][2][4][2], const g8::Unit& u, int wr, int wc, int fr, int fq) const {
    u16* sX = (u16*)xbuf;
    int tid_ = (wv << 6) | lane_now();
    asm volatile("" : "+v"(tid_));
    const int row = tid_ >> 1, hf = tid_ & 1;
    const int T = 254 * u.pm - 1 + row;
    const bool live = row >= 1 && row <= 254 && T < NTOK;
    int pos = 0, S = 4096;
    if (live) { if (T < 16384) { pos = T & 4095; } else { pos = (T - 16384) & 2047; S = 2048; } }
    const bool hasp = pos > 0, hasn = pos < S - 1;
    if (wr == 0) __builtin_amdgcn_s_barrier();
#pragma unroll 1
    for (int wcj = 0; wcj < 4; ++wcj)
#pragma unroll
    for (int nj = 0; nj < 2; ++nj) {
      if (wc == wcj) {
#pragma unroll
        for (int ai = 0; ai < 2; ++ai)
#pragma unroll
          for (int m = 0; m < 4; ++m) {
            int r = ai * 128 + wr * 64 + m * 16 + fr;
            *(uint2*)(sX + r * 32 + fq * 4) = pack4(acc[ai][0][m][nj]);
            *(uint2*)(sX + r * 32 + 16 + fq * 4) = pack4(acc[ai][1][m][nj]);
          }
      }
      __syncthreads();
      if (live) {
        const int ca = u.pn * 128 + wcj * 32 + nj * 16 + hf * 8;
        float oa[8], ob[8];
#pragma unroll
        for (int e = 0; e < 8; ++e) { oa[e] = cbias[ca + e]; ob[e] = cbias[DFF + ca + e]; }
#pragma unroll
        for (int t = 0; t < 3; ++t) {
          if ((t == 0 && !hasp) || (t == 2 && !hasn)) continue;
          uint4 va = *(const uint4*)(sX + (row - 1 + t) * 32 + hf * 8);
          uint4 vb = *(const uint4*)(sX + (row - 1 + t) * 32 + 16 + hf * 8);
          unsigned wa[4] = {va.x, va.y, va.z, va.w}, wb[4] = {vb.x, vb.y, vb.z, vb.w};
#pragma unroll
          for (int e = 0; e < 8; ++e) {
            float ua = (e & 1) ? bhi(wa[e >> 1]) : blo(wa[e >> 1]);
            float ub = (e & 1) ? bhi(wb[e >> 1]) : blo(wb[e >> 1]);
            oa[e] += cw[t * 5632 + ca + e] * ua;
            ob[e] += cw[t * 5632 + DFF + ca + e] * ub;
          }
        }
        unsigned o[4];
#pragma unroll
        for (int e = 0; e < 8; e += 2) {
          float g0 = fsilu(oa[e]) * ob[e], g1 = fsilu(oa[e + 1]) * ob[e + 1];
          o[e >> 1] = pack2(g0, g1);
        }
        *(uint4*)(gated + (size_t)T * DFF + ca) = make_uint4(o[0], o[1], o[2], o[3]);
      }
      __syncthreads();
    }
    if (wr == 1) __builtin_amdgcn_s_barrier();
  }
};


#define XB_TMO      128
#define XB_XCNT(j)  (256  + 64 * (j))
#define XB_XSUB(j)  (1280 + 64 * (j))
#define XB_XGEN(j)  (2304 + 64 * (j))
#define XB_TOP      3328
#define XB_TOPGEN   3392
#define XCD_BAR_WORDS 3456
#define XB_SPIN_CAP (1u << 18)
#define XLAS __attribute__((address_space(3)))
DI unsigned xb_ld(unsigned* p) { return __hip_atomic_load(p, __ATOMIC_RELAXED, __HIP_MEMORY_SCOPE_AGENT); }
DI unsigned xb_add(unsigned* p, unsigned v) { return __hip_atomic_fetch_add(p, v, __ATOMIC_RELAXED, __HIP_MEMORY_SCOPE_AGENT); }
DI unsigned xb_xcc_id() { return (unsigned)__builtin_amdgcn_s_getreg((3 << 11) | 20) & 0xFu; }
#define XB_SPIN(cond, bar) do { unsigned _sp = 0; while (cond) { __builtin_amdgcn_s_sleep(1); \
    if ((++_sp & 255u) == 0u) { if (xb_ld(&(bar)[XB_TMO])) break; if (_sp > XB_SPIN_CAP) { atomicAdd(&(bar)[XB_TMO], 1u); break; } } } } while (0)
struct XcdBarrier { unsigned* bar; unsigned x; volatile XLAS unsigned* st; };
DI XcdBarrier xcd_barrier_post(unsigned* bar, volatile XLAS unsigned* st) {
  XcdBarrier b; b.bar = bar; b.x = xb_xcc_id(); b.st = st;
  if (threadIdx.x == 0) (void)xb_add(&bar[XB_XCNT(b.x)], 1u);
  return b;
}
DI void xcd_barrier_complete(unsigned* bar, unsigned x, unsigned& nloc, unsigned& nx) {
  const unsigned G = gridDim.x * gridDim.y * gridDim.z;
  unsigned sum, cnt, mine, sp = 0u;
  for (;;) {
    sum = 0u; cnt = 0u; mine = 0u;
#pragma unroll
    for (unsigned j = 0; j < 16; ++j) { const unsigned c = xb_ld(&bar[XB_XCNT(j)]); sum += c; cnt += (c > 0u) ? 1u : 0u; mine = (j == x) ? c : mine; }
    if (sum == G) break;
    __builtin_amdgcn_s_sleep(1);
    if ((++sp & 255u) == 0u) { if (xb_ld(&bar[XB_TMO])) break; if (sp > XB_SPIN_CAP) { atomicAdd(&bar[XB_TMO], 1u); break; } }
  }
  nloc = mine > 0u ? mine : 1u; nx = cnt > 0u ? cnt : 1u;
}
DI void xcd_barrier(const XcdBarrier& b) {
  asm volatile("s_waitcnt vmcnt(0)" ::: "memory");
  __syncthreads();
  if (threadIdx.x == 0) {
    unsigned* bar = b.bar;
    __builtin_amdgcn_s_waitcnt(0);
    unsigned nloc = b.st[0], nx = b.st[1];
    if (nloc == 0u) { xcd_barrier_complete(bar, b.x, nloc, nx); b.st[0] = nloc; b.st[1] = nx; }
    const unsigned old = xb_add(&bar[XB_XSUB(b.x)], 1u);
    const unsigned gen = old / nloc;
    if (old + 1u == (gen + 1u) * nloc) {
      __builtin_amdgcn_fence(__ATOMIC_RELEASE, "agent");
      asm volatile("s_waitcnt vmcnt(0)" ::: "memory");
      const unsigned og = xb_add(&bar[XB_TOP], 1u);
      const unsigned tg = og / nx;
      if (og + 1u == (tg + 1u) * nx) xb_add(&bar[XB_TOPGEN], 1u);
      else XB_SPIN(xb_ld(&bar[XB_TOPGEN]) == tg, bar);
      __builtin_amdgcn_fence(__ATOMIC_ACQUIRE, "agent");
      xb_add(&bar[XB_XGEN(b.x)], 1u);
      asm volatile("s_waitcnt vmcnt(0)" ::: "memory");
    } else {
      XB_SPIN(xb_ld(&bar[XB_XGEN(b.x)]) == gen, bar);
      __builtin_amdgcn_fence(__ATOMIC_ACQUIRE, "agent");
      asm volatile("s_waitcnt vmcnt(0)" ::: "memory");
    }
  }
  __syncthreads();
}

#define GSYNC() do { xcd_barrier(xb); if (PROBE & 128) xcd_barrier(xb); } while (0)
template <int layer>
DI void run_layer(const Params& pp, const XcdBarrier& xb, char* smem_all, int wv0) {
  const int hb = wv0 >> 2;
  char* smem = smem_all + hb * HALF_LDS;
  const int vb = blockIdx.x * 2 + hb, nvb = gridDim.x * 2;
#define PH_BEGIN Params p = pp; p.wv = wv0; asm volatile("" : "+s"(p.ws), "+s"(p.out), "+s"(p.wv));
  {
    PH_BEGIN
    __syncthreads();
    EpiWin E{(u16*)(p.ws + OFF_RB), (u16*)(p.ws + OFF_PQT), (const float2*)(p.ws + OFF_TAB)};
    for (int rep_ = 0; rep_ < 1 + (((PROBE >> 8) & 1) && layer == 0 ? 1 : 0); ++rep_)
    g8::gemm_phase<1024, 1024, 1024, 320, 17>(p.wv, (G8_LAS unsigned char*)smem_all, (const u16*)(p.ws + OFF_RA), (const u16*)(p.ws + OFF_WT + layer * WT_LAYER + WT_IN), E);
  }
  GSYNC();
  {
    PH_BEGIN
    int* ctr = (int*)(p.ws + OFF_CTR) + layer * 2 + 0;
    volatile int* slot = (volatile int*)(smem_all + 2 * HALF_LDS);
    for (;;) {
      __syncthreads();
      if (p.wv == 0 && lane_now() == 0) *slot = atomicAdd(ctr, 2);
      __syncthreads();
      const int it = *slot + hb;
      if (it >= N_P2) break;
      int i = it;
      if (i < N_RST) { ph_retscan(p, i, layer, smem); continue; }
      i -= N_RST;
      if (i < N_DIL) { if ((PROBE & 2) && layer == 0) ph_dil(p, i, smem, true); ph_dil(p, i, smem); continue; }
      i -= N_DIL;
      if (i < N_QP) { ph_qproj(p, i, layer, smem); continue; }
      i -= N_QP;
      if (i < N_KVP) { ph_kvproj(p, i, layer, smem); continue; }
      i -= N_KVP;
      ph_pqfold(p, i);
    }
  }
  GSYNC();
  {
    PH_BEGIN
    int* ctr = (int*)(p.ws + OFF_CTR) + layer * 2 + 1;
    volatile int* slot = (volatile int*)(smem_all + 2 * HALF_LDS);
    for (;;) {
      __syncthreads();
      if (p.wv == 0 && lane_now() == 0) *slot = atomicAdd(ctr, 2);
      __syncthreads();
      const int it = *slot + hb;
      if (it >= N_P3) break;
      int i = it;
      if (i < N_FM) { ph_fmid(p, i); continue; }
      i -= N_FM;
      if (i < N_MLA) { if ((PROBE & 4) && layer == 0) ph_mla(p, i, smem); ph_mla(p, i, smem); continue; }
      i -= N_MLA;
      if (i < N_FG) { ph_fgemm(p, i, smem); continue; }
      i -= N_FG;
      if (i < N_RO) { ph_retout(p, i, layer, smem); continue; }
      i -= N_RO;
      ph_comb(p, i);
    }
  }
  GSYNC();
  {
    PH_BEGIN
    __syncthreads();
    g8::EpiStore E{(u16*)(p.ws + OFF_RA), 1024};
    for (int rep_ = 0; rep_ < 1 + (((PROBE >> 9) & 1) && layer == 0 ? 1 : 0); ++rep_)
    g8::gemm_phase<ZW, 1024, 1024, 320, 4>(p.wv, (G8_LAS unsigned char*)smem_all, (const u16*)(p.ws + OFF_RB) + Z_RG, (const u16*)(p.ws + OFF_WT + layer * WT_LAYER + WT_OUT), E);
  }
  GSYNC();
  {
    PH_BEGIN
    for (int it = vb; it < 5120; it += nvb) { if ((PROBE & 32) && layer == 0) ph_ew(p, it, 1, layer); ph_ew(p, it, 1, layer); }
  }
  GSYNC();
  {
    PH_BEGIN
    __syncthreads();
    EpiUp E{(u16*)(p.ws + OFF_RB + RB_GATED), p.conv_w + (size_t)layer * 3 * 5632, p.conv_b + (size_t)layer * 5632, smem_all + 131072, p.wv};
    for (int rep_ = 0; rep_ < 1 + (((PROBE >> 10) & 1) && layer == 0 ? 1 : 0); ++rep_)
    g8::gemm_phase<1024, 1024, 1024, 323, 22>(p.wv, (G8_LAS unsigned char*)smem_all, (const u16*)(p.ws + OFF_RB + RB_H2), (const u16*)(p.ws + OFF_WT + layer * WT_LAYER + WT_UP), E);
  }
  GSYNC();
  {
    PH_BEGIN
    __syncthreads();
    g8::EpiStore E{(u16*)(p.ws + OFF_RA), 1024};
    for (int rep_ = 0; rep_ < 1 + (((PROBE >> 11) & 1) && layer == 0 ? 1 : 0); ++rep_)
    g8::gemm_phase<DFF, DFF, DFF, 320, 4>(p.wv, (G8_LAS unsigned char*)smem_all, (const u16*)(p.ws + OFF_RB + RB_GATED), (const u16*)(p.ws + OFF_WT + layer * WT_LAYER + WT_DOWN), E);
  }
  GSYNC();
  {
    PH_BEGIN
    for (int it = vb; it < 5120; it += nvb) ph_ew(p, it, 2, layer);
  }
}

__global__ void __launch_bounds__(512, 2) mega(Params pp) {
  extern __shared__ __attribute__((aligned(16))) char smem_all[];
  cg::grid_group grid = cg::this_grid();
  const int wv0 = __builtin_amdgcn_readfirstlane(threadIdx.x >> 6);
  volatile XLAS unsigned* xst = (volatile XLAS unsigned*)(smem_all + 2 * HALF_LDS + 16);
  if (threadIdx.x < 2) xst[threadIdx.x] = 0u;
  __syncthreads();
  XcdBarrier xb = xcd_barrier_post((unsigned*)(pp.ws + OFF_BAR), xst);
  {
    const int hb = wv0 >> 2;
    char* smem = smem_all + hb * HALF_LDS;
    const int vb = blockIdx.x * 2 + hb, nvb = gridDim.x * 2;
    {
      PH_BEGIN
      int* ctr = (int*)(p.ws + OFF_CTR) + 8;
      volatile int* slot = (volatile int*)(smem_all + 2 * HALF_LDS);
      for (;;) {
        __syncthreads();
        if (p.wv == 0 && lane_now() == 0) *slot = atomicAdd(ctr, 2);
        __syncthreads();
        const int j = *slot + hb;
        if (j >= N_PREP) break;
        int it;
        if (j < 192) it = PI_TR + PI_FOLD + PI_PAD + j;
        else if (j < 320) it = PI_TR + (j - 192);
        else if (j < 576) it = PI_TR + PI_FOLD + PI_PAD + PI_MOD + (j - 320);
        else if (j < 832) it = PI_TR + PI_FOLD + PI_PAD + PI_MOD + PI_DFT + (j - 576);
        else if (j < 834) it = PI_TR + PI_FOLD + (j - 832);
        else it = j - 834;
        ph_prep(p, it, smem);
      }
    }
    grid.sync();
    {
      PH_BEGIN
      for (int it = vb; it < 5120; it += nvb) ph_ew(p, it, 0, 0);
    }
    GSYNC();
  }
  run_layer<0>(pp, xb, smem_all, wv0);
  GSYNC();
  run_layer<1>(pp, xb, smem_all, wv0);
}

extern "C" void kernel_launch(void* const* d_in, const int* in_sizes, int n_in, void* d_out, int out_size, void* d_ws,
                              size_t ws_size, hipStream_t stream) {
  static int grid_blocks = 0;
  if (!grid_blocks) {
    hipFuncSetAttribute((const void*)mega, hipFuncAttributeMaxDynamicSharedMemorySize, DYN_LDS);
    int dev = 0, cus = 0, per_cu = 0;
    hipGetDevice(&dev);
    hipDeviceGetAttribute(&cus, hipDeviceAttributeMultiprocessorCount, dev);
    hipOccupancyMaxActiveBlocksPerMultiprocessor(&per_cu, mega, 512, DYN_LDS);
    if (per_cu > 1) per_cu = 1;
    if (per_cu < 1) per_cu = 1;
    grid_blocks = cus * per_cu;
  }
  if (ws_size < WS_NEED) { fprintf(stderr, "workspace too small: %zu < %zu\n", ws_size, (size_t)WS_NEED); return; }
  Params p{};
  const float** f = (const float**)&p;
  for (int i = 0; i < 23; ++i) f[i] = (const float*)d_in[i];
  p.out = (float*)d_out;
  p.ws = (char*)d_ws;
#if 0
#else
  hipMemsetAsync((char*)d_ws + OFF_CTR, 0, 4096 + 16384, stream);
  p.ph_lo = 0;
  p.ph_hi = 20;
  void* args[] = {&p};
  hipError_t e = hipLaunchCooperativeKernel((void*)mega, dim3(grid_blocks), dim3(512), args, DYN_LDS, stream);
  if (e != hipSuccess) fprintf(stderr, "cooperative launch failed: %s (grid %d)\n", hipGetErrorString(e), grid_blocks);
#endif
}
```
